# Optimizing an MI355X kernel written in HIP

```python
import math
import jax, jax.numpy as jnp
from jax import lax
import numpy as np

D_MODEL = 1024
BATCH = 4
SEQ = 8192
DEPTH = 4

N_SSM_LAYERS = DEPTH // 2
N_ATTN_LAYERS = DEPTH - N_SSM_LAYERS
SSM_GROUP = 16
SSM_GROUPS = D_MODEL // SSM_GROUP
SSM_STATE = 64
DT_MIN = 1e-3
DT_MAX = 1e-1
HEAD_DIM = 64
V_DIM = 2 * HEAD_DIM
N_HEADS = D_MODEL // (2 * HEAD_DIM)
QK_WIDTH = N_HEADS * 2 * HEAD_DIM
V_WIDTH = N_HEADS * V_DIM
D_FF = 4 * D_MODEL
NUM_BUCKETS = 32
MAX_DISTANCE = 128
Q_BLOCK = 128
NORM_EPS = 1e-6
NEG_INF = -1e30

kernel_name = "yoco_s5_diffattn_hybrid"


def _rms_norm(x, gain):
    xf = x.astype(jnp.float32)
    y = xf * lax.rsqrt(jnp.mean(xf * xf, axis=-1, keepdims=True) + NORM_EPS)
    return (y * gain.astype(jnp.float32)).astype(x.dtype)


def _sq_relu_mlp(h, w_up, w_down):
    a = jax.nn.relu(h @ w_up)
    return (a * a) @ w_down


def _complex_linear_combine(left, right):
    a_re1, a_im1, b_re1, b_im1 = left
    a_re2, a_im2, b_re2, b_im2 = right
    a_re = a_re1 * a_re2 - a_im1 * a_im2
    a_im = a_re1 * a_im2 + a_im1 * a_re2
    b_re = a_re2 * b_re1 - a_im2 * b_im1 + b_re2
    b_im = a_re2 * b_im1 + a_im2 * b_re1 + b_im2
    return (a_re, a_im, b_re, b_im)


def _s5_mixer(h, w_in, a_re, a_im, log_dt, b_re, b_im, c_re, c_im, d_skip, w_glu):
    bsz, seqlen, _ = h.shape
    u = (h @ w_in).astype(jnp.float32).reshape(bsz, seqlen, SSM_GROUPS, SSM_GROUP)
    dt = jnp.exp(log_dt.astype(jnp.float32))[:, None]
    lr = a_re.astype(jnp.float32)
    li = a_im.astype(jnp.float32)
    mag = jnp.exp(lr * dt)
    ab_re = mag * jnp.cos(li * dt)
    ab_im = mag * jnp.sin(li * dt)
    den = lr * lr + li * li
    coef_re = ((ab_re - 1.0) * lr + ab_im * li) / den
    coef_im = (ab_im * lr - (ab_re - 1.0) * li) / den
    br = b_re.astype(jnp.float32)
    bi = b_im.astype(jnp.float32)
    bb_re = coef_re[..., None] * br - coef_im[..., None] * bi
    bb_im = coef_re[..., None] * bi + coef_im[..., None] * br
    bu_re = jnp.einsum('blgc,gpc->blgp', u, bb_re)
    bu_im = jnp.einsum('blgc,gpc->blgp', u, bb_im)
    a_seq_re = jnp.broadcast_to(ab_re, (1, seqlen, SSM_GROUPS, SSM_STATE))
    a_seq_im = jnp.broadcast_to(ab_im, (1, seqlen, SSM_GROUPS, SSM_STATE))
    _, _, s_re, s_im = lax.associative_scan(
        _complex_linear_combine, (a_seq_re, a_seq_im, bu_re, bu_im), axis=1)
    y = (jnp.einsum('blgp,gcp->blgc', s_re, c_re.astype(jnp.float32))
         - jnp.einsum('blgp,gcp->blgc', s_im, c_im.astype(jnp.float32)))
    y = y + d_skip.astype(jnp.float32).reshape(SSM_GROUPS, SSM_GROUP) * u
    y = jax.nn.gelu(y.reshape(bsz, seqlen, D_MODEL)).astype(h.dtype)
    val, gate = jnp.split(y @ w_glu, 2, axis=-1)
    return val * jax.nn.sigmoid(gate)


def _shared_kv(x, kv_norm, w_kv):
    bsz, seqlen, _ = x.shape
    kv = _rms_norm(x, kv_norm) @ w_kv
    k = kv[..., :QK_WIDTH].reshape(bsz, seqlen, N_HEADS, 2, HEAD_DIM)
    v = kv[..., QK_WIDTH:].reshape(bsz, seqlen, N_HEADS, V_DIM)
    k1 = jnp.transpose(k[..., 0, :], (0, 2, 1, 3))
    k2 = jnp.transpose(k[..., 1, :], (0, 2, 1, 3))
    v = jnp.transpose(v, (0, 2, 1, 3))
    return k1, k2, v


def _t5_bucket(rel):
    n = jnp.maximum(rel, 0)
    max_exact = NUM_BUCKETS // 2
    large = max_exact + (jnp.log(jnp.maximum(n, max_exact).astype(jnp.float32) / max_exact)
                         / math.log(MAX_DISTANCE / max_exact)
                         * (NUM_BUCKETS - max_exact)).astype(jnp.int32)
    large = jnp.minimum(large, NUM_BUCKETS - 1)
    return jnp.where(n < max_exact, n, large)


def _block_probs(q, k, bias, causal, scale):
    s = jnp.einsum('bhqd,bhkd->bhqk', q, k).astype(jnp.float32) * scale + bias
    return jax.nn.softmax(jnp.where(causal, s, NEG_INF), axis=-1)


def _diff_attention_mixer(h, k1, k2, v, w_q, lq1, lk1, lq2, lk2, head_norm, w_o,
                          rel_bias, lam_init):
    bsz, seqlen, _ = h.shape
    q = (h @ w_q).reshape(bsz, seqlen, N_HEADS, 2, HEAD_DIM)
    q1 = jnp.transpose(q[..., 0, :], (0, 2, 1, 3))
    q2 = jnp.transpose(q[..., 1, :], (0, 2, 1, 3))
    lam = (jnp.exp(jnp.sum(lq1.astype(jnp.float32) * lk1.astype(jnp.float32)))
           - jnp.exp(jnp.sum(lq2.astype(jnp.float32) * lk2.astype(jnp.float32)))
           + lam_init)
    scale = HEAD_DIM ** -0.5
    table = rel_bias.astype(jnp.float32)
    blocks = []
    for start in range(0, seqlen, Q_BLOCK):
        end = start + Q_BLOCK
        rel = jnp.arange(start, end)[:, None] - jnp.arange(end)[None, :]
        causal = rel >= 0
        bias = jnp.transpose(table[_t5_bucket(rel)], (2, 0, 1))
        p1 = _block_probs(q1[:, :, start:end], k1[:, :, :end], bias, causal, scale)
        p2 = _block_probs(q2[:, :, start:end], k2[:, :, :end], bias, causal, scale)
        w = p1 - lam * p2
        blocks.append(jnp.einsum('bhqk,bhkv->bhqv', w, v[:, :, :end].astype(jnp.float32)))
    o = jnp.concatenate(blocks, axis=2)
    o = o * lax.rsqrt(jnp.mean(o * o, axis=-1, keepdims=True) + NORM_EPS)
    o = o * head_norm.astype(jnp.float32) * (1.0 - lam_init)
    o = jnp.transpose(o, (0, 2, 1, 3)).reshape(bsz, seqlen, V_WIDTH).astype(h.dtype)
    return o @ w_o


def setup_inputs(seed: int = 0) -> dict:
    key = jax.random.key(seed)
    ks = jax.random.split(key, 32)
    f32 = jnp.float32

    def nrm(k, shape, scale):
        return jax.random.normal(k, shape, f32) * scale

    def gain(k, shape):
        return 1.0 + nrm(k, shape, 0.05)

    na, nb = N_SSM_LAYERS, N_ATTN_LAYERS
    x = nrm(ks[0], (BATCH, SEQ, D_MODEL), 1.0)
    norm_mixer_pre = gain(ks[1], (DEPTH, D_MODEL))
    norm_mixer_post = gain(ks[2], (DEPTH, D_MODEL))
    norm_mlp_pre = gain(ks[3], (DEPTH, D_MODEL))
    norm_mlp_post = gain(ks[4], (DEPTH, D_MODEL))
    mlp_w_up = nrm(ks[5], (DEPTH, D_MODEL, D_FF), D_MODEL ** -0.5)
    mlp_w_down = nrm(ks[6], (DEPTH, D_FF, D_MODEL), D_FF ** -0.5)
    ssm_w_in = nrm(ks[7], (na, D_MODEL, D_MODEL), D_MODEL ** -0.5)
    ssm_a_re = -0.5 + nrm(ks[8], (na, SSM_GROUPS, SSM_STATE), 0.01)
    ssm_a_im = (math.pi * jnp.arange(SSM_STATE, dtype=f32))[None, None, :] \
        + nrm(ks[9], (na, SSM_GROUPS, SSM_STATE), 0.01)
    ssm_log_dt = jax.random.uniform(ks[10], (na, SSM_GROUPS), f32,
                                    minval=math.log(DT_MIN), maxval=math.log(DT_MAX))
    ssm_b_re = nrm(ks[11], (na, SSM_GROUPS, SSM_STATE, SSM_GROUP), SSM_GROUP ** -0.5)
    ssm_b_im = nrm(ks[12], (na, SSM_GROUPS, SSM_STATE, SSM_GROUP), SSM_GROUP ** -0.5)
    ssm_c_re = nrm(ks[13], (na, SSM_GROUPS, SSM_GROUP, SSM_STATE), SSM_STATE ** -0.5)
    ssm_c_im = nrm(ks[14], (na, SSM_GROUPS, SSM_GROUP, SSM_STATE), SSM_STATE ** -0.5)
    ssm_d = nrm(ks[15], (na, D_MODEL), 1.0)
    ssm_w_glu = nrm(ks[16], (na, D_MODEL, 2 * D_MODEL), D_MODEL ** -0.5)
    kv_norm = gain(ks[17], (D_MODEL,))
    w_kv = nrm(ks[18], (D_MODEL, QK_WIDTH + V_WIDTH), D_MODEL ** -0.5)
    attn_w_q = nrm(ks[19], (nb, D_MODEL, QK_WIDTH), D_MODEL ** -0.5)
    attn_lambda_q1 = nrm(ks[20], (nb, HEAD_DIM), 0.1)
    attn_lambda_k1 = nrm(ks[21], (nb, HEAD_DIM), 0.1)
    attn_lambda_q2 = nrm(ks[22], (nb, HEAD_DIM), 0.1)
    attn_lambda_k2 = nrm(ks[23], (nb, HEAD_DIM), 0.1)
    attn_head_norm = gain(ks[24], (nb, V_DIM))
    attn_w_o = nrm(ks[25], (nb, V_WIDTH, D_MODEL), V_WIDTH ** -0.5)
    rel_bias = nrm(ks[26], (NUM_BUCKETS, N_HEADS), 0.3)
    return {"x": x,
            "norm_mixer_pre": norm_mixer_pre, "norm_mixer_post": norm_mixer_post,
            "norm_mlp_pre": norm_mlp_pre, "norm_mlp_post": norm_mlp_post,
            "mlp_w_up": mlp_w_up, "mlp_w_down": mlp_w_down,
            "ssm_w_in": ssm_w_in, "ssm_a_re": ssm_a_re, "ssm_a_im": ssm_a_im,
            "ssm_log_dt": ssm_log_dt, "ssm_b_re": ssm_b_re, "ssm_b_im": ssm_b_im,
            "ssm_c_re": ssm_c_re, "ssm_c_im": ssm_c_im, "ssm_d": ssm_d,
            "ssm_w_glu": ssm_w_glu,
            "kv_norm": kv_norm, "w_kv": w_kv,
            "attn_w_q": attn_w_q, "attn_lambda_q1": attn_lambda_q1,
            "attn_lambda_k1": attn_lambda_k1, "attn_lambda_q2": attn_lambda_q2,
            "attn_lambda_k2": attn_lambda_k2, "attn_head_norm": attn_head_norm,
            "attn_w_o": attn_w_o, "rel_bias": rel_bias}


def reference(x, norm_mixer_pre, norm_mixer_post, norm_mlp_pre, norm_mlp_post,
              mlp_w_up, mlp_w_down,
              ssm_w_in, ssm_a_re, ssm_a_im, ssm_log_dt, ssm_b_re, ssm_b_im,
              ssm_c_re, ssm_c_im, ssm_d, ssm_w_glu,
              kv_norm, w_kv,
              attn_w_q, attn_lambda_q1, attn_lambda_k1, attn_lambda_q2, attn_lambda_k2,
              attn_head_norm, attn_w_o, rel_bias):
    k1 = k2 = v = None
    for layer in range(DEPTH):
        h = _rms_norm(x, norm_mixer_pre[layer])
        if layer < N_SSM_LAYERS:
            i = layer
            mix = _s5_mixer(h, ssm_w_in[i], ssm_a_re[i], ssm_a_im[i], ssm_log_dt[i],
                            ssm_b_re[i], ssm_b_im[i], ssm_c_re[i], ssm_c_im[i],
                            ssm_d[i], ssm_w_glu[i])
        else:
            if layer == N_SSM_LAYERS:
                k1, k2, v = _shared_kv(x, kv_norm, w_kv)
            j = layer - N_SSM_LAYERS
            lam_init = 0.8 - 0.6 * math.exp(-0.3 * layer)
            mix = _diff_attention_mixer(h, k1, k2, v, attn_w_q[j],
                                        attn_lambda_q1[j], attn_lambda_k1[j],
                                        attn_lambda_q2[j], attn_lambda_k2[j],
                                        attn_head_norm[j], attn_w_o[j], rel_bias, lam_init)
        x = x + _rms_norm(mix, norm_mixer_post[layer])
        h = _rms_norm(x, norm_mlp_pre[layer])
        x = x + _rms_norm(_sq_relu_mlp(h, mlp_w_up[layer], mlp_w_down[layer]),
                          norm_mlp_post[layer])
    return x
```

```cpp
#include <hip/hip_runtime.h>
#include <hip/hip_cooperative_groups.h>
#include <cstdio>
#include <cstdint>
namespace cg = cooperative_groups;

#define LAS __attribute__((address_space(3)))
typedef unsigned short bf16_t;
typedef short bf16x8 __attribute__((ext_vector_type(8)));
typedef float f32x4 __attribute__((ext_vector_type(4)));
typedef float f32x16 __attribute__((ext_vector_type(16)));
typedef unsigned u32x4 __attribute__((ext_vector_type(4)));
typedef unsigned u32x2 __attribute__((ext_vector_type(2)));

constexpr int TOK = 32768, DM = 1024, FF = 4096, SEQ = 8192;
constexpr int NG = 64, GS = 16, NP = 64;
constexpr int CL = 32;
constexpr int NCH = TOK / CL;
constexpr int UGP = CL * GS + 2 * NP;
constexpr float EPS = 1e-6f;
constexpr float LOG2E = 1.4426950408889634f;

constexpr size_t MiB = 1u << 20;
constexpr size_t WS_BIAS = 0;
constexpr size_t WS_SCAL = 4096;
constexpr size_t WS_LAML = 8192;
constexpr size_t WS_BAR = 131072;
constexpr size_t WS_UP23 = 1 * MiB;
constexpr size_t WS_DN23 = 17 * MiB;
constexpr size_t WS_KVW = 33 * MiB;
constexpr size_t WS_QW = 37 * MiB;
constexpr size_t WS_OW = 41 * MiB;
constexpr size_t WS_UP01 = 45 * MiB;
constexpr size_t WS_DN01 = 61 * MiB;
constexpr size_t WS_WIN = 77 * MiB;
constexpr size_t WS_GLU = 81 * MiB;
constexpr size_t WS_TM = 89 * MiB;
constexpr size_t WS_SIN = 169 * MiB;
constexpr size_t WS_K = 45 * MiB;
constexpr size_t WS_VT = 109 * MiB;
constexpr size_t WS_HM = 186 * MiB;
constexpr size_t WS_ACT = 250 * MiB;
constexpr size_t WS_UG = WS_ACT;
constexpr size_t WS_Z = WS_ACT + 80 * MiB;
constexpr size_t WS_YG = WS_ACT + 112 * MiB;
constexpr size_t WS_Q = WS_ACT;
constexpr size_t WS_ON = WS_ACT + 64 * MiB;
constexpr size_t WS_HKV = WS_ACT + 128 * MiB;
constexpr size_t WS_OB = WS_ACT + 128 * MiB;
constexpr size_t WS_END = 506 * MiB;

constexpr int LDS_BYTES = 147456;
#ifndef REPEAT_MASK
#define REPEAT_MASK 0
#endif

__device__ __forceinline__ unsigned cvt_pk_bf16(float lo, float hi) { unsigned r; asm("v_cvt_pk_bf16_f32 %0, %1, %2" : "=v"(r) : "v"(lo), "v"(hi)); return r; }
__device__ __forceinline__ float bf_lo(unsigned w) { return __uint_as_float(w << 16); }
__device__ __forceinline__ float bf_hi(unsigned w) { return __uint_as_float(w & 0xffff0000u); }
__device__ __forceinline__ float fexp2(float x) { return __builtin_amdgcn_exp2f(x); }
__device__ __forceinline__ float frcp(float x) { return __builtin_amdgcn_rcpf(x); }
__device__ __forceinline__ float max3f(float a, float b, float c) { float r; asm("v_max3_f32 %0, %1, %2, %3" : "=v"(r) : "v"(a), "v"(b), "v"(c)); return r; }
__device__ __forceinline__ float max2f(float a, float b) { float r; asm("v_max_f32_e32 %0, %1, %2" : "=v"(r) : "v"(a), "v"(b)); return r; }
__device__ __forceinline__ int opaque_tid() { int t_ = threadIdx.x; asm volatile("" : "+v"(t_)); return t_; }
__device__ __forceinline__ float wave_sum(float v) {
#pragma unroll
    for (int o = 32; o >= 1; o >>= 1) v += __shfl_xor(v, o);
    return v;
}
__device__ __forceinline__ float gelu_tanh(float y) {
    const float t = y * (1.5957691216057308f + 0.07135481627f * y * y);
    return y * frcp(1.0f + fexp2(-t * LOG2E));
}

namespace pg8 {
constexpr int BM = 256, BK = 64, HALF = 128, HTB = HALF * BK * 2, STAGE_BYTES = 8 * HTB;
__host__ __device__ __forceinline__ int lds_byte(int r, int c) { const int st = (r >> 4) * 2 + (c >> 5), rr = r & 15, cc = c & 31, ob = rr * 64 + cc * 2; return st * 1024 + (ob ^ (((ob >> 9) & 1) << 5)); }
__host__ __device__ __forceinline__ void stage_rc(int b, int& R, int& C) { const int st = b / 1024, sb = b % 1024, swz = sb ^ (((sb >> 9) & 1) << 5); R = (st >> 1) * 16 + swz / 64; C = (st & 1) * 32 + (swz % 64) / 2; }
__host__ __device__ __forceinline__ int perm32(int rho) { const int n = rho >> 4, i = rho & 15; return 8 * (i >> 2) + 4 * n + (i & 3); }

struct Unit { int pm, pn, arow, brow; };
enum { ORD_STATIC = 0, ORD_Z = 1, ORD_Y = 2 };
enum { EPI_STORE = 0, EPI_RELU2 = 1, EPI_GLU = 2, EPI_UG = 3, EPI_Z = 4, EPI_Y = 5, EPI_VT = 6 };
struct Job { const bf16_t* A; const bf16_t* Bt; int lda, ldb, K, ord, M, N, epi, ldc; float scale; void* O; const void* x1; const void* x2; };

__device__ __forceinline__ bool next_unit(const Job& jb, int G, int bx, int vc, int i, Unit& u) {
    if (jb.ord == ORD_STATIC) {
        const int nM = jb.M / BM, nN = jb.N / BM, nwg = nM * nN;
        const long L = (long)i * G + bx; if (L >= nwg) return false;
        int wgid = (int)L; { const int q = nwg / 8, r = nwg % 8, xcd = wgid % 8, off = wgid / 8; wgid = (xcd < r ? xcd * (q + 1) : r * (q + 1) + (xcd - r) * q) + off; }
        const int nig = 8 * nN, gid = wgid / nig, fm = gid * 8, gsz = (nM - fm) < 8 ? (nM - fm) : 8;
        u.pm = fm + ((wgid % nig) % gsz); u.pn = (wgid % nig) / gsz; u.arow = u.pm * BM; u.brow = u.pn * BM; return true;
    } else if (jb.ord == ORD_Z) {
        const int L = i * G + vc; if (L >= NG * 4) return false; u.pm = L; u.pn = 0; u.arow = L * BM; u.brow = (L >> 2) * 128; return true;
    } else {
        const int L = i * G + vc; if (L >= NG * 8) return false; const int g = L >> 3, r = L & 7; u.pm = g * 4 + (r >> 1); u.pn = g * 2 + (r & 1); u.arow = u.pm * BM; u.brow = u.pn * BM; return true;
    }
}

typedef f32x4 Acc[2][2][4][2];
__device__ __forceinline__ u32x4 pack8(const f32x4 v0, const f32x4 v1) { u32x4 w; w.x = cvt_pk_bf16(v0[0], v0[1]); w.y = cvt_pk_bf16(v0[2], v0[3]); w.z = cvt_pk_bf16(v1[0], v1[1]); w.w = cvt_pk_bf16(v1[2], v1[3]); return w; }

__device__ __forceinline__ void epilogue(const Job& jb, const Acc& acc, const Unit& u) {
    int t_ = threadIdx.x; asm volatile("" : "+v"(t_));
    const int wid_ = __builtin_amdgcn_readfirstlane(t_ >> 6), wr = wid_ >> 2, wc = wid_ & 3, fr = t_ & 15, fq = (t_ & 63) >> 4;
    const int row0 = u.pm * BM + wr * 64 + fr;
#ifdef EPI_MASK
    const int epi_ = ((1 << jb.epi) & EPI_MASK) ? jb.epi : 0;
#else
    const int epi_ = jb.epi;
#endif
    if (epi_ == EPI_STORE || epi_ == EPI_RELU2) {
        bf16_t* O = (bf16_t*)jb.O; const int col0 = u.pn * BM + wc * 32 + 8 * fq; const bool r2 = epi_ == EPI_RELU2; const float scale = jb.scale;
#pragma unroll
        for (int ai = 0; ai < 2; ++ai)
#pragma unroll
            for (int m = 0; m < 4; ++m) { bf16_t* rowp = O + (size_t)(row0 + ai * HALF + m * 16) * jb.ldc + col0;
#pragma unroll
                for (int bj = 0; bj < 2; ++bj) { f32x4 v0 = acc[ai][bj][m][0], v1 = acc[ai][bj][m][1];
                    if (r2) {
#pragma unroll
                        for (int e = 0; e < 4; ++e) { const float a = fmaxf(v0[e], 0.f), b = fmaxf(v1[e], 0.f); v0[e] = a * a; v1[e] = b * b; } }
                    v0 = v0 * scale; v1 = v1 * scale;
                    *(u32x4*)(rowp + bj * HALF) = pack8(v0, v1); } }
    } else if (epi_ == EPI_GLU) {
        bf16_t* O = (bf16_t*)jb.O; const int col0 = u.pn * HALF + wc * 32 + 8 * fq;
#pragma unroll
        for (int ai = 0; ai < 2; ++ai)
#pragma unroll
            for (int m = 0; m < 4; ++m) { bf16_t* rowp = O + (size_t)(row0 + ai * HALF + m * 16) * DM + col0;
                f32x4 o0, o1;
#pragma unroll
                for (int e = 0; e < 4; ++e) { o0[e] = acc[ai][0][m][0][e] * frcp(1.0f + fexp2(-acc[ai][1][m][0][e] * LOG2E)); o1[e] = acc[ai][0][m][1][e] * frcp(1.0f + fexp2(-acc[ai][1][m][1][e] * LOG2E)); }
                *(u32x4*)rowp = pack8(o0, o1); }
    } else if (epi_ == EPI_UG) {
        bf16_t* Ug = (bf16_t*)jb.O;
#pragma unroll
        for (int ai = 0; ai < 2; ++ai)
#pragma unroll
            for (int m = 0; m < 4; ++m) { const int tok = row0 + ai * HALF + m * 16;
#pragma unroll
                for (int bj = 0; bj < 2; ++bj) { const int g = u.pn * 16 + bj * 8 + wc * 2 + (fq >> 1);
                    *(u32x4*)(Ug + ((size_t)(g * NCH + (tok >> 5)) * UGP + (tok & 31) * 16 + (fq & 1) * 8)) = pack8(acc[ai][bj][m][0], acc[ai][bj][m][1]); } }
    } else if (epi_ == EPI_Z) {
        float* Z = (float*)jb.O; const int col0 = wc * 32 + 8 * fq;
#pragma unroll
        for (int ai = 0; ai < 2; ++ai)
#pragma unroll
            for (int m = 0; m < 4; ++m) { float* p = Z + (size_t)(row0 + ai * HALF + m * 16) * 128 + col0;
                *(f32x4*)p = acc[ai][0][m][0]; *(f32x4*)(p + 4) = acc[ai][0][m][1]; }
    } else if (epi_ == EPI_VT) {
        bf16_t* O = (bf16_t*)jb.O; const int col0 = u.pn * BM + wc * 32 + 8 * fq;
#pragma unroll
        for (int ai = 0; ai < 2; ++ai)
#pragma unroll
            for (int m = 0; m < 4; ++m) { const int row = row0 + ai * HALF + m * 16;
#pragma unroll
                for (int bj = 0; bj < 2; ++bj) { const int col = col0 + bj * HALF;
                    const size_t off = ((size_t)(((col >> 13) * 8 + (row >> 7)) * 128 + ((col & 8191) >> 6)) << 13) + (row & 127) * 64 + (col & 63);
                    *(u32x4*)(O + off) = pack8(acc[ai][bj][m][0], acc[ai][bj][m][1]); } }
    } else {
        const bf16_t* Ug = (const bf16_t*)jb.x1; const float* dsk = (const float*)jb.x2; bf16_t* YG = (bf16_t*)jb.O;
        const int g = u.pm >> 2, n0 = (u.pm & 3) * BM + wr * 64 + fr, c0 = (u.pn & 1) * BM + wc * 32 + 8 * fq;
        const int co0 = (fq & 1) * 8;
        const f32x4 d0 = *(const f32x4*)(dsk + g * 16 + co0), d1 = *(const f32x4*)(dsk + g * 16 + co0 + 4);
#pragma unroll
        for (int ai = 0; ai < 2; ++ai)
#pragma unroll
            for (int m = 0; m < 4; ++m) { const int n = n0 + ai * HALF + m * 16;
#pragma unroll
                for (int bj = 0; bj < 2; ++bj) { const int cc = c0 + bj * HALF, j = cc >> 4;
                    const u32x4 uu = *(const u32x4*)(Ug + ((size_t)(g * NCH + n) * UGP + cc));
                    const f32x4 v0 = acc[ai][bj][m][0], v1 = acc[ai][bj][m][1];
                    f32x4 y0, y1;
                    y0[0] = v0[0] + d0[0] * bf_lo(uu.x); y0[1] = v0[1] + d0[1] * bf_hi(uu.x); y0[2] = v0[2] + d0[2] * bf_lo(uu.y); y0[3] = v0[3] + d0[3] * bf_hi(uu.y);
                    y1[0] = v1[0] + d1[0] * bf_lo(uu.z); y1[1] = v1[1] + d1[1] * bf_hi(uu.z); y1[2] = v1[2] + d1[2] * bf_lo(uu.w); y1[3] = v1[3] + d1[3] * bf_hi(uu.w);
#pragma unroll
                    for (int e = 0; e < 4; ++e) { y0[e] = gelu_tanh(y0[e]); y1[e] = gelu_tanh(y1[e]); }
                    *(u32x4*)(YG + ((size_t)(n * CL + j) * DM + g * 16 + co0)) = pack8(y0, y1); } }
    }
}

__device__ __forceinline__ void gemm_phase(LAS unsigned char* lds, const Job& g, const int G, const int bx, const int vc, const int tid_unused) {
    const int tid = opaque_tid(); (void)tid_unused;
    const int wid = __builtin_amdgcn_readfirstlane(tid >> 6), lane = tid & 63, wr = wid >> 2, wc = wid & 3, fr = lane & 15, fq = lane >> 4;
    const int K = g.K, nt = K / BK;
    unsigned voffA[2], voffB[2];
#pragma unroll
    for (int i = 0; i < 2; ++i) { int R, C; stage_rc(tid * 16 + i * 8192, R, C); const int Rb = (R & ~31) + perm32(R & 31);
        voffA[i] = (unsigned)(R * g.lda + C) * 2u; voffB[i] = (unsigned)(Rb * g.ldb + C) * 2u; }
    const size_t kstep = (size_t)(BK * 2);
    const size_t hstepA = (size_t)HALF * g.lda * 2, hstepB = (size_t)HALF * g.ldb * 2;
    const size_t rowA = (size_t)g.lda * 2, rowB = (size_t)g.ldb * 2;
    const unsigned ldsw = (unsigned)wid * 1024u;
    const int aoff = lds_byte(wr * 64 + fr, fq * 8), boff = lds_byte(wc * 32 + fr, fq * 8);
#define PG8_SA(b, h) (((b) * 2 + (h)) * HTB)
#define PG8_SB(b, h) ((4 + (b) * 2 + (h)) * HTB)
#define PG8_STAGE(bufoff, gbase, voff) do { _Pragma("unroll") for (int _i = 0; _i < 2; ++_i) \
        __builtin_amdgcn_global_load_lds((const unsigned*)((const char*)(gbase) + (voff)[_i]), (LAS unsigned*)(lds + (bufoff) + ldsw + _i * 8192), 16, 0, 0); } while (0)
#define PG8_LDA(dst, b, h) do { _Pragma("unroll") for (int m = 0; m < 4; ++m) _Pragma("unroll") for (int k = 0; k < 2; ++k) dst[m][k] = *(const LAS bf16x8*)(lds + PG8_SA(b, h) + aoff + m * 2048 + k * 1024); } while (0)
#define PG8_LDB(dst, b, h) do { _Pragma("unroll") for (int n = 0; n < 2; ++n) _Pragma("unroll") for (int k = 0; k < 2; ++k) dst[n][k] = *(const LAS bf16x8*)(lds + PG8_SB(b, h) + boff + n * 2048 + k * 1024); } while (0)
#define PG8_MMA(ai, bj, At, Bt) do { __builtin_amdgcn_s_setprio(1); _Pragma("unroll") for (int m = 0; m < 4; ++m) _Pragma("unroll") for (int n = 0; n < 2; ++n) _Pragma("unroll") for (int k = 0; k < 2; ++k) \
        acc[ai][bj][m][n] = __builtin_amdgcn_mfma_f32_16x16x32_bf16(Bt[n][k], At[m][k], acc[ai][bj][m][n], 0, 0, 0); __builtin_amdgcn_s_setprio(0); } while (0)
#define PG8_WAIT_V(n) asm volatile("s_waitcnt vmcnt(" #n ")" ::: "memory")
#define PG8_WAIT_L(n) asm volatile("s_waitcnt lgkmcnt(" #n ")" ::: "memory")
#define PG8_BAR __builtin_amdgcn_s_barrier()
#define PG8_SCHED __builtin_amdgcn_sched_barrier(0)
    Unit cur, nxt; int ui = 0;
    if (!next_unit(g, G, bx, vc, 0, cur)) return;
    Acc acc;
#pragma unroll
    for (int a = 0; a < 2; ++a)
#pragma unroll
        for (int b = 0; b < 2; ++b)
#pragma unroll
            for (int m = 0; m < 4; ++m)
#pragma unroll
                for (int n = 0; n < 2; ++n) acc[a][b][m][n] = (f32x4){0.f, 0.f, 0.f, 0.f};
    bf16x8 At[4][2], B0[2][2], B1[2][2];
    const char* cA = (const char*)g.A + (size_t)cur.arow * rowA; const char* cB = (const char*)g.Bt + (size_t)cur.brow * rowB;
    PG8_STAGE(PG8_SB(0, 0), cB, voffB); PG8_STAGE(PG8_SB(0, 1), cB + hstepB, voffB); PG8_STAGE(PG8_SA(0, 0), cA, voffA); PG8_STAGE(PG8_SA(0, 1), cA + hstepA, voffA);
    if (wr == 1) PG8_BAR;
    PG8_WAIT_V(2); PG8_BAR;
    PG8_STAGE(PG8_SB(1, 0), cB + kstep, voffB); PG8_STAGE(PG8_SA(1, 0), cA + kstep, voffA); PG8_STAGE(PG8_SB(1, 1), cB + hstepB + kstep, voffB);
    PG8_WAIT_V(6); PG8_BAR;
    for (;;) {
        const bool has_next = next_unit(g, G, bx, vc, ui + 1, nxt);
        const char* nA = has_next ? (const char*)g.A + (size_t)nxt.arow * rowA : cA; const char* nB = has_next ? (const char*)g.Bt + (size_t)nxt.brow * rowB : cB;
        for (int t = 0; t < nt; t += 2) {
            const bool last = (t == nt - 2);
            const char* a1 = cA + (size_t)(t + 1) * kstep;
            const char* a2 = last ? nA : cA + (size_t)(t + 2) * kstep; const char* b2 = last ? nB : cB + (size_t)(t + 2) * kstep;
            const char* a3 = a2 + kstep; const char* b3 = b2 + kstep;
            PG8_LDB(B0, 0, 0); PG8_LDB(B1, 0, 1); PG8_SCHED; PG8_LDA(At, 0, 0); PG8_STAGE(PG8_SA(1, 1), a1 + hstepA, voffA);
            PG8_WAIT_V(8); PG8_WAIT_L(0); PG8_BAR; PG8_MMA(0, 0, At, B0); PG8_MMA(0, 1, At, B1); PG8_BAR; PG8_SCHED;
            PG8_LDA(At, 0, 1); PG8_STAGE(PG8_SB(0, 0), b2, voffB); PG8_STAGE(PG8_SB(0, 1), b2 + hstepB, voffB); PG8_STAGE(PG8_SA(0, 0), a2, voffA);
            PG8_WAIT_V(8); PG8_WAIT_L(0); PG8_BAR; PG8_MMA(1, 0, At, B0); PG8_MMA(1, 1, At, B1); PG8_BAR; PG8_SCHED;
            PG8_LDB(B0, 1, 0); PG8_LDB(B1, 1, 1); PG8_SCHED; PG8_LDA(At, 1, 0); PG8_STAGE(PG8_SA(0, 1), a2 + hstepA, voffA);
            PG8_WAIT_V(8); PG8_WAIT_L(0); PG8_BAR; PG8_MMA(0, 0, At, B0); PG8_MMA(0, 1, At, B1); PG8_BAR; PG8_SCHED;
            PG8_LDA(At, 1, 1); PG8_STAGE(PG8_SB(1, 0), b3, voffB); PG8_STAGE(PG8_SB(1, 1), b3 + hstepB, voffB); PG8_STAGE(PG8_SA(1, 0), a3, voffA);
            PG8_WAIT_V(8); PG8_WAIT_L(0); PG8_BAR; PG8_MMA(1, 0, At, B0); PG8_MMA(1, 1, At, B1); PG8_BAR; PG8_SCHED;
        }
        if (wr == 0) PG8_BAR;
        epilogue(g, acc, cur);
        if (!has_next) break;
#pragma unroll
        for (int a = 0; a < 2; ++a)
#pragma unroll
            for (int b = 0; b < 2; ++b)
#pragma unroll
                for (int m = 0; m < 4; ++m)
#pragma unroll
                    for (int n = 0; n < 2; ++n) acc[a][b][m][n] = (f32x4){0.f, 0.f, 0.f, 0.f};
        cur = nxt; cA = nA; cB = nB; ++ui;
        if (wr == 1) PG8_BAR;
    }
    PG8_WAIT_V(0);
    PG8_BAR;
#undef PG8_SA
#undef PG8_SB
#undef PG8_STAGE
#undef PG8_LDA
#undef PG8_LDB
#undef PG8_MMA
#undef PG8_WAIT_V
#undef PG8_WAIT_L
#undef PG8_BAR
#undef PG8_SCHED
}
}

#define XB_TMO      128
#define XB_XCNT(j)  (256  + 64 * (j))
#define XB_XSUB(j)  (1280 + 64 * (j))
#define XB_XGEN(j)  (2304 + 64 * (j))
#define XB_TOP      3328
#define XB_TOPGEN   3392
#define XCD_BAR_WORDS 3456
#define XB_SPIN_CAP (1u << 22)
__device__ __forceinline__ unsigned xb_ld(unsigned* p)              { return __hip_atomic_load(p, __ATOMIC_RELAXED, __HIP_MEMORY_SCOPE_AGENT); }
__device__ __forceinline__ unsigned xb_add(unsigned* p, unsigned v) { return __hip_atomic_fetch_add(p, v, __ATOMIC_RELAXED, __HIP_MEMORY_SCOPE_AGENT); }
__device__ __forceinline__ unsigned xb_xcc_id() { return (unsigned)__builtin_amdgcn_s_getreg((3 << 11) | 20) & 0xFu; }
#define XB_SPIN(cond, bar) do { unsigned _sp = 0; while (cond) { __builtin_amdgcn_s_sleep(1); \
    if ((++_sp & 255u) == 0u) { if (xb_ld(&(bar)[XB_TMO])) break; if (_sp > XB_SPIN_CAP) { atomicAdd(&(bar)[XB_TMO], 1u); break; } } } } while (0)
struct XcdBarrier { unsigned* bar; unsigned x; volatile LAS unsigned* st; };
__device__ __forceinline__ XcdBarrier xcd_barrier_post(unsigned* bar, volatile LAS unsigned* st) {
    XcdBarrier b; b.bar = bar; b.x = xb_xcc_id(); b.st = st;
    if (threadIdx.x == 0) (void)xb_add(&bar[XB_XCNT(b.x)], 1u);
    return b;
}
__device__ __forceinline__ void xcd_barrier_complete(unsigned* bar, unsigned x, unsigned& nloc, unsigned& nx) {
    const unsigned G = gridDim.x * gridDim.y * gridDim.z;
    unsigned sum, cnt, mine, sp = 0u;
    for (;;) {
        sum = 0u; cnt = 0u; mine = 0u;
#pragma unroll
        for (unsigned j = 0; j < 16; ++j) { const unsigned c = xb_ld(&bar[XB_XCNT(j)]); sum += c; cnt += (c > 0u) ? 1u : 0u; mine = (j == x) ? c : mine; }
        if (sum == G) break;
        __builtin_amdgcn_s_sleep(1);
        if ((++sp & 255u) == 0u) { if (xb_ld(&bar[XB_TMO])) break; if (sp > XB_SPIN_CAP) { atomicAdd(&bar[XB_TMO], 1u); break; } }
    }
    nloc = mine > 0u ? mine : 1u; nx = cnt > 0u ? cnt : 1u;
}
__device__ __forceinline__ void xcd_barrier(const XcdBarrier& b) {
    asm volatile("s_waitcnt vmcnt(0)" ::: "memory");
    __syncthreads();
    if (threadIdx.x == 0) {
        unsigned* bar = b.bar;
        __builtin_amdgcn_s_waitcnt(0);
        unsigned nloc = b.st[0], nx = b.st[1];
        if (nloc == 0u) { xcd_barrier_complete(bar, b.x, nloc, nx); b.st[0] = nloc; b.st[1] = nx; }
        const unsigned old = xb_add(&bar[XB_XSUB(b.x)], 1u);
        const unsigned gen = old / nloc;
        if (old + 1u == (gen + 1u) * nloc) {
            __builtin_amdgcn_fence(__ATOMIC_RELEASE, "agent");
            asm volatile("s_waitcnt vmcnt(0)" ::: "memory");
            const unsigned og = xb_add(&bar[XB_TOP], 1u);
            const unsigned tg = og / nx;
            if (og + 1u == (tg + 1u) * nx) xb_add(&bar[XB_TOPGEN], 1u);
            else XB_SPIN(xb_ld(&bar[XB_TOPGEN]) == tg, bar);
            __builtin_amdgcn_fence(__ATOMIC_ACQUIRE, "agent");
            xb_add(&bar[XB_XGEN(b.x)], 1u);
            asm volatile("s_waitcnt vmcnt(0)" ::: "memory");
        } else {
            XB_SPIN(xb_ld(&bar[XB_XGEN(b.x)]) == gen, bar);
            __builtin_amdgcn_fence(__ATOMIC_ACQUIRE, "agent");
            asm volatile("s_waitcnt vmcnt(0)" ::: "memory");
        }
    }
    __syncthreads();
}

struct Params {
    const float* in[27];
    float* out;
    unsigned char* ws;
};

struct Ctx { LAS unsigned char* lds; int tid, lane, wid, G, bx, vc; };

__device__ __forceinline__ bool wdesc(int i, const Params& p, const float*& src, bf16_t*& dst, int& K, int& N, int& glu) {
    unsigned char* ws = p.ws; glu = 0;
    if (i < 4) { src = p.in[5] + (size_t)i * DM * FF; dst = (bf16_t*)(ws + (i < 2 ? WS_UP01 : WS_UP23)) + (size_t)(i & 1) * DM * FF; K = DM; N = FF; return true; }
    if (i < 8) { const int l = i - 4; src = p.in[6] + (size_t)l * DM * FF; dst = (bf16_t*)(ws + (l < 2 ? WS_DN01 : WS_DN23)) + (size_t)(l & 1) * DM * FF; K = FF; N = DM; return true; }
    if (i < 10) { const int l = i - 8; src = p.in[7] + (size_t)l * DM * DM; dst = (bf16_t*)(ws + WS_WIN) + (size_t)l * DM * DM; K = DM; N = DM; return true; }
    if (i < 12) { const int l = i - 10; src = p.in[16] + (size_t)l * DM * 2 * DM; dst = (bf16_t*)(ws + WS_GLU) + (size_t)l * DM * 2 * DM; K = DM; N = 2 * DM; glu = 1; return true; }
    if (i < 13) { src = p.in[18]; dst = (bf16_t*)(ws + WS_KVW); K = DM; N = 2 * DM; return true; }
    if (i < 15) { const int l = i - 13; src = p.in[19] + (size_t)l * DM * DM; dst = (bf16_t*)(ws + WS_QW) + (size_t)l * DM * DM; K = DM; N = DM; return true; }
    if (i < 17) { const int l = i - 15; src = p.in[25] + (size_t)l * DM * DM; dst = (bf16_t*)(ws + WS_OW) + (size_t)l * DM * DM; K = DM; N = DM; return true; }
    return false;
}
__device__ __forceinline__ bool wlocate(int f, const Params& p, const float*& src, bf16_t*& dst, int& K, int& N, int& n0, int& k0, int& sc0) {
    int base = 0;
    for (int i = 0; ; ++i) {
        int glu;
        if (!wdesc(i, p, src, dst, K, N, glu)) return false;
        const int ntk = K >> 6, nt = ntk * (N >> 6);
        if (f < base + nt) { const int t = f - base; n0 = (t / ntk) << 6; k0 = (t % ntk) << 6;
            sc0 = glu ? (((n0 >> 7) & 1) * DM + (n0 >> 8) * 128 + (n0 & 127)) : n0; return true; }
        base += nt;
    }
}
constexpr int NCONV_TILES = 11264;
__device__ void convert_weights(const Ctx& c, const Params& p) {
    LAS float* T = (LAS float*)c.lds;
    int f, fstep, fend;
    if (c.G == 256) { if (c.bx < 128) { f = c.bx; fstep = 128; fend = 128 * 38; } else { f = 128 * 38 + (c.bx - 128); fstep = 128; fend = NCONV_TILES; } }
    else { f = c.bx; fstep = c.G; fend = NCONV_TILES; }
    const float* src; bf16_t* dst; int K, N, n0, k0, sc0;
    bool have = (f < fend) && wlocate(f, p, src, dst, K, N, n0, k0, sc0);
    f32x4 v0, v1;
    const int ctid = opaque_tid(); const int kk = ctid >> 4, c4 = (ctid & 15) * 4;
    if (have) { v0 = *(const f32x4*)(src + (size_t)(k0 + kk) * N + sc0 + c4); v1 = *(const f32x4*)(src + (size_t)(k0 + 32 + kk) * N + sc0 + c4); }
    int par = 0;
    while (have) {
        const f32x4 a0 = v0, a1 = v1; bf16_t* cdst = dst; const int cK = K, cn0 = n0, ck0 = k0;
        f += fstep;
        have = (f < fend) && wlocate(f, p, src, dst, K, N, n0, k0, sc0);
        if (have) { v0 = *(const f32x4*)(src + (size_t)(k0 + kk) * N + sc0 + c4); v1 = *(const f32x4*)(src + (size_t)(k0 + 32 + kk) * N + sc0 + c4); }
        LAS float* Tb = T + par * (64 * 65);
        Tb[(c4 + 0) * 65 + kk] = a0[0]; Tb[(c4 + 1) * 65 + kk] = a0[1]; Tb[(c4 + 2) * 65 + kk] = a0[2]; Tb[(c4 + 3) * 65 + kk] = a0[3];
        Tb[(c4 + 0) * 65 + 32 + kk] = a1[0]; Tb[(c4 + 1) * 65 + 32 + kk] = a1[1]; Tb[(c4 + 2) * 65 + 32 + kk] = a1[2]; Tb[(c4 + 3) * 65 + 32 + kk] = a1[3];
        __syncthreads();
        { const int nn = ctid >> 3, k8 = (ctid & 7) * 8; const LAS float* r = Tb + nn * 65 + k8;
          u32x4 w; w.x = cvt_pk_bf16(r[0], r[1]); w.y = cvt_pk_bf16(r[2], r[3]); w.z = cvt_pk_bf16(r[4], r[5]); w.w = cvt_pk_bf16(r[6], r[7]);
          *(u32x4*)(cdst + (size_t)(cn0 + nn) * cK + ck0 + k8) = w; }
        par ^= 1;
    }
    __syncthreads();
}

__device__ void ssm_tables(const Ctx& c, const Params& p, int layer, int g) {
    LAS float* lamp = (LAS float*)c.lds;
    LAS float* bbar = lamp + 33 * 64 * 2;
    LAS float* ccp = bbar + 64 * 16 * 2;
    LAS float* Kt = ccp + 16 * 64 * 2;
    LAS float* coef = Kt + 32 * 256;
    const int tid = opaque_tid();
    const size_t lg = (size_t)layer * NG + g;
    if (tid < 64) {
        const int pp = tid;
        const float dt = expf(p.in[10][lg]);
        const float lr = p.in[8][lg * NP + pp], li = p.in[9][lg * NP + pp];
        const float mag = expf(lr * dt), ar = mag * cosf(li * dt), ai = mag * sinf(li * dt);
        const float den = lr * lr + li * li;
        coef[pp * 2] = ((ar - 1.0f) * lr + ai * li) / den; coef[pp * 2 + 1] = (ai * lr - (ar - 1.0f) * li) / den;
        float pr = 1.0f, pi = 0.0f; asm volatile("" : "+v"(pr), "+v"(pi));
        for (int k = 0; k <= 32; ++k) { lamp[(k * 64 + pp) * 2] = pr; lamp[(k * 64 + pp) * 2 + 1] = pi; const float nr = pr * ar - pi * ai, ni = pr * ai + pi * ar; pr = nr; pi = ni; }
        float* lamL = (float*)(p.ws + WS_LAML) + (lg * NP + pp) * 2;
        lamL[0] = lamp[(32 * 64 + pp) * 2]; lamL[1] = lamp[(32 * 64 + pp) * 2 + 1];
    }
    __syncthreads();
    for (int e = tid; e < 1024; e += 512) {
        const int pp = e >> 4, cc = e & 15;
        const float br = p.in[11][lg * 1024 + e], bi = p.in[12][lg * 1024 + e], cr = coef[pp * 2], ci = coef[pp * 2 + 1];
        bbar[e * 2] = cr * br - ci * bi; bbar[e * 2 + 1] = cr * bi + ci * br;
        ccp[e * 2] = p.in[13][lg * 1024 + e]; ccp[e * 2 + 1] = p.in[14][lg * 1024 + e];
        (void)cc;
    }
    __syncthreads();
    {
        const int k = tid >> 4, co = tid & 15;
        float acc16[16];
#pragma unroll
        for (int q = 0; q < 16; ++q) acc16[q] = 0.f;
        for (int pp = 0; pp < 64; ++pp) {
            const float lr = lamp[(k * 64 + pp) * 2], li = lamp[(k * 64 + pp) * 2 + 1], cr = ccp[(co * 64 + pp) * 2], ci = ccp[(co * 64 + pp) * 2 + 1];
            const float wr = cr * lr - ci * li, wi = cr * li + ci * lr;
            const LAS f32x4* bb = (const LAS f32x4*)(bbar + pp * 32);
#pragma unroll
            for (int q = 0; q < 8; ++q) { const f32x4 b = bb[q]; acc16[2 * q] += wr * b[0] - wi * b[1]; acc16[2 * q + 1] += wr * b[2] - wi * b[3]; }
        }
#pragma unroll
        for (int q = 0; q < 16; ++q) Kt[(k * 16 + co) * 16 + q] = acc16[q];
    }
    __syncthreads();
    bf16_t* Tm = (bf16_t*)(p.ws + WS_TM) + (size_t)layer * NG * 512 * UGP + (size_t)g * 512 * UGP;
    for (int e = tid; e < 512 * 80; e += 512) {
        const int row = e / 80, ch = e % 80, j = row >> 4, co = row & 15;
        float v[8];
        if (ch < 64) { const int i = ch >> 1, ci0 = (ch & 1) * 8;
#pragma unroll
            for (int q = 0; q < 8; ++q) v[q] = (i <= j) ? Kt[((j - i) * 16 + co) * 16 + ci0 + q] : 0.f;
        } else { const int p0 = (ch - 64) * 8;
#pragma unroll
            for (int q = 0; q < 8; ++q) { const int pq = p0 + q, pp = pq & 63;
                const float lr = lamp[((j + 1) * 64 + pp) * 2], li = lamp[((j + 1) * 64 + pp) * 2 + 1], cr = ccp[(co * 64 + pp) * 2], ci = ccp[(co * 64 + pp) * 2 + 1];
                v[q] = pq < 64 ? (cr * lr - ci * li) : -(cr * li + ci * lr); }
        }
        u32x4 w; w.x = cvt_pk_bf16(v[0], v[1]); w.y = cvt_pk_bf16(v[2], v[3]); w.z = cvt_pk_bf16(v[4], v[5]); w.w = cvt_pk_bf16(v[6], v[7]);
        *(u32x4*)(Tm + (size_t)row * UGP + ch * 8) = w;
    }
    bf16_t* Sin = (bf16_t*)(p.ws + WS_SIN) + (size_t)layer * NG * 128 * 512 + (size_t)g * 128 * 512;
    for (int e = tid; e < 128 * 64; e += 512) {
        const int row = e >> 6, ch = e & 63, pp = row & 63, i = ch >> 1, ci0 = (ch & 1) * 8;
        const float lr = lamp[((31 - i) * 64 + pp) * 2], li = lamp[((31 - i) * 64 + pp) * 2 + 1];
        float v[8];
#pragma unroll
        for (int q = 0; q < 8; ++q) { const float br = bbar[(pp * 16 + ci0 + q) * 2], bi = bbar[(pp * 16 + ci0 + q) * 2 + 1]; v[q] = row < 64 ? (lr * br - li * bi) : (lr * bi + li * br); }
        u32x4 w; w.x = cvt_pk_bf16(v[0], v[1]); w.y = cvt_pk_bf16(v[2], v[3]); w.z = cvt_pk_bf16(v[4], v[5]); w.w = cvt_pk_bf16(v[6], v[7]);
        *(u32x4*)(Sin + (size_t)row * 512 + ch * 8) = w;
    }
    __syncthreads();
}

__device__ void small_tables(const Ctx& c, const Params& p) {
    float* bt = (float*)(p.ws + WS_BIAS);
    const int stid = opaque_tid();
    for (int e = stid; e < 8 * 128; e += 512) {
        const int h = e >> 7, n = e & 127;
        int bk = n;
        if (n >= 16) { const int th[16] = {16, 19, 21, 24, 27, 31, 35, 40, 46, 52, 59, 67, 77, 87, 99, 113}; bk = 15;
#pragma unroll
            for (int q = 0; q < 16; ++q) bk += (n >= th[q]) ? 1 : 0; }
        bt[e] = (p.in[26][bk * 8 + h] - p.in[26][31 * 8 + h]) * LOG2E;
    }
    if (stid < 2) {
        const int j = stid; float s1 = 0.f, s2 = 0.f;
        for (int q = 0; q < 64; ++q) { s1 += p.in[20][j * 64 + q] * p.in[21][j * 64 + q]; s2 += p.in[22][j * 64 + q] * p.in[23][j * 64 + q]; }
        const float li = 0.8f - 0.6f * expf(-0.3f * (float)(j + 2));
        float* sc = (float*)(p.ws + WS_SCAL) + j * 4;
        sc[0] = expf(s1) - expf(s2) + li; sc[1] = 1.0f - li; sc[2] = 0.f; sc[3] = 0.f;
    }
}

__device__ void norm_phase(const Ctx& c, const float* xin, float* xout, const bf16_t* mix, const float* gpost, const float* gpre, bf16_t* hout, const float* gkv, bf16_t* hkv) {
    const int tid_ = opaque_tid(), lane = tid_ & 63, wid_ = __builtin_amdgcn_readfirstlane(tid_ >> 6);
    for (int r0 = (wid_ * c.G + c.bx) * 4; r0 < TOK; r0 += 8 * c.G * 4) {
        f32x4 xv[4][4]; u32x4 mw[4][2];
#pragma unroll
        for (int rr = 0; rr < 4; ++rr)
#pragma unroll
            for (int k = 0; k < 2; ++k) { const float* xp = xin + (size_t)(r0 + rr) * DM + k * 512 + lane * 8; xv[rr][2 * k] = *(const f32x4*)xp; xv[rr][2 * k + 1] = *(const f32x4*)(xp + 4); }
        if (mix) {
#pragma unroll
            for (int rr = 0; rr < 4; ++rr)
#pragma unroll
                for (int k = 0; k < 2; ++k) mw[rr][k] = *(const u32x4*)(mix + (size_t)(r0 + rr) * DM + k * 512 + lane * 8);
        }
#pragma unroll
        for (int rr = 0; rr < 4; ++rr) {
            const int row = r0 + rr;
            float x[16];
#pragma unroll
            for (int q = 0; q < 4; ++q)
#pragma unroll
                for (int e = 0; e < 4; ++e) x[q * 4 + e] = xv[rr][q][e];
            if (mix) {
                float mv[16]; float ss = 0.f;
#pragma unroll
                for (int k = 0; k < 2; ++k) { const u32x4 w = mw[rr][k];
                    mv[k * 8 + 0] = bf_lo(w.x); mv[k * 8 + 1] = bf_hi(w.x); mv[k * 8 + 2] = bf_lo(w.y); mv[k * 8 + 3] = bf_hi(w.y); mv[k * 8 + 4] = bf_lo(w.z); mv[k * 8 + 5] = bf_hi(w.z); mv[k * 8 + 6] = bf_lo(w.w); mv[k * 8 + 7] = bf_hi(w.w); }
#pragma unroll
                for (int e = 0; e < 16; ++e) ss += mv[e] * mv[e];
                ss = wave_sum(ss);
                const float rs = rsqrtf(ss * (1.0f / DM) + EPS);
#pragma unroll
                for (int k = 0; k < 2; ++k) { const float* gp = gpost + k * 512 + lane * 8; const f32x4 ga = *(const f32x4*)gp, gb = *(const f32x4*)(gp + 4);
#pragma unroll
                    for (int e = 0; e < 4; ++e) { x[k * 8 + e] += mv[k * 8 + e] * rs * ga[e]; x[k * 8 + 4 + e] += mv[k * 8 + 4 + e] * rs * gb[e]; }
                    float* xo = xout + (size_t)row * DM + k * 512 + lane * 8;
                    *(f32x4*)xo = (f32x4){x[k * 8 + 0], x[k * 8 + 1], x[k * 8 + 2], x[k * 8 + 3]}; *(f32x4*)(xo + 4) = (f32x4){x[k * 8 + 4], x[k * 8 + 5], x[k * 8 + 6], x[k * 8 + 7]}; }
            }
            if (gpre) {
                float ss = 0.f;
#pragma unroll
                for (int e = 0; e < 16; ++e) ss += x[e] * x[e];
                ss = wave_sum(ss);
                const float rs = rsqrtf(ss * (1.0f / DM) + EPS);
#pragma unroll
                for (int k = 0; k < 2; ++k) { const float* gp = gpre + k * 512 + lane * 8; const f32x4 ga = *(const f32x4*)gp, gb = *(const f32x4*)(gp + 4);
                    u32x4 w; w.x = cvt_pk_bf16(x[k * 8 + 0] * rs * ga[0], x[k * 8 + 1] * rs * ga[1]); w.y = cvt_pk_bf16(x[k * 8 + 2] * rs * ga[2], x[k * 8 + 3] * rs * ga[3]);
                    w.z = cvt_pk_bf16(x[k * 8 + 4] * rs * gb[0], x[k * 8 + 5] * rs * gb[1]); w.w = cvt_pk_bf16(x[k * 8 + 6] * rs * gb[2], x[k * 8 + 7] * rs * gb[3]);
                    *(u32x4*)(hout + (size_t)row * DM + k * 512 + lane * 8) = w;
                    if (gkv) { const float* kp = gkv + k * 512 + lane * 8; const f32x4 ka = *(const f32x4*)kp, kb = *(const f32x4*)(kp + 4);
                        u32x4 w2; w2.x = cvt_pk_bf16(x[k * 8 + 0] * rs * ka[0], x[k * 8 + 1] * rs * ka[1]); w2.y = cvt_pk_bf16(x[k * 8 + 2] * rs * ka[2], x[k * 8 + 3] * rs * ka[3]);
                        w2.z = cvt_pk_bf16(x[k * 8 + 4] * rs * kb[0], x[k * 8 + 5] * rs * kb[1]); w2.w = cvt_pk_bf16(x[k * 8 + 6] * rs * kb[2], x[k * 8 + 7] * rs * kb[3]);
                        *(u32x4*)(hkv + (size_t)row * DM + k * 512 + lane * 8) = w2; } }
            }
        }
    }
}

__device__ void scan_phase(const Ctx& c, const Params& p, int layer) {
    const float* Z = (const float*)(p.ws + WS_Z); bf16_t* Ug = (bf16_t*)(p.ws + WS_UG);
    const float* lamL = (const float*)(p.ws + WS_LAML) + (size_t)layer * NG * NP * 2;
    const int tid_ = opaque_tid(), wid_ = __builtin_amdgcn_readfirstlane(tid_ >> 6);
    for (int pr = wid_ * c.G + c.bx; pr < 4 * NG; pr += 8 * c.G) {
        const int b = pr >> 6, g = pr & 63, pp = tid_ & 63;
        const float lr = lamL[(g * NP + pp) * 2], li = lamL[(g * NP + pp) * 2 + 1];
        float sr = 0.f, si = 0.f;
        const size_t row0 = (size_t)g * NCH + b * 256;
#pragma unroll 8
        for (int ch = 0; ch < 256; ++ch) {
            const float zr = Z[(row0 + ch) * 128 + pp], zi = Z[(row0 + ch) * 128 + 64 + pp];
            bf16_t* o = Ug + (row0 + ch) * UGP + 512 + pp;
            const unsigned w = cvt_pk_bf16(sr, si);
            o[0] = (bf16_t)(w & 0xffffu); o[64] = (bf16_t)(w >> 16);
            const float nr = lr * sr - li * si + zr, ni = lr * si + li * sr + zi; sr = nr; si = ni;
        }
    }
}

__device__ void scan_after_z(const Ctx& c, const Params& p, int layer) {
    asm volatile("s_waitcnt vmcnt(0)" ::: "memory"); __syncthreads();
    __builtin_amdgcn_fence(__ATOMIC_ACQUIRE, "agent");
    asm volatile("s_waitcnt vmcnt(0)" ::: "memory");
    const float* Z = (const float*)(p.ws + WS_Z); bf16_t* Ug = (bf16_t*)(p.ws + WS_UG);
    const float* lamL = (const float*)(p.ws + WS_LAML) + (size_t)layer * NG * NP * 2;
    const int tid_ = opaque_tid(), wid_ = __builtin_amdgcn_readfirstlane(tid_ >> 6), pp = tid_ & 63;
    for (int i = wid_; ; i += 8) {
        const int L = i * c.G + c.vc; if (L >= 4 * NG) break;
        const int g = L >> 2, b = L & 3;
        const float lr = lamL[(g * NP + pp) * 2], li = lamL[(g * NP + pp) * 2 + 1];
        float sr = 0.f, si = 0.f;
        const size_t row0 = (size_t)g * NCH + b * 256;
#pragma unroll 8
        for (int ch = 0; ch < 256; ++ch) {
            const float zr = Z[(row0 + ch) * 128 + pp], zi = Z[(row0 + ch) * 128 + 64 + pp];
            bf16_t* o = Ug + (row0 + ch) * UGP + 512 + pp;
            const unsigned w = cvt_pk_bf16(sr, si);
            o[0] = (bf16_t)(w & 0xffffu); o[64] = (bf16_t)(w >> 16);
            const float nr = lr * sr - li * si + zr, ni = lr * si + li * sr + zi; sr = nr; si = ni;
        }
    }
}

#define ATTN_DMA(gp, ldsoff) __builtin_amdgcn_global_load_lds((const unsigned*)(gp), (LAS unsigned*)(lds + (ldsoff)), 16, 0, 0)
#define ATTN_PV(PB, VBASE) do { \
    bf16x8 fa__[8], fb__[8]; \
    _Pragma("unroll") for (int q_ = 0; q_ < 8; ++q_) fa__[q_] = *(LAS const bf16x8*)((VBASE) + (q_ >> 2) * 4096 + vo[q_ & 3]); \
    __builtin_amdgcn_sched_barrier(0); \
    _Pragma("unroll") for (int q_ = 0; q_ < 8; ++q_) fb__[q_] = *(LAS const bf16x8*)((VBASE) + (2 + (q_ >> 2)) * 4096 + vo[q_ & 3]); \
    _Pragma("unroll") for (int q_ = 0; q_ < 8; ++q_) o[q_ & 1] = __builtin_amdgcn_mfma_f32_32x32x16_bf16(fa__[(q_ & 1) * 4 + (q_ >> 1)], PB[q_ >> 1], o[q_ & 1], 0, 0, 0); \
    __builtin_amdgcn_sched_barrier(0); \
    _Pragma("unroll") for (int q_ = 0; q_ < 8; ++q_) o[2 + (q_ & 1)] = __builtin_amdgcn_mfma_f32_32x32x16_bf16(fb__[(q_ & 1) * 4 + (q_ >> 1)], PB[q_ >> 1], o[2 + (q_ & 1)], 0, 0, 0); \
    __builtin_amdgcn_sched_barrier(0); } while (0)
#define ATTN_QK(P0, P1, KB) do { \
    bf16x8 kf_[4]; \
    _Pragma("unroll") for (int d0 = 0; d0 < 4; ++d0) kf_[d0] = *(LAS const bf16x8*)((KB) + ko[d0]); \
    __builtin_amdgcn_sched_barrier(0); \
    P0 = __builtin_amdgcn_mfma_f32_32x32x16_bf16(kf_[0], qf[0], negm, 0, 0, 0); \
    _Pragma("unroll") for (int d0 = 1; d0 < 4; ++d0) P0 = __builtin_amdgcn_mfma_f32_32x32x16_bf16(kf_[d0], qf[d0], P0, 0, 0, 0); \
    __builtin_amdgcn_sched_barrier(0); \
    _Pragma("unroll") for (int d0 = 0; d0 < 4; ++d0) kf_[d0] = *(LAS const bf16x8*)((KB) + 4096 + ko[d0]); \
    __builtin_amdgcn_sched_barrier(0); \
    P1 = __builtin_amdgcn_mfma_f32_32x32x16_bf16(kf_[0], qf[0], negm, 0, 0, 0); \
    _Pragma("unroll") for (int d0 = 1; d0 < 4; ++d0) P1 = __builtin_amdgcn_mfma_f32_32x32x16_bf16(kf_[d0], qf[d0], P1, 0, 0, 0); \
    __builtin_amdgcn_sched_barrier(0); } while (0)
#define ATTN_BAND(P0, P1, DD) do { \
    __builtin_amdgcn_sched_barrier(0); \
    _Pragma("unroll") for (int r = 0; r < 16; ++r) { const int d0_ = (DD) - (16 * (r >> 3) + (r & 7)); P0[r] += btab[1 + min(max(d0_, -1), 127)]; } \
    __builtin_amdgcn_sched_barrier(0); \
    _Pragma("unroll") for (int r = 0; r < 16; ++r) { const int d1_ = (DD) - 32 - (16 * (r >> 3) + (r & 7)); P1[r] += btab[1 + min(max(d1_, -1), 127)]; } \
    __builtin_amdgcn_sched_barrier(0); } while (0)
#define ATTN_EXP(P0, P1, PB) do { \
    float ls0_ = 0.f, ls1_ = 0.f; \
    _Pragma("unroll") for (int r = 0; r < 16; ++r) { P0[r] = fexp2(P0[r]); P1[r] = fexp2(P1[r]); ls0_ += P0[r]; ls1_ += P1[r]; } \
    lrun += ls0_ + ls1_; \
    _Pragma("unroll") for (int q = 0; q < 2; ++q) { u32x4 w0_, w1_; \
        w0_.x = cvt_pk_bf16(P0[q * 8 + 0], P0[q * 8 + 1]); w0_.y = cvt_pk_bf16(P0[q * 8 + 2], P0[q * 8 + 3]); w0_.z = cvt_pk_bf16(P0[q * 8 + 4], P0[q * 8 + 5]); w0_.w = cvt_pk_bf16(P0[q * 8 + 6], P0[q * 8 + 7]); \
        w1_.x = cvt_pk_bf16(P1[q * 8 + 0], P1[q * 8 + 1]); w1_.y = cvt_pk_bf16(P1[q * 8 + 2], P1[q * 8 + 3]); w1_.z = cvt_pk_bf16(P1[q * 8 + 4], P1[q * 8 + 5]); w1_.w = cvt_pk_bf16(P1[q * 8 + 6], P1[q * 8 + 7]); \
        PB[q] = __builtin_bit_cast(bf16x8, w0_); PB[2 + q] = __builtin_bit_cast(bf16x8, w1_); } } while (0)
__device__ void attn_phase(const Ctx& c, const bf16_t* Q, const bf16_t* Kg, const bf16_t* Vt, bf16_t* OB, const float* biasT) {
    constexpr int KSUB = 8192, VSUB = 16384, STAGE = 49152, VS_OFF = 16384, BT_OFF = 98304;
    LAS unsigned char* lds = c.lds;
    LAS unsigned char* ldsr = lds; asm volatile("" : "+s"(ldsr) :: "memory");
    for (int itu = 0; ; ++itu) {
        const int L = itu * c.G + c.vc; if (L >= 2048) break;
        const int tid = opaque_tid(), lane = tid & 63, wid = __builtin_amdgcn_readfirstlane(tid >> 6), l31 = lane & 31, hi = lane >> 5;
        const int i7 = 7 - (L >> 8), trip = (L & 255) >> 2, j4 = L & 3;
        const int qb = (i7 & 1) ? (8 * (i7 >> 1) + 7 - j4) : (8 * (i7 >> 1) + j4);
        const int b = trip >> 4, h = (trip >> 1) & 7, br = trip & 1, q0 = qb * 256, NI = 2 * qb + 2;
        const int prow = (l31 & ~12) | ((l31 & 4) << 1) | ((l31 & 8) >> 1);
        const int kbase = prow * 128, krx = (prow >> 1) & 7;
        const int vbase = VS_OFF + l31 * 128, vx0 = hi ^ ((l31 >> 1) & 7);
        int ko[4], vo[4];
#pragma unroll
        for (int q = 0; q < 4; ++q) { ko[q] = (((q << 1) | hi) ^ krx) << 4; vo[q] = (vx0 ^ (q << 1)) << 4; }
        const int kr0 = 8 * wid + (lane >> 3), kc = (lane & 7) ^ ((kr0 >> 1) & 7);
        const int vr0 = 8 * wid + (lane >> 3), vcx = (lane & 7) ^ ((vr0 >> 1) & 7);
        const int dst0 = wid * 1024, dst1 = (wid + 8) * 1024;
        LAS const float* btab = (LAS const float*)(lds + BT_OFF);
        const size_t tokb = (size_t)b * SEQ;
        const bf16_t* kg = Kg + (tokb + kr0) * DM + h * 128 + br * 64 + kc * 8;
        const bf16_t* vg = Vt + ((size_t)((b * 8 + h) * 128) << 13) + vr0 * 64 + vcx * 8;
        const bf16_t* qp = Q + (tokb + q0 + wid * 32 + l31) * DM + h * 128 + br * 64 + hi * 8;
        bf16x8 qf[4];
#pragma unroll
        for (int d0 = 0; d0 < 4; ++d0) qf[d0] = *(const bf16x8*)(qp + d0 * 16);
        if (tid < 128) ((LAS float*)(lds + BT_OFF))[1 + tid] = biasT[h * 128 + tid];
        if (tid == 128) ((LAS float*)(lds + BT_OFF))[0] = -1e30f;
#pragma unroll
        for (int sb = 0; sb < 2; ++sb) {
            ATTN_DMA(kg + (size_t)sb * 64 * DM, sb * KSUB + dst0);
            ATTN_DMA(vg + (size_t)sb * 8192, VS_OFF + sb * VSUB + dst0); ATTN_DMA(vg + (size_t)sb * 8192 + 4096, VS_OFF + sb * VSUB + dst1);
        }
        f32x16 o[4], negm;
#pragma unroll
        for (int r = 0; r < 16; ++r) { o[0][r] = 0.f; o[1][r] = 0.f; o[2][r] = 0.f; o[3][r] = 0.f; negm[r] = 0.f; }
        float lrun = 0.f;
        const int qrow = q0 + wid * 32 + l31;
        for (int it = 0; it < NI; ++it) {
            const int st = it & 1, kt0 = it * 128;
            asm volatile("s_waitcnt vmcnt(0) lgkmcnt(0)\n\ts_barrier" ::: "memory");
            if (it + 1 < NI) { const int s2 = (st ^ 1) * STAGE;
#pragma unroll
                for (int sb = 0; sb < 2; ++sb) { const bf16_t* kn = kg + (size_t)(kt0 + 128 + sb * 64) * DM; const bf16_t* vn = vg + (size_t)((it + 1) * 2 + sb) * 8192;
                    ATTN_DMA(kn, s2 + sb * KSUB + dst0);
                    ATTN_DMA(vn, s2 + VS_OFF + sb * VSUB + dst0); ATTN_DMA(vn + 4096, s2 + VS_OFF + sb * VSUB + dst1); } }
            LAS const unsigned char* kbp = ldsr + st * STAGE + kbase;
            LAS const unsigned char* vbp = ldsr + st * STAGE + vbase;
#pragma unroll
            for (int sb = 0; sb < 2; ++sb) {
                f32x16 pa0, pa1;
                ATTN_QK(pa0, pa1, kbp + sb * KSUB);
                if (it >= NI - 3) { const int dd = qrow - kt0 - sb * 64 - 8 * hi; ATTN_BAND(pa0, pa1, dd); }
                float mxa = max3f(pa0[0], pa0[1], pa1[0]), mxb = max3f(pa0[2], pa0[3], pa1[1]); mxa = max3f(mxa, pa1[2], pa1[3]);
#pragma unroll
                for (int r = 4; r < 16; r += 4) { mxa = max3f(mxa, pa0[r], pa0[r + 1]); mxb = max3f(mxb, pa0[r + 2], pa0[r + 3]); mxa = max3f(mxa, pa1[r], pa1[r + 1]); mxb = max3f(mxb, pa1[r + 2], pa1[r + 3]); }
                float mx = max2f(mxa, mxb);
                { const auto rr_ = __builtin_amdgcn_permlane32_swap(__float_as_uint(mx), __float_as_uint(mx), false, false); mx = max2f(__uint_as_float(rr_[0]), __uint_as_float(rr_[1])); }
                if ((it == 0 && sb == 0) || __any(mx > 8.0f)) {
                    const float delta = (it == 0 && sb == 0) ? mx : fmaxf(mx, 0.f), alpha = fexp2(-delta); lrun *= alpha;
#pragma unroll
                    for (int r = 0; r < 16; ++r) { pa0[r] -= delta; pa1[r] -= delta; negm[r] -= delta; }
#pragma unroll
                    for (int q = 0; q < 4; ++q) o[q] = o[q] * alpha;
                }
                bf16x8 pk[4];
                ATTN_EXP(pa0, pa1, pk);
                ATTN_PV(pk, vbp + sb * VSUB);
            }
        }
        {
            const int te = opaque_tid(), le31 = te & 31, hie = (te & 63) >> 5, wide = __builtin_amdgcn_readfirstlane(te >> 6);
            const float inv = frcp(lrun + __shfl_xor(lrun, 32));
            bf16_t* op = OB + (size_t)br * TOK * DM + ((size_t)b * SEQ + q0 + wide * 32 + le31) * DM + h * 128;
#pragma unroll
            for (int blk = 0; blk < 4; ++blk)
#pragma unroll
                for (int r4 = 0; r4 < 4; ++r4) { const int dv = blk * 32 + 8 * r4 + 4 * hie;
                    u32x2 w; w.x = cvt_pk_bf16(o[blk][r4 * 4 + 0] * inv, o[blk][r4 * 4 + 1] * inv); w.y = cvt_pk_bf16(o[blk][r4 * 4 + 2] * inv, o[blk][r4 * 4 + 3] * inv);
                    *(u32x2*)(op + dv) = w; }
        }
        __syncthreads();
    }
}
#undef ATTN_PV
#undef ATTN_QK
#undef ATTN_BAND
#undef ATTN_EXP
#undef ATTN_DMA

__device__ void attn_combine(const Ctx& c, const bf16_t* OB, bf16_t* ON, const float* scal, const float* hn) {
    const int tid_ = opaque_tid(), lane = tid_ & 63, wid_ = __builtin_amdgcn_readfirstlane(tid_ >> 6);
    const float lam = scal[0], onem = scal[1];
    for (int r0 = (wid_ * c.G + c.bx) * 4; r0 < TOK; r0 += 8 * c.G * 4) {
        u32x4 a[4][2], bb[4][2];
#pragma unroll
        for (int rr = 0; rr < 4; ++rr)
#pragma unroll
            for (int k = 0; k < 2; ++k) { const size_t off = (size_t)(r0 + rr) * DM + k * 512 + lane * 8; a[rr][k] = *(const u32x4*)(OB + off); bb[rr][k] = *(const u32x4*)(OB + (size_t)TOK * DM + off); }
#pragma unroll
        for (int rr = 0; rr < 4; ++rr)
#pragma unroll
            for (int k = 0; k < 2; ++k) {
                const u32x4 x1 = a[rr][k], x2 = bb[rr][k];
                float v[8];
                v[0] = bf_lo(x1.x) - lam * bf_lo(x2.x); v[1] = bf_hi(x1.x) - lam * bf_hi(x2.x); v[2] = bf_lo(x1.y) - lam * bf_lo(x2.y); v[3] = bf_hi(x1.y) - lam * bf_hi(x2.y);
                v[4] = bf_lo(x1.z) - lam * bf_lo(x2.z); v[5] = bf_hi(x1.z) - lam * bf_hi(x2.z); v[6] = bf_lo(x1.w) - lam * bf_lo(x2.w); v[7] = bf_hi(x1.w) - lam * bf_hi(x2.w);
                float ss = 0.f;
#pragma unroll
                for (int e = 0; e < 8; ++e) ss += v[e] * v[e];
                ss += __shfl_xor(ss, 1); ss += __shfl_xor(ss, 2); ss += __shfl_xor(ss, 4); ss += __shfl_xor(ss, 8);
                const float rs = rsqrtf(ss * (1.0f / 128.0f) + EPS) * onem;
                const int dv = (lane & 15) * 8; const f32x4 g0 = *(const f32x4*)(hn + dv), g1 = *(const f32x4*)(hn + dv + 4);
                u32x4 w; w.x = cvt_pk_bf16(v[0] * rs * g0[0], v[1] * rs * g0[1]); w.y = cvt_pk_bf16(v[2] * rs * g0[2], v[3] * rs * g0[3]);
                w.z = cvt_pk_bf16(v[4] * rs * g1[0], v[5] * rs * g1[1]); w.w = cvt_pk_bf16(v[6] * rs * g1[2], v[7] * rs * g1[3]);
                *(u32x4*)(ON + (size_t)(r0 + rr) * DM + k * 512 + lane * 8) = w;
            }
    }
}

__global__ void __launch_bounds__(512, 2) yoco_fwd(Params p) {
    extern __shared__ __attribute__((aligned(16))) unsigned char lds_raw[];
    cg::grid_group grid = cg::this_grid();
    Ctx c; c.lds = (LAS unsigned char*)lds_raw; c.tid = threadIdx.x; c.lane = c.tid & 63; c.wid = __builtin_amdgcn_readfirstlane(c.tid >> 6);
    c.G = gridDim.x; c.bx = blockIdx.x; c.vc = (c.G % 8 == 0) ? (c.bx % 8) * (c.G / 8) + c.bx / 8 : c.bx;
    unsigned char* ws = p.ws;
    float* X = p.out;
    { volatile LAS unsigned* xst0 = (volatile LAS unsigned*)(c.lds + 131072); if (c.tid < 4) xst0[c.tid] = 0u; }
    __syncthreads();
    (void)xcd_barrier_post((unsigned*)(ws + WS_BAR), (volatile LAS unsigned*)(c.lds + 131072));
    bf16_t* HM = (bf16_t*)(ws + WS_HM); bf16_t* ACT = (bf16_t*)(ws + WS_ACT);
    bf16_t* UG = (bf16_t*)(ws + WS_UG); float* Zb = (float*)(ws + WS_Z); bf16_t* YG = (bf16_t*)(ws + WS_YG);
    bf16_t* Qb = (bf16_t*)(ws + WS_Q); bf16_t* ONb = (bf16_t*)(ws + WS_ON); bf16_t* HKV = (bf16_t*)(ws + WS_HKV);
    bf16_t* Kb = (bf16_t*)(ws + WS_K); bf16_t* Vtb = (bf16_t*)(ws + WS_VT);

    enum { K_PRO = 0, K_WIN = 1, K_Z = 2, K_SCAN = 3, K_Y = 4, K_GLU = 5, K_NORMA = 6, K_UP = 7, K_DOWN = 8, K_NORMB = 9, K_K = 10, K_VT = 11, K_Q = 12, K_ATTN = 13, K_O = 14, K_ACOMB = 15 };
    for (int ph = 0; ph < 37; ++ph) {
        int kind, layer;
        if (ph == 0) { kind = K_PRO; layer = 0; }
        else if (ph < 19) { layer = (ph - 1) / 9; kind = 1 + (ph - 1) % 9; }
        else { int k; if (ph < 29) { layer = 2; k = ph - 19; } else { layer = 3; k = ph - 27; }
            kind = k < 3 ? K_K + k : (k == 3 ? K_ATTN : (k == 4 ? K_ACOMB : (k == 5 ? K_O : K_NORMA + (k - 6)))); }
        const int j = layer & 1;
        if (kind == K_SCAN) continue;
        for (int rep = 0; rep < (((REPEAT_MASK >> kind) & 1) ? 2 : 1); ++rep) {
        { int t_ = threadIdx.x; asm volatile("" : "+v"(t_)); c.tid = t_; c.lane = t_ & 63; c.wid = __builtin_amdgcn_readfirstlane(t_ >> 6); }
        const bool is_gemm = (kind == K_WIN) | (kind == K_Z) | (kind == K_Y) | (kind == K_GLU) | (kind == K_UP) | (kind == K_DOWN) | (kind == K_K) | (kind == K_VT) | (kind == K_Q) | (kind == K_O);
        if (is_gemm) {
            pg8::Job jb; jb.lda = DM; jb.ldb = DM; jb.K = DM; jb.ord = pg8::ORD_STATIC; jb.M = TOK; jb.N = DM; jb.epi = pg8::EPI_STORE; jb.ldc = DM; jb.scale = 1.0f; jb.O = HM; jb.x1 = nullptr; jb.x2 = nullptr; jb.A = HM; jb.Bt = nullptr;
            switch (kind) {
            case K_WIN: jb.Bt = (const bf16_t*)(ws + WS_WIN) + (size_t)j * DM * DM; jb.epi = pg8::EPI_UG; jb.O = UG; break;
            case K_Z: jb.A = UG; jb.Bt = (const bf16_t*)(ws + WS_SIN) + (size_t)j * NG * 128 * 512; jb.lda = UGP; jb.ldb = 512; jb.K = 512; jb.ord = pg8::ORD_Z; jb.epi = pg8::EPI_Z; jb.O = Zb; break;
            case K_Y: jb.A = UG; jb.Bt = (const bf16_t*)(ws + WS_TM) + (size_t)j * NG * 512 * UGP; jb.lda = UGP; jb.ldb = UGP; jb.K = UGP; jb.ord = pg8::ORD_Y; jb.epi = pg8::EPI_Y; jb.O = YG; jb.x1 = UG; jb.x2 = p.in[15] + (size_t)j * DM; break;
            case K_GLU: jb.A = YG; jb.Bt = (const bf16_t*)(ws + WS_GLU) + (size_t)j * DM * 2 * DM; jb.N = 2 * DM; jb.epi = pg8::EPI_GLU; break;
            case K_UP: jb.Bt = (const bf16_t*)(ws + (layer < 2 ? WS_UP01 : WS_UP23)) + (size_t)j * DM * FF; jb.N = FF; jb.epi = pg8::EPI_RELU2; jb.O = ACT; jb.ldc = FF; break;
            case K_DOWN: jb.A = ACT; jb.Bt = (const bf16_t*)(ws + (layer < 2 ? WS_DN01 : WS_DN23)) + (size_t)j * DM * FF; jb.lda = FF; jb.ldb = FF; jb.K = FF; break;
            case K_K: jb.A = HKV; jb.Bt = (const bf16_t*)(ws + WS_KVW); jb.O = Kb; break;
            case K_VT: jb.A = (const bf16_t*)(ws + WS_KVW) + (size_t)DM * DM; jb.Bt = HKV; jb.M = DM; jb.N = TOK; jb.O = Vtb; jb.epi = pg8::EPI_VT; break;
            case K_Q: jb.Bt = (const bf16_t*)(ws + WS_QW) + (size_t)j * DM * DM; jb.O = Qb; jb.scale = 0.125f * LOG2E; break;
            default:   jb.A = ONb; jb.Bt = (const bf16_t*)(ws + WS_OW) + (size_t)j * DM * DM; break;
            }
#ifndef NO_GEMM
            pg8::gemm_phase(c.lds, jb, c.G, c.bx, c.vc, c.tid);
#endif
            if (kind == K_Z) scan_after_z(c, p, j);
        } else if (kind == K_NORMA || kind == K_NORMB || kind == K_PRO) {
            if (kind == K_PRO) {
#ifndef NO_TAB
                for (int u = c.bx; u < 2 * NG; u += c.G) ssm_tables(c, p, u >> 6, u & 63);
#endif
                if (c.bx == c.G - 1) small_tables(c, p);
#ifndef NO_CONV
                convert_weights(c, p);
#endif
            }
            const float* xin = X; float* xout = X; const bf16_t* mix = HM; const float* gpost; const float* gpre; const float* gkv = nullptr;
            if (kind == K_PRO) { xin = p.in[0]; xout = nullptr; mix = nullptr; gpost = nullptr; gpre = p.in[1]; }
            else if (kind == K_NORMA) { if (layer == 0) xin = p.in[0]; gpost = p.in[2] + layer * DM; gpre = p.in[3] + layer * DM; }
            else { gpost = p.in[4] + layer * DM; gpre = layer < 3 ? p.in[1] + (layer + 1) * DM : nullptr; if (layer == 1) gkv = p.in[17]; }
#ifndef NO_NORM
            norm_phase(c, xin, xout, mix, gpost, gpre, HM, gkv, HKV);
#endif
        } else if (kind == K_SCAN) {
#ifndef NO_SCAN
            scan_phase(c, p, j);
#endif
        } else if (kind == K_ACOMB) {
            attn_combine(c, (const bf16_t*)(ws + WS_OB), ONb, (const float*)(ws + WS_SCAL) + j * 4, p.in[24] + j * 128);
        } else {
#ifndef NO_ATTN
            attn_phase(c, Qb, Kb, Vtb, (bf16_t*)(ws + WS_OB), (const float*)(ws + WS_BIAS));
#endif
        }
        }
        if (!(kind == K_K || kind == K_VT || ph == 36)) { if (ph == 0) grid.sync(); else { XcdBarrier xb_; xb_.bar = (unsigned*)(ws + WS_BAR); xb_.x = xb_xcc_id(); xb_.st = (volatile LAS unsigned*)(c.lds + 131072); xcd_barrier(xb_); } }
    }
}

extern "C" void kernel_launch(void* const* d_in, const int* in_sizes, int n_in, void* d_out, int out_size, void* d_ws, size_t ws_size, hipStream_t stream) {
    static int grid_blocks = 0;
    if (grid_blocks == 0) {
        if (n_in != 27 || out_size != TOK * DM || ws_size < WS_END) { fprintf(stderr, "kernel_launch: unexpected shapes (n_in %d, out %d, ws %zu)\n", n_in, out_size, ws_size); grid_blocks = -1; return; }
        int dev = 0, cus = 0, per_cu = 0;
        hipGetDevice(&dev);
        hipDeviceGetAttribute(&cus, hipDeviceAttributeMultiprocessorCount, dev);
        if (hipFuncSetAttribute((const void*)yoco_fwd, hipFuncAttributeMaxDynamicSharedMemorySize, LDS_BYTES) != hipSuccess) { fprintf(stderr, "kernel_launch: hipFuncSetAttribute failed\n"); grid_blocks = -1; return; }
        if (hipOccupancyMaxActiveBlocksPerMultiprocessor(&per_cu, (const void*)yoco_fwd, 512, LDS_BYTES) != hipSuccess || per_cu < 1) { fprintf(stderr, "kernel_launch: occupancy query says %d\n", per_cu); per_cu = 1; }
        (void)hipGetLastError();
        grid_blocks = cus * 1;
    }
    if (grid_blocks < 0) return;
    Params p{};
    for (int i = 0; i < 27; ++i) p.in[i] = (const float*)d_in[i];
    p.out = (float*)d_out; p.ws = (unsigned char*)d_ws;
    if (hipMemsetAsync((char*)d_ws + WS_BAR, 0, 16384, stream) != hipSuccess) { fprintf(stderr, "kernel_launch: memset of barrier words failed\n"); return; }
    void* args[] = {&p};
    hipError_t e = hipLaunchCooperativeKernel((const void*)yoco_fwd, dim3(grid_blocks), dim3(512), args, LDS_BYTES, stream);
    if (e != hipSuccess) fprintf(stderr, "cooperative launch failed: %s (grid %d)\n", hipGetErrorString(e), grid_blocks);
}
```

```cpp
#include <hip/hip_runtime.h>
#include <hip/hip_cooperative_groups.h>
#include <cstdio>
#include <cstdint>
namespace cg = cooperative_groups;

#define LAS __attribute__((address_space(3)))
typedef unsigned short bf16_t;
typedef short bf16x8 __attribute__((ext_vector_type(8)));
typedef float f32x4 __attribute__((ext_vector_type(4)));
typedef float f32x16 __attribute__((ext_vector_type(16)));
typedef unsigned u32x4 __attribute__((ext_vector_type(4)));
typedef unsigned u32x2 __attribute__((ext_vector_type(2)));

constexpr int TOK = 32768, DM = 1024, FF = 4096, SEQ = 8192;
constexpr int NG = 64, GS = 16, NP = 64;
constexpr int CL = 32;
constexpr int NCH = TOK / CL;
constexpr int UGP = CL * GS + 2 * NP;
constexpr float EPS = 1e-6f;
constexpr float LOG2E = 1.4426950408889634f;

constexpr size_t MiB = 1u << 20;
constexpr size_t WS_BIAS = 0;
constexpr size_t WS_SCAL = 4096;
constexpr size_t WS_LAML = 8192;
constexpr size_t WS_BAR = 131072;
constexpr size_t WS_UP23 = 1 * MiB;
constexpr size_t WS_DN23 = 17 * MiB;
constexpr size_t WS_KVW = 33 * MiB;
constexpr size_t WS_QW = 37 * MiB;
constexpr size_t WS_OW = 41 * MiB;
constexpr size_t WS_UP01 = 45 * MiB;
constexpr size_t WS_DN01 = 61 * MiB;
constexpr size_t WS_WIN = 77 * MiB;
constexpr size_t WS_GLU = 81 * MiB;
constexpr size_t WS_TM = 89 * MiB;
constexpr size_t WS_SIN = 169 * MiB;
constexpr size_t WS_K = 45 * MiB;
constexpr size_t WS_VT = 109 * MiB;
constexpr size_t WS_HM = 186 * MiB;
constexpr size_t WS_ACT = 250 * MiB;
constexpr size_t WS_UG = WS_ACT;
constexpr size_t WS_Z = WS_ACT + 80 * MiB;
constexpr size_t WS_YG = WS_ACT + 112 * MiB;
constexpr size_t WS_Q = WS_ACT;
constexpr size_t WS_ON = WS_ACT + 64 * MiB;
constexpr size_t WS_HKV = WS_ACT + 128 * MiB;
constexpr size_t WS_END = 506 * MiB;

constexpr int LDS_BYTES = 147456;
#ifndef REPEAT_MASK
#define REPEAT_MASK 0
#endif

__device__ __forceinline__ unsigned cvt_pk_bf16(float lo, float hi) { unsigned r; asm("v_cvt_pk_bf16_f32 %0, %1, %2" : "=v"(r) : "v"(lo), "v"(hi)); return r; }
__device__ __forceinline__ float bf_lo(unsigned w) { return __uint_as_float(w << 16); }
__device__ __forceinline__ float bf_hi(unsigned w) { return __uint_as_float(w & 0xffff0000u); }
__device__ __forceinline__ float fexp2(float x) { return __builtin_amdgcn_exp2f(x); }
__device__ __forceinline__ float frcp(float x) { return __builtin_amdgcn_rcpf(x); }
__device__ __forceinline__ float max3f(float a, float b, float c) { float r; asm("v_max3_f32 %0, %1, %2, %3" : "=v"(r) : "v"(a), "v"(b), "v"(c)); return r; }
__device__ __forceinline__ float max2f(float a, float b) { float r; asm("v_max_f32_e32 %0, %1, %2" : "=v"(r) : "v"(a), "v"(b)); return r; }
__device__ __forceinline__ int opaque_tid() { int t_ = threadIdx.x; asm volatile("" : "+v"(t_)); return t_; }
__device__ __forceinline__ float wave_sum(float v) {
#pragma unroll
    for (int o = 32; o >= 1; o >>= 1) v += __shfl_xor(v, o);
    return v;
}
__device__ __forceinline__ float gelu_tanh(float y) {
    const float t = y * (1.5957691216057308f + 0.07135481627f * y * y);
    return y * frcp(1.0f + fexp2(-t * LOG2E));
}

namespace pg8 {
constexpr int BM = 256, BK = 64, HALF = 128, HTB = HALF * BK * 2, STAGE_BYTES = 8 * HTB;
__host__ __device__ __forceinline__ int lds_byte(int r, int c) { const int st = (r >> 4) * 2 + (c >> 5), rr = r & 15, cc = c & 31, ob = rr * 64 + cc * 2; return st * 1024 + (ob ^ (((ob >> 9) & 1) << 5)); }
__host__ __device__ __forceinline__ void stage_rc(int b, int& R, int& C) { const int st = b / 1024, sb = b % 1024, swz = sb ^ (((sb >> 9) & 1) << 5); R = (st >> 1) * 16 + swz / 64; C = (st & 1) * 32 + (swz % 64) / 2; }
__host__ __device__ __forceinline__ int perm32(int rho) { const int n = rho >> 4, i = rho & 15; return 8 * (i >> 2) + 4 * n + (i & 3); }

struct Unit { int pm, pn, arow, brow; };
enum { ORD_STATIC = 0, ORD_Z = 1, ORD_Y = 2 };
enum { EPI_STORE = 0, EPI_RELU2 = 1, EPI_GLU = 2, EPI_UG = 3, EPI_Z = 4, EPI_Y = 5, EPI_VT = 6 };
struct Job { const bf16_t* A; const bf16_t* Bt; int lda, ldb, K, ord, M, N, epi, ldc; float scale; void* O; const void* x1; const void* x2; };

__device__ __forceinline__ bool next_unit(const Job& jb, int G, int bx, int vc, int i, Unit& u) {
    if (jb.ord == ORD_STATIC) {
        const int nM = jb.M / BM, nN = jb.N / BM, nwg = nM * nN;
        const long L = (long)i * G + bx; if (L >= nwg) return false;
        int wgid = (int)L; { const int q = nwg / 8, r = nwg % 8, xcd = wgid % 8, off = wgid / 8; wgid = (xcd < r ? xcd * (q + 1) : r * (q + 1) + (xcd - r) * q) + off; }
        const int nig = 8 * nN, gid = wgid / nig, fm = gid * 8, gsz = (nM - fm) < 8 ? (nM - fm) : 8;
        u.pm = fm + ((wgid % nig) % gsz); u.pn = (wgid % nig) / gsz; u.arow = u.pm * BM; u.brow = u.pn * BM; return true;
    } else if (jb.ord == ORD_Z) {
        const int L = i * G + vc; if (L >= NG * 4) return false; u.pm = L; u.pn = 0; u.arow = L * BM; u.brow = (L >> 2) * 128; return true;
    } else {
        const int L = i * G + vc; if (L >= NG * 8) return false; const int g = L >> 3, r = L & 7; u.pm = g * 4 + (r >> 1); u.pn = g * 2 + (r & 1); u.arow = u.pm * BM; u.brow = u.pn * BM; return true;
    }
}

typedef f32x4 Acc[2][2][4][2];
__device__ __forceinline__ u32x4 pack8(const f32x4 v0, const f32x4 v1) { u32x4 w; w.x = cvt_pk_bf16(v0[0], v0[1]); w.y = cvt_pk_bf16(v0[2], v0[3]); w.z = cvt_pk_bf16(v1[0], v1[1]); w.w = cvt_pk_bf16(v1[2], v1[3]); return w; }

__device__ __forceinline__ void epilogue(const Job& jb, const Acc& acc, const Unit& u) {
    int t_ = threadIdx.x; asm volatile("" : "+v"(t_));
    const int wid_ = __builtin_amdgcn_readfirstlane(t_ >> 6), wr = wid_ >> 2, wc = wid_ & 3, fr = t_ & 15, fq = (t_ & 63) >> 4;
    const int row0 = u.pm * BM + wr * 64 + fr;
#ifdef EPI_MASK
    const int epi_ = ((1 << jb.epi) & EPI_MASK) ? jb.epi : 0;
#else
    const int epi_ = jb.epi;
#endif
    if (epi_ == EPI_STORE || epi_ == EPI_RELU2) {
        bf16_t* O = (bf16_t*)jb.O; const int col0 = u.pn * BM + wc * 32 + 8 * fq; const bool r2 = epi_ == EPI_RELU2; const float scale = jb.scale;
#pragma unroll
        for (int ai = 0; ai < 2; ++ai)
#pragma unroll
            for (int m = 0; m < 4; ++m) { bf16_t* rowp = O + (size_t)(row0 + ai * HALF + m * 16) * jb.ldc + col0;
#pragma unroll
                for (int bj = 0; bj < 2; ++bj) { f32x4 v0 = acc[ai][bj][m][0], v1 = acc[ai][bj][m][1];
                    if (r2) {
#pragma unroll
                        for (int e = 0; e < 4; ++e) { const float a = fmaxf(v0[e], 0.f), b = fmaxf(v1[e], 0.f); v0[e] = a * a; v1[e] = b * b; } }
                    v0 = v0 * scale; v1 = v1 * scale;
                    *(u32x4*)(rowp + bj * HALF) = pack8(v0, v1); } }
    } else if (epi_ == EPI_GLU) {
        bf16_t* O = (bf16_t*)jb.O; const int col0 = u.pn * HALF + wc * 32 + 8 * fq;
#pragma unroll
        for (int ai = 0; ai < 2; ++ai)
#pragma unroll
            for (int m = 0; m < 4; ++m) { bf16_t* rowp = O + (size_t)(row0 + ai * HALF + m * 16) * DM + col0;
                f32x4 o0, o1;
#pragma unroll
                for (int e = 0; e < 4; ++e) { o0[e] = acc[ai][0][m][0][e] * frcp(1.0f + fexp2(-acc[ai][1][m][0][e] * LOG2E)); o1[e] = acc[ai][0][m][1][e] * frcp(1.0f + fexp2(-acc[ai][1][m][1][e] * LOG2E)); }
                *(u32x4*)rowp = pack8(o0, o1); }
    } else if (epi_ == EPI_UG) {
        bf16_t* Ug = (bf16_t*)jb.O;
#pragma unroll
        for (int ai = 0; ai < 2; ++ai)
#pragma unroll
            for (int m = 0; m < 4; ++m) { const int tok = row0 + ai * HALF + m * 16;
#pragma unroll
                for (int bj = 0; bj < 2; ++bj) { const int g = u.pn * 16 + bj * 8 + wc * 2 + (fq >> 1);
                    *(u32x4*)(Ug + ((size_t)(g * NCH + (tok >> 5)) * UGP + (tok & 31) * 16 + (fq & 1) * 8)) = pack8(acc[ai][bj][m][0], acc[ai][bj][m][1]); } }
    } else if (epi_ == EPI_Z) {
        float* Z = (float*)jb.O; const int col0 = wc * 32 + 8 * fq;
#pragma unroll
        for (int ai = 0; ai < 2; ++ai)
#pragma unroll
            for (int m = 0; m < 4; ++m) { float* p = Z + (size_t)(row0 + ai * HALF + m * 16) * 128 + col0;
                *(f32x4*)p = acc[ai][0][m][0]; *(f32x4*)(p + 4) = acc[ai][0][m][1]; }
    } else if (epi_ == EPI_VT) {
        bf16_t* O = (bf16_t*)jb.O; const int col0 = u.pn * BM + wc * 32 + 8 * fq;
#pragma unroll
        for (int ai = 0; ai < 2; ++ai)
#pragma unroll
            for (int m = 0; m < 4; ++m) { const int row = row0 + ai * HALF + m * 16;
#pragma unroll
                for (int bj = 0; bj < 2; ++bj) { const int col = col0 + bj * HALF;
                    const size_t off = ((size_t)(((col >> 13) * 8 + (row >> 7)) * 128 + ((col & 8191) >> 6)) << 13) + (row & 127) * 64 + (col & 63);
                    *(u32x4*)(O + off) = pack8(acc[ai][bj][m][0], acc[ai][bj][m][1]); } }
    } else {
        const bf16_t* Ug = (const bf16_t*)jb.x1; const float* dsk = (const float*)jb.x2; bf16_t* YG = (bf16_t*)jb.O;
        const int g = u.pm >> 2, n0 = (u.pm & 3) * BM + wr * 64 + fr, c0 = (u.pn & 1) * BM + wc * 32 + 8 * fq;
        const int co0 = (fq & 1) * 8;
        const f32x4 d0 = *(const f32x4*)(dsk + g * 16 + co0), d1 = *(const f32x4*)(dsk + g * 16 + co0 + 4);
#pragma unroll
        for (int ai = 0; ai < 2; ++ai)
#pragma unroll
            for (int m = 0; m < 4; ++m) { const int n = n0 + ai * HALF + m * 16;
#pragma unroll
                for (int bj = 0; bj < 2; ++bj) { const int cc = c0 + bj * HALF, j = cc >> 4;
                    const u32x4 uu = *(const u32x4*)(Ug + ((size_t)(g * NCH + n) * UGP + cc));
                    const f32x4 v0 = acc[ai][bj][m][0], v1 = acc[ai][bj][m][1];
                    f32x4 y0, y1;
                    y0[0] = v0[0] + d0[0] * bf_lo(uu.x); y0[1] = v0[1] + d0[1] * bf_hi(uu.x); y0[2] = v0[2] + d0[2] * bf_lo(uu.y); y0[3] = v0[3] + d0[3] * bf_hi(uu.y);
                    y1[0] = v1[0] + d1[0] * bf_lo(uu.z); y1[1] = v1[1] + d1[1] * bf_hi(uu.z); y1[2] = v1[2] + d1[2] * bf_lo(uu.w); y1[3] = v1[3] + d1[3] * bf_hi(uu.w);
#pragma unroll
                    for (int e = 0; e < 4; ++e) { y0[e] = gelu_tanh(y0[e]); y1[e] = gelu_tanh(y1[e]); }
                    *(u32x4*)(YG + ((size_t)(n * CL + j) * DM + g * 16 + co0)) = pack8(y0, y1); } }
    }
}

__device__ __forceinline__ void gemm_phase(LAS unsigned char* lds, const Job& g, const int G, const int bx, const int vc, const int tid_unused) {
    const int tid = opaque_tid(); (void)tid_unused;
    const int wid = __builtin_amdgcn_readfirstlane(tid >> 6), lane = tid & 63, wr = wid >> 2, wc = wid & 3, fr = lane & 15, fq = lane >> 4;
    const int K = g.K, nt = K / BK;
    unsigned voffA[2], voffB[2];
#pragma unroll
    for (int i = 0; i < 2; ++i) { int R, C; stage_rc(tid * 16 + i * 8192, R, C); const int Rb = (R & ~31) + perm32(R & 31);
        voffA[i] = (unsigned)(R * g.lda + C) * 2u; voffB[i] = (unsigned)(Rb * g.ldb + C) * 2u; }
    const size_t kstep = (size_t)(BK * 2);
    const size_t hstepA = (size_t)HALF * g.lda * 2, hstepB = (size_t)HALF * g.ldb * 2;
    const size_t rowA = (size_t)g.lda * 2, rowB = (size_t)g.ldb * 2;
    const unsigned ldsw = (unsigned)wid * 1024u;
    const int aoff = lds_byte(wr * 64 + fr, fq * 8), boff = lds_byte(wc * 32 + fr, fq * 8);
#define PG8_SA(b, h) (((b) * 2 + (h)) * HTB)
#define PG8_SB(b, h) ((4 + (b) * 2 + (h)) * HTB)
#define PG8_STAGE(bufoff, gbase, voff) do { _Pragma("unroll") for (int _i = 0; _i < 2; ++_i) \
        __builtin_amdgcn_global_load_lds((const unsigned*)((const char*)(gbase) + (voff)[_i]), (LAS unsigned*)(lds + (bufoff) + ldsw + _i * 8192), 16, 0, 0); } while (0)
#define PG8_LDA(dst, b, h) do { _Pragma("unroll") for (int m = 0; m < 4; ++m) _Pragma("unroll") for (int k = 0; k < 2; ++k) dst[m][k] = *(const LAS bf16x8*)(lds + PG8_SA(b, h) + aoff + m * 2048 + k * 1024); } while (0)
#define PG8_LDB(dst, b, h) do { _Pragma("unroll") for (int n = 0; n < 2; ++n) _Pragma("unroll") for (int k = 0; k < 2; ++k) dst[n][k] = *(const LAS bf16x8*)(lds + PG8_SB(b, h) + boff + n * 2048 + k * 1024); } while (0)
#define PG8_MMA(ai, bj, At, Bt) do { __builtin_amdgcn_s_setprio(1); _Pragma("unroll") for (int m = 0; m < 4; ++m) _Pragma("unroll") for (int n = 0; n < 2; ++n) _Pragma("unroll") for (int k = 0; k < 2; ++k) \
        acc[ai][bj][m][n] = __builtin_amdgcn_mfma_f32_16x16x32_bf16(Bt[n][k], At[m][k], acc[ai][bj][m][n], 0, 0, 0); __builtin_amdgcn_s_setprio(0); } while (0)
#define PG8_WAIT_V(n) asm volatile("s_waitcnt vmcnt(" #n ")" ::: "memory")
#define PG8_WAIT_L(n) asm volatile("s_waitcnt lgkmcnt(" #n ")" ::: "memory")
#define PG8_BAR __builtin_amdgcn_s_barrier()
#define PG8_SCHED __builtin_amdgcn_sched_barrier(0)
    Unit cur, nxt; int ui = 0;
    if (!next_unit(g, G, bx, vc, 0, cur)) return;
    Acc acc;
#pragma unroll
    for (int a = 0; a < 2; ++a)
#pragma unroll
        for (int b = 0; b < 2; ++b)
#pragma unroll
            for (int m = 0; m < 4; ++m)
#pragma unroll
                for (int n = 0; n < 2; ++n) acc[a][b][m][n] = (f32x4){0.f, 0.f, 0.f, 0.f};
    bf16x8 At[4][2], B0[2][2], B1[2][2];
    const char* cA = (const char*)g.A + (size_t)cur.arow * rowA; const char* cB = (const char*)g.Bt + (size_t)cur.brow * rowB;
    PG8_STAGE(PG8_SB(0, 0), cB, voffB); PG8_STAGE(PG8_SB(0, 1), cB + hstepB, voffB); PG8_STAGE(PG8_SA(0, 0), cA, voffA); PG8_STAGE(PG8_SA(0, 1), cA + hstepA, voffA);
    if (wr == 1) PG8_BAR;
    PG8_WAIT_V(2); PG8_BAR;
    PG8_STAGE(PG8_SB(1, 0), cB + kstep, voffB); PG8_STAGE(PG8_SA(1, 0), cA + kstep, voffA); PG8_STAGE(PG8_SB(1, 1), cB + hstepB + kstep, voffB);
    PG8_WAIT_V(6); PG8_BAR;
    for (;;) {
        const bool has_next = next_unit(g, G, bx, vc, ui + 1, nxt);
        const char* nA = has_next ? (const char*)g.A + (size_t)nxt.arow * rowA : cA; const char* nB = has_next ? (const char*)g.Bt + (size_t)nxt.brow * rowB : cB;
        for (int t = 0; t < nt; t += 2) {
            const bool last = (t == nt - 2);
            const char* a1 = cA + (size_t)(t + 1) * kstep;
            const char* a2 = last ? nA : cA + (size_t)(t + 2) * kstep; const char* b2 = last ? nB : cB + (size_t)(t + 2) * kstep;
            const char* a3 = a2 + kstep; const char* b3 = b2 + kstep;
            PG8_LDB(B0, 0, 0); PG8_LDB(B1, 0, 1); PG8_SCHED; PG8_LDA(At, 0, 0); PG8_STAGE(PG8_SA(1, 1), a1 + hstepA, voffA);
            PG8_WAIT_V(8); PG8_WAIT_L(0); PG8_BAR; PG8_MMA(0, 0, At, B0); PG8_MMA(0, 1, At, B1); PG8_BAR; PG8_SCHED;
            PG8_LDA(At, 0, 1); PG8_STAGE(PG8_SB(0, 0), b2, voffB); PG8_STAGE(PG8_SB(0, 1), b2 + hstepB, voffB); PG8_STAGE(PG8_SA(0, 0), a2, voffA);
            PG8_WAIT_V(8); PG8_WAIT_L(0); PG8_BAR; PG8_MMA(1, 0, At, B0); PG8_MMA(1, 1, At, B1); PG8_BAR; PG8_SCHED;
            PG8_LDB(B0, 1, 0); PG8_LDB(B1, 1, 1); PG8_SCHED; PG8_LDA(At, 1, 0); PG8_STAGE(PG8_SA(0, 1), a2 + hstepA, voffA);
            PG8_WAIT_V(8); PG8_WAIT_L(0); PG8_BAR; PG8_MMA(0, 0, At, B0); PG8_MMA(0, 1, At, B1); PG8_BAR; PG8_SCHED;
            PG8_LDA(At, 1, 1); PG8_STAGE(PG8_SB(1, 0), b3, voffB); PG8_STAGE(PG8_SB(1, 1), b3 + hstepB, voffB); PG8_STAGE(PG8_SA(1, 0), a3, voffA);
            PG8_WAIT_V(8); PG8_WAIT_L(0); PG8_BAR; PG8_MMA(1, 0, At, B0); PG8_MMA(1, 1, At, B1); PG8_BAR; PG8_SCHED;
        }
        if (wr == 0) PG8_BAR;
        epilogue(g, acc, cur);
        if (!has_next) break;
#pragma unroll
        for (int a = 0; a < 2; ++a)
#pragma unroll
            for (int b = 0; b < 2; ++b)
#pragma unroll
                for (int m = 0; m < 4; ++m)
#pragma unroll
                    for (int n = 0; n < 2; ++n) acc[a][b][m][n] = (f32x4){0.f, 0.f, 0.f, 0.f};
        cur = nxt; cA = nA; cB = nB; ++ui;
        if (wr == 1) PG8_BAR;
    }
    PG8_WAIT_V(0);
    PG8_BAR;
#undef PG8_SA
#undef PG8_SB
#undef PG8_STAGE
#undef PG8_LDA
#undef PG8_LDB
#undef PG8_MMA
#undef PG8_WAIT_V
#undef PG8_WAIT_L
#undef PG8_BAR
#undef PG8_SCHED
}
}

#define XB_TMO      128
#define XB_XCNT(j)  (256  + 64 * (j))
#define XB_XSUB(j)  (1280 + 64 * (j))
#define XB_XGEN(j)  (2304 + 64 * (j))
#define XB_TOP      3328
#define XB_TOPGEN   3392
#define XCD_BAR_WORDS 3456
#define XB_SPIN_CAP (1u << 22)
__device__ __forceinline__ unsigned xb_ld(unsigned* p)              { return __hip_atomic_load(p, __ATOMIC_RELAXED, __HIP_MEMORY_SCOPE_AGENT); }
__device__ __forceinline__ unsigned xb_add(unsigned* p, unsigned v) { return __hip_atomic_fetch_add(p, v, __ATOMIC_RELAXED, __HIP_MEMORY_SCOPE_AGENT); }
__device__ __forceinline__ unsigned xb_xcc_id() { return (unsigned)__builtin_amdgcn_s_getreg((3 << 11) | 20) & 0xFu; }
#define XB_SPIN(cond, bar) do { unsigned _sp = 0; while (cond) { __builtin_amdgcn_s_sleep(1); \
    if ((++_sp & 255u) == 0u) { if (xb_ld(&(bar)[XB_TMO])) break; if (_sp > XB_SPIN_CAP) { atomicAdd(&(bar)[XB_TMO], 1u); break; } } } } while (0)
struct XcdBarrier { unsigned* bar; unsigned x; volatile LAS unsigned* st; };
__device__ __forceinline__ XcdBarrier xcd_barrier_post(unsigned* bar, volatile LAS unsigned* st) {
    XcdBarrier b; b.bar = bar; b.x = xb_xcc_id(); b.st = st;
    if (threadIdx.x == 0) (void)xb_add(&bar[XB_XCNT(b.x)], 1u);
    return b;
}
__device__ __forceinline__ void xcd_barrier_complete(unsigned* bar, unsigned x, unsigned& nloc, unsigned& nx) {
    const unsigned G = gridDim.x * gridDim.y * gridDim.z;
    unsigned sum, cnt, mine, sp = 0u;
    for (;;) {
        sum = 0u; cnt = 0u; mine = 0u;
#pragma unroll
        for (unsigned j = 0; j < 16; ++j) { const unsigned c = xb_ld(&bar[XB_XCNT(j)]); sum += c; cnt += (c > 0u) ? 1u : 0u; mine = (j == x) ? c : mine; }
        if (sum == G) break;
        __builtin_amdgcn_s_sleep(1);
        if ((++sp & 255u) == 0u) { if (xb_ld(&bar[XB_TMO])) break; if (sp > XB_SPIN_CAP) { atomicAdd(&bar[XB_TMO], 1u); break; } }
    }
    nloc = mine > 0u ? mine : 1u; nx = cnt > 0u ? cnt : 1u;
}
__device__ __forceinline__ void xcd_barrier(const XcdBarrier& b) {
    asm volatile("s_waitcnt vmcnt(0)" ::: "memory");
    __syncthreads();
    if (threadIdx.x == 0) {
        unsigned* bar = b.bar;
        __builtin_amdgcn_s_waitcnt(0);
        unsigned nloc = b.st[0], nx = b.st[1];
        if (nloc == 0u) { xcd_barrier_complete(bar, b.x, nloc, nx); b.st[0] = nloc; b.st[1] = nx; }
        const unsigned old = xb_add(&bar[XB_XSUB(b.x)], 1u);
        const unsigned gen = old / nloc;
        if (old + 1u == (gen + 1u) * nloc) {
            __builtin_amdgcn_fence(__ATOMIC_RELEASE, "agent");
            asm volatile("s_waitcnt vmcnt(0)" ::: "memory");
            const unsigned og = xb_add(&bar[XB_TOP], 1u);
            const unsigned tg = og / nx;
            if (og + 1u == (tg + 1u) * nx) xb_add(&bar[XB_TOPGEN], 1u);
            else XB_SPIN(xb_ld(&bar[XB_TOPGEN]) == tg, bar);
            __builtin_amdgcn_fence(__ATOMIC_ACQUIRE, "agent");
            xb_add(&bar[XB_XGEN(b.x)], 1u);
            asm volatile("s_waitcnt vmcnt(0)" ::: "memory");
        } else {
            XB_SPIN(xb_ld(&bar[XB_XGEN(b.x)]) == gen, bar);
            __builtin_amdgcn_fence(__ATOMIC_ACQUIRE, "agent");
            asm volatile("s_waitcnt vmcnt(0)" ::: "memory");
        }
    }
    __syncthreads();
}

struct Params {
    const float* in[27];
    float* out;
    unsigned char* ws;
};

struct Ctx { LAS unsigned char* lds; int tid, lane, wid, G, bx, vc; };

__device__ __forceinline__ bool wdesc(int i, const Params& p, const float*& src, bf16_t*& dst, int& K, int& N, int& glu) {
    unsigned char* ws = p.ws; glu = 0;
    if (i < 4) { src = p.in[5] + (size_t)i * DM * FF; dst = (bf16_t*)(ws + (i < 2 ? WS_UP01 : WS_UP23)) + (size_t)(i & 1) * DM * FF; K = DM; N = FF; return true; }
    if (i < 8) { const int l = i - 4; src = p.in[6] + (size_t)l * DM * FF; dst = (bf16_t*)(ws + (l < 2 ? WS_DN01 : WS_DN23)) + (size_t)(l & 1) * DM * FF; K = FF; N = DM; return true; }
    if (i < 10) { const int l = i - 8; src = p.in[7] + (size_t)l * DM * DM; dst = (bf16_t*)(ws + WS_WIN) + (size_t)l * DM * DM; K = DM; N = DM; return true; }
    if (i < 12) { const int l = i - 10; src = p.in[16] + (size_t)l * DM * 2 * DM; dst = (bf16_t*)(ws + WS_GLU) + (size_t)l * DM * 2 * DM; K = DM; N = 2 * DM; glu = 1; return true; }
    if (i < 13) { src = p.in[18]; dst = (bf16_t*)(ws + WS_KVW); K = DM; N = 2 * DM; return true; }
    if (i < 15) { const int l = i - 13; src = p.in[19] + (size_t)l * DM * DM; dst = (bf16_t*)(ws + WS_QW) + (size_t)l * DM * DM; K = DM; N = DM; return true; }
    if (i < 17) { const int l = i - 15; src = p.in[25] + (size_t)l * DM * DM; dst = (bf16_t*)(ws + WS_OW) + (size_t)l * DM * DM; K = DM; N = DM; return true; }
    return false;
}
__device__ __forceinline__ bool wlocate(int f, const Params& p, const float*& src, bf16_t*& dst, int& K, int& N, int& n0, int& k0, int& sc0) {
    int base = 0;
    for (int i = 0; ; ++i) {
        int glu;
        if (!wdesc(i, p, src, dst, K, N, glu)) return false;
        const int ntk = K >> 6, nt = ntk * (N >> 6);
        if (f < base + nt) { const int t = f - base; n0 = (t / ntk) << 6; k0 = (t % ntk) << 6;
            sc0 = glu ? (((n0 >> 7) & 1) * DM + (n0 >> 8) * 128 + (n0 & 127)) : n0; return true; }
        base += nt;
    }
}
constexpr int NCONV_TILES = 11264;
__device__ void convert_weights(const Ctx& c, const Params& p) {
    LAS float* T = (LAS float*)c.lds;
    int f, fstep, fend;
    if (c.G == 256) { if (c.bx < 128) { f = c.bx; fstep = 128; fend = 128 * 38; } else { f = 128 * 38 + (c.bx - 128); fstep = 128; fend = NCONV_TILES; } }
    else { f = c.bx; fstep = c.G; fend = NCONV_TILES; }
    const float* src; bf16_t* dst; int K, N, n0, k0, sc0;
    bool have = (f < fend) && wlocate(f, p, src, dst, K, N, n0, k0, sc0);
    f32x4 v0, v1;
    const int ctid = opaque_tid(); const int kk = ctid >> 4, c4 = (ctid & 15) * 4;
    if (have) { v0 = *(const f32x4*)(src + (size_t)(k0 + kk) * N + sc0 + c4); v1 = *(const f32x4*)(src + (size_t)(k0 + 32 + kk) * N + sc0 + c4); }
    int par = 0;
    while (have) {
        const f32x4 a0 = v0, a1 = v1; bf16_t* cdst = dst; const int cK = K, cn0 = n0, ck0 = k0;
        f += fstep;
        have = (f < fend) && wlocate(f, p, src, dst, K, N, n0, k0, sc0);
        if (have) { v0 = *(const f32x4*)(src + (size_t)(k0 + kk) * N + sc0 + c4); v1 = *(const f32x4*)(src + (size_t)(k0 + 32 + kk) * N + sc0 + c4); }
        LAS float* Tb = T + par * (64 * 65);
        Tb[(c4 + 0) * 65 + kk] = a0[0]; Tb[(c4 + 1) * 65 + kk] = a0[1]; Tb[(c4 + 2) * 65 + kk] = a0[2]; Tb[(c4 + 3) * 65 + kk] = a0[3];
        Tb[(c4 + 0) * 65 + 32 + kk] = a1[0]; Tb[(c4 + 1) * 65 + 32 + kk] = a1[1]; Tb[(c4 + 2) * 65 + 32 + kk] = a1[2]; Tb[(c4 + 3) * 65 + 32 + kk] = a1[3];
        __syncthreads();
        { const int nn = ctid >> 3, k8 = (ctid & 7) * 8; const LAS float* r = Tb + nn * 65 + k8;
          u32x4 w; w.x = cvt_pk_bf16(r[0], r[1]); w.y = cvt_pk_bf16(r[2], r[3]); w.z = cvt_pk_bf16(r[4], r[5]); w.w = cvt_pk_bf16(r[6], r[7]);
          *(u32x4*)(cdst + (size_t)(cn0 + nn) * cK + ck0 + k8) = w; }
        par ^= 1;
    }
    __syncthreads();
}

__device__ void ssm_tables(const Ctx& c, const Params& p, int layer, int g) {
    LAS float* lamp = (LAS float*)c.lds;
    LAS float* bbar = lamp + 33 * 64 * 2;
    LAS float* ccp = bbar + 64 * 16 * 2;
    LAS float* Kt = ccp + 16 * 64 * 2;
    LAS float* coef = Kt + 32 * 256;
    const int tid = opaque_tid();
    const size_t lg = (size_t)layer * NG + g;
    if (tid < 64) {
        const int pp = tid;
        const float dt = expf(p.in[10][lg]);
        const float lr = p.in[8][lg * NP + pp], li = p.in[9][lg * NP + pp];
        const float mag = expf(lr * dt), ar = mag * cosf(li * dt), ai = mag * sinf(li * dt);
        const float den = lr * lr + li * li;
        coef[pp * 2] = ((ar - 1.0f) * lr + ai * li) / den; coef[pp * 2 + 1] = (ai * lr - (ar - 1.0f) * li) / den;
        float pr = 1.0f, pi = 0.0f; asm volatile("" : "+v"(pr), "+v"(pi));
        for (int k = 0; k <= 32; ++k) { lamp[(k * 64 + pp) * 2] = pr; lamp[(k * 64 + pp) * 2 + 1] = pi; const float nr = pr * ar - pi * ai, ni = pr * ai + pi * ar; pr = nr; pi = ni; }
        float* lamL = (float*)(p.ws + WS_LAML) + (lg * NP + pp) * 2;
        lamL[0] = lamp[(32 * 64 + pp) * 2]; lamL[1] = lamp[(32 * 64 + pp) * 2 + 1];
    }
    __syncthreads();
    for (int e = tid; e < 1024; e += 512) {
        const int pp = e >> 4, cc = e & 15;
        const float br = p.in[11][lg * 1024 + e], bi = p.in[12][lg * 1024 + e], cr = coef[pp * 2], ci = coef[pp * 2 + 1];
        bbar[e * 2] = cr * br - ci * bi; bbar[e * 2 + 1] = cr * bi + ci * br;
        ccp[e * 2] = p.in[13][lg * 1024 + e]; ccp[e * 2 + 1] = p.in[14][lg * 1024 + e];
        (void)cc;
    }
    __syncthreads();
    {
        const int k = tid >> 4, co = tid & 15;
        float acc16[16];
#pragma unroll
        for (int q = 0; q < 16; ++q) acc16[q] = 0.f;
        for (int pp = 0; pp < 64; ++pp) {
            const float lr = lamp[(k * 64 + pp) * 2], li = lamp[(k * 64 + pp) * 2 + 1], cr = ccp[(co * 64 + pp) * 2], ci = ccp[(co * 64 + pp) * 2 + 1];
            const float wr = cr * lr - ci * li, wi = cr * li + ci * lr;
            const LAS f32x4* bb = (const LAS f32x4*)(bbar + pp * 32);
#pragma unroll
            for (int q = 0; q < 8; ++q) { const f32x4 b = bb[q]; acc16[2 * q] += wr * b[0] - wi * b[1]; acc16[2 * q + 1] += wr * b[2] - wi * b[3]; }
        }
#pragma unroll
        for (int q = 0; q < 16; ++q) Kt[(k * 16 + co) * 16 + q] = acc16[q];
    }
    __syncthreads();
    bf16_t* Tm = (bf16_t*)(p.ws + WS_TM) + (size_t)layer * NG * 512 * UGP + (size_t)g * 512 * UGP;
    for (int e = tid; e < 512 * 80; e += 512) {
        const int row = e / 80, ch = e % 80, j = row >> 4, co = row & 15;
        float v[8];
        if (ch < 64) { const int i = ch >> 1, ci0 = (ch & 1) * 8;
#pragma unroll
            for (int q = 0; q < 8; ++q) v[q] = (i <= j) ? Kt[((j - i) * 16 + co) * 16 + ci0 + q] : 0.f;
        } else { const int p0 = (ch - 64) * 8;
#pragma unroll
            for (int q = 0; q < 8; ++q) { const int pq = p0 + q, pp = pq & 63;
                const float lr = lamp[((j + 1) * 64 + pp) * 2], li = lamp[((j + 1) * 64 + pp) * 2 + 1], cr = ccp[(co * 64 + pp) * 2], ci = ccp[(co * 64 + pp) * 2 + 1];
                v[q] = pq < 64 ? (cr * lr - ci * li) : -(cr * li + ci * lr); }
        }
        u32x4 w; w.x = cvt_pk_bf16(v[0], v[1]); w.y = cvt_pk_bf16(v[2], v[3]); w.z = cvt_pk_bf16(v[4], v[5]); w.w = cvt_pk_bf16(v[6], v[7]);
        *(u32x4*)(Tm + (size_t)row * UGP + ch * 8) = w;
    }
    bf16_t* Sin = (bf16_t*)(p.ws + WS_SIN) + (size_t)layer * NG * 128 * 512 + (size_t)g * 128 * 512;
    for (int e = tid; e < 128 * 64; e += 512) {
        const int row = e >> 6, ch = e & 63, pp = row & 63, i = ch >> 1, ci0 = (ch & 1) * 8;
        const float lr = lamp[((31 - i) * 64 + pp) * 2], li = lamp[((31 - i) * 64 + pp) * 2 + 1];
        float v[8];
#pragma unroll
        for (int q = 0; q < 8; ++q) { const float br = bbar[(pp * 16 + ci0 + q) * 2], bi = bbar[(pp * 16 + ci0 + q) * 2 + 1]; v[q] = row < 64 ? (lr * br - li * bi) : (lr * bi + li * br); }
        u32x4 w; w.x = cvt_pk_bf16(v[0], v[1]); w.y = cvt_pk_bf16(v[2], v[3]); w.z = cvt_pk_bf16(v[4], v[5]); w.w = cvt_pk_bf16(v[6], v[7]);
        *(u32x4*)(Sin + (size_t)row * 512 + ch * 8) = w;
    }
    __syncthreads();
}

__device__ void small_tables(const Ctx& c, const Params& p) {
    float* bt = (float*)(p.ws + WS_BIAS);
    const int stid = opaque_tid();
    for (int e = stid; e < 8 * 128; e += 512) {
        const int h = e >> 7, n = e & 127;
        int bk = n;
        if (n >= 16) { const int th[16] = {16, 19, 21, 24, 27, 31, 35, 40, 46, 52, 59, 67, 77, 87, 99, 113}; bk = 15;
#pragma unroll
            for (int q = 0; q < 16; ++q) bk += (n >= th[q]) ? 1 : 0; }
        bt[e] = (p.in[26][bk * 8 + h] - p.in[26][31 * 8 + h]) * LOG2E;
    }
    if (stid < 2) {
        const int j = stid; float s1 = 0.f, s2 = 0.f;
        for (int q = 0; q < 64; ++q) { s1 += p.in[20][j * 64 + q] * p.in[21][j * 64 + q]; s2 += p.in[22][j * 64 + q] * p.in[23][j * 64 + q]; }
        const float li = 0.8f - 0.6f * expf(-0.3f * (float)(j + 2));
        float* sc = (float*)(p.ws + WS_SCAL) + j * 4;
        sc[0] = expf(s1) - expf(s2) + li; sc[1] = 1.0f - li; sc[2] = 0.f; sc[3] = 0.f;
    }
}

__device__ void norm_phase(const Ctx& c, const void* xin_, int xin_f32, void* xout_, int xout_f32, const bf16_t* mix, const float* gpost, const float* gpre, bf16_t* hout, const float* gkv, bf16_t* hkv) {
    const float* xin = (const float*)xin_; const bf16_t* xin16 = (const bf16_t*)xin_; float* xout = (float*)xout_; bf16_t* xout16 = (bf16_t*)xout_;
    const int tid_ = opaque_tid(), lane = tid_ & 63, wid_ = __builtin_amdgcn_readfirstlane(tid_ >> 6);
    for (int r0 = (wid_ * c.G + c.bx) * 4; r0 < TOK; r0 += 8 * c.G * 4) {
        f32x4 xv[4][4]; u32x4 xw[4][2]; u32x4 mw[4][2];
        if (xin_f32) {
#pragma unroll
            for (int rr = 0; rr < 4; ++rr)
#pragma unroll
                for (int k = 0; k < 2; ++k) { const float* xp = xin + (size_t)(r0 + rr) * DM + k * 512 + lane * 8; xv[rr][2 * k] = *(const f32x4*)xp; xv[rr][2 * k + 1] = *(const f32x4*)(xp + 4); }
        } else {
#pragma unroll
            for (int rr = 0; rr < 4; ++rr)
#pragma unroll
                for (int k = 0; k < 2; ++k) xw[rr][k] = *(const u32x4*)(xin16 + (size_t)(r0 + rr) * DM + k * 512 + lane * 8);
        }
        if (mix) {
#pragma unroll
            for (int rr = 0; rr < 4; ++rr)
#pragma unroll
                for (int k = 0; k < 2; ++k) mw[rr][k] = *(const u32x4*)(mix + (size_t)(r0 + rr) * DM + k * 512 + lane * 8);
        }
#pragma unroll
        for (int rr = 0; rr < 4; ++rr) {
            const int row = r0 + rr;
            float x[16];
            if (xin_f32) {
#pragma unroll
                for (int q = 0; q < 4; ++q)
#pragma unroll
                    for (int e = 0; e < 4; ++e) x[q * 4 + e] = xv[rr][q][e];
            } else {
#pragma unroll
                for (int k = 0; k < 2; ++k) { const u32x4 w = xw[rr][k];
                    x[k * 8 + 0] = bf_lo(w.x); x[k * 8 + 1] = bf_hi(w.x); x[k * 8 + 2] = bf_lo(w.y); x[k * 8 + 3] = bf_hi(w.y); x[k * 8 + 4] = bf_lo(w.z); x[k * 8 + 5] = bf_hi(w.z); x[k * 8 + 6] = bf_lo(w.w); x[k * 8 + 7] = bf_hi(w.w); }
            }
            if (mix) {
                float mv[16]; float ss = 0.f;
#pragma unroll
                for (int k = 0; k < 2; ++k) { const u32x4 w = mw[rr][k];
                    mv[k * 8 + 0] = bf_lo(w.x); mv[k * 8 + 1] = bf_hi(w.x); mv[k * 8 + 2] = bf_lo(w.y); mv[k * 8 + 3] = bf_hi(w.y); mv[k * 8 + 4] = bf_lo(w.z); mv[k * 8 + 5] = bf_hi(w.z); mv[k * 8 + 6] = bf_lo(w.w); mv[k * 8 + 7] = bf_hi(w.w); }
#pragma unroll
                for (int e = 0; e < 16; ++e) ss += mv[e] * mv[e];
                ss = wave_sum(ss);
                const float rs = rsqrtf(ss * (1.0f / DM) + EPS);
#pragma unroll
                for (int k = 0; k < 2; ++k) { const float* gp = gpost + k * 512 + lane * 8; const f32x4 ga = *(const f32x4*)gp, gb = *(const f32x4*)(gp + 4);
#pragma unroll
                    for (int e = 0; e < 4; ++e) { x[k * 8 + e] += mv[k * 8 + e] * rs * ga[e]; x[k * 8 + 4 + e] += mv[k * 8 + 4 + e] * rs * gb[e]; }
                    if (xout_f32) { float* xo = xout + (size_t)row * DM + k * 512 + lane * 8;
                        *(f32x4*)xo = (f32x4){x[k * 8 + 0], x[k * 8 + 1], x[k * 8 + 2], x[k * 8 + 3]}; *(f32x4*)(xo + 4) = (f32x4){x[k * 8 + 4], x[k * 8 + 5], x[k * 8 + 6], x[k * 8 + 7]}; }
                    else { u32x4 wx; wx.x = cvt_pk_bf16(x[k * 8 + 0], x[k * 8 + 1]); wx.y = cvt_pk_bf16(x[k * 8 + 2], x[k * 8 + 3]); wx.z = cvt_pk_bf16(x[k * 8 + 4], x[k * 8 + 5]); wx.w = cvt_pk_bf16(x[k * 8 + 6], x[k * 8 + 7]);
                        *(u32x4*)(xout16 + (size_t)row * DM + k * 512 + lane * 8) = wx;
                        x[k * 8 + 0] = bf_lo(wx.x); x[k * 8 + 1] = bf_hi(wx.x); x[k * 8 + 2] = bf_lo(wx.y); x[k * 8 + 3] = bf_hi(wx.y); x[k * 8 + 4] = bf_lo(wx.z); x[k * 8 + 5] = bf_hi(wx.z); x[k * 8 + 6] = bf_lo(wx.w); x[k * 8 + 7] = bf_hi(wx.w); } }
            }
            if (gpre) {
                float ss = 0.f;
#pragma unroll
                for (int e = 0; e < 16; ++e) ss += x[e] * x[e];
                ss = wave_sum(ss);
                const float rs = rsqrtf(ss * (1.0f / DM) + EPS);
#pragma unroll
                for (int k = 0; k < 2; ++k) { const float* gp = gpre + k * 512 + lane * 8; const f32x4 ga = *(const f32x4*)gp, gb = *(const f32x4*)(gp + 4);
                    u32x4 w; w.x = cvt_pk_bf16(x[k * 8 + 0] * rs * ga[0], x[k * 8 + 1] * rs * ga[1]); w.y = cvt_pk_bf16(x[k * 8 + 2] * rs * ga[2], x[k * 8 + 3] * rs * ga[3]);
                    w.z = cvt_pk_bf16(x[k * 8 + 4] * rs * gb[0], x[k * 8 + 5] * rs * gb[1]); w.w = cvt_pk_bf16(x[k * 8 + 6] * rs * gb[2], x[k * 8 + 7] * rs * gb[3]);
                    *(u32x4*)(hout + (size_t)row * DM + k * 512 + lane * 8) = w;
                    if (gkv) { const float* kp = gkv + k * 512 + lane * 8; const f32x4 ka = *(const f32x4*)kp, kb = *(const f32x4*)(kp + 4);
                        u32x4 w2; w2.x = cvt_pk_bf16(x[k * 8 + 0] * rs * ka[0], x[k * 8 + 1] * rs * ka[1]); w2.y = cvt_pk_bf16(x[k * 8 + 2] * rs * ka[2], x[k * 8 + 3] * rs * ka[3]);
                        w2.z = cvt_pk_bf16(x[k * 8 + 4] * rs * kb[0], x[k * 8 + 5] * rs * kb[1]); w2.w = cvt_pk_bf16(x[k * 8 + 6] * rs * kb[2], x[k * 8 + 7] * rs * kb[3]);
                        *(u32x4*)(hkv + (size_t)row * DM + k * 512 + lane * 8) = w2; } }
            }
        }
    }
}

__device__ void scan_phase(const Ctx& c, const Params& p, int layer) {
    const float* Z = (const float*)(p.ws + WS_Z); bf16_t* Ug = (bf16_t*)(p.ws + WS_UG);
    const float* lamL = (const float*)(p.ws + WS_LAML) + (size_t)layer * NG * NP * 2;
    const int tid_ = opaque_tid(), wid_ = __builtin_amdgcn_readfirstlane(tid_ >> 6);
    for (int pr = wid_ * c.G + c.bx; pr < 4 * NG; pr += 8 * c.G) {
        const int b = pr >> 6, g = pr & 63, pp = tid_ & 63;
        const float lr = lamL[(g * NP + pp) * 2], li = lamL[(g * NP + pp) * 2 + 1];
        float sr = 0.f, si = 0.f;
        const size_t row0 = (size_t)g * NCH + b * 256;
#pragma unroll 8
        for (int ch = 0; ch < 256; ++ch) {
            const float zr = Z[(row0 + ch) * 128 + pp], zi = Z[(row0 + ch) * 128 + 64 + pp];
            bf16_t* o = Ug + (row0 + ch) * UGP + 512 + pp;
            const unsigned w = cvt_pk_bf16(sr, si);
            o[0] = (bf16_t)(w & 0xffffu); o[64] = (bf16_t)(w >> 16);
            const float nr = lr * sr - li * si + zr, ni = lr * si + li * sr + zi; sr = nr; si = ni;
        }
    }
}

__device__ void scan_after_z(const Ctx& c, const Params& p, int layer) {
    asm volatile("s_waitcnt vmcnt(0)" ::: "memory"); __syncthreads();
    __builtin_amdgcn_fence(__ATOMIC_ACQUIRE, "agent");
    asm volatile("s_waitcnt vmcnt(0)" ::: "memory");
    const float* Z = (const float*)(p.ws + WS_Z); bf16_t* Ug = (bf16_t*)(p.ws + WS_UG);
    const float* lamL = (const float*)(p.ws + WS_LAML) + (size_t)layer * NG * NP * 2;
    const int tid_ = opaque_tid(), wid_ = __builtin_amdgcn_readfirstlane(tid_ >> 6), pp = tid_ & 63;
    for (int i = wid_; ; i += 8) {
        const int L = i * c.G + c.vc; if (L >= 4 * NG) break;
        const int g = L >> 2, b = L & 3;
        const float lr = lamL[(g * NP + pp) * 2], li = lamL[(g * NP + pp) * 2 + 1];
        float sr = 0.f, si = 0.f;
        const size_t row0 = (size_t)g * NCH + b * 256;
#pragma unroll 8
        for (int ch = 0; ch < 256; ++ch) {
            const float zr = Z[(row0 + ch) * 128 + pp], zi = Z[(row0 + ch) * 128 + 64 + pp];
            bf16_t* o = Ug + (row0 + ch) * UGP + 512 + pp;
            const unsigned w = cvt_pk_bf16(sr, si);
            o[0] = (bf16_t)(w & 0xffffu); o[64] = (bf16_t)(w >> 16);
            const float nr = lr * sr - li * si + zr, ni = lr * si + li * sr + zi; sr = nr; si = ni;
        }
    }
}

#define ATTN_DMA(gp, ldsoff) __builtin_amdgcn_global_load_lds((const unsigned*)(gp), (LAS unsigned*)(lds + (ldsoff)), 16, 0, 0)
#define ATTN_PV(PB, VBASE) do { \
    bf16x8 fa__[8], fb__[8]; \
    _Pragma("unroll") for (int q_ = 0; q_ < 8; ++q_) fa__[q_] = *(LAS const bf16x8*)((VBASE) + (q_ >> 2) * 4096 + vo[q_ & 3]); \
    __builtin_amdgcn_sched_barrier(0); \
    _Pragma("unroll") for (int q_ = 0; q_ < 8; ++q_) fb__[q_] = *(LAS const bf16x8*)((VBASE) + (2 + (q_ >> 2)) * 4096 + vo[q_ & 3]); \
    _Pragma("unroll") for (int q_ = 0; q_ < 8; ++q_) o[q_ & 1] = __builtin_amdgcn_mfma_f32_32x32x16_bf16(fa__[(q_ & 1) * 4 + (q_ >> 1)], PB[q_ >> 1], o[q_ & 1], 0, 0, 0); \
    __builtin_amdgcn_sched_barrier(0); \
    _Pragma("unroll") for (int q_ = 0; q_ < 8; ++q_) o[2 + (q_ & 1)] = __builtin_amdgcn_mfma_f32_32x32x16_bf16(fb__[(q_ & 1) * 4 + (q_ >> 1)], PB[q_ >> 1], o[2 + (q_ & 1)], 0, 0, 0); \
    __builtin_amdgcn_sched_barrier(0); } while (0)
#define ATTN_QK(P0, P1, KB) do { \
    bf16x8 kf_[4]; \
    _Pragma("unroll") for (int d0 = 0; d0 < 4; ++d0) kf_[d0] = *(LAS const bf16x8*)((KB) + ko[d0]); \
    __builtin_amdgcn_sched_barrier(0); \
    P0 = __builtin_amdgcn_mfma_f32_32x32x16_bf16(kf_[0], qf[0], negm, 0, 0, 0); \
    _Pragma("unroll") for (int d0 = 1; d0 < 4; ++d0) P0 = __builtin_amdgcn_mfma_f32_32x32x16_bf16(kf_[d0], qf[d0], P0, 0, 0, 0); \
    __builtin_amdgcn_sched_barrier(0); \
    _Pragma("unroll") for (int d0 = 0; d0 < 4; ++d0) kf_[d0] = *(LAS const bf16x8*)((KB) + 8192 + ko[d0]); \
    __builtin_amdgcn_sched_barrier(0); \
    P1 = __builtin_amdgcn_mfma_f32_32x32x16_bf16(kf_[0], qf[0], negm, 0, 0, 0); \
    _Pragma("unroll") for (int d0 = 1; d0 < 4; ++d0) P1 = __builtin_amdgcn_mfma_f32_32x32x16_bf16(kf_[d0], qf[d0], P1, 0, 0, 0); \
    __builtin_amdgcn_sched_barrier(0); } while (0)
#define ATTN_BAND(P0, P1, DD) do { \
    __builtin_amdgcn_sched_barrier(0); \
    _Pragma("unroll") for (int r = 0; r < 16; ++r) { const int d0_ = (DD) - (16 * (r >> 3) + (r & 7)); P0[r] += btab[1 + min(max(d0_, -1), 127)]; } \
    __builtin_amdgcn_sched_barrier(0); \
    _Pragma("unroll") for (int r = 0; r < 16; ++r) { const int d1_ = (DD) - 32 - (16 * (r >> 3) + (r & 7)); P1[r] += btab[1 + min(max(d1_, -1), 127)]; } \
    __builtin_amdgcn_sched_barrier(0); } while (0)
#define ATTN_EXP(P0, P1, PB) do { \
    float ls0_ = 0.f, ls1_ = 0.f; \
    _Pragma("unroll") for (int r = 0; r < 16; ++r) { P0[r] = fexp2(P0[r]); P1[r] = fexp2(P1[r]); ls0_ += P0[r]; ls1_ += P1[r]; } \
    lrun += ls0_ + ls1_; \
    _Pragma("unroll") for (int q = 0; q < 2; ++q) { u32x4 w0_, w1_; \
        w0_.x = cvt_pk_bf16(P0[q * 8 + 0], P0[q * 8 + 1]); w0_.y = cvt_pk_bf16(P0[q * 8 + 2], P0[q * 8 + 3]); w0_.z = cvt_pk_bf16(P0[q * 8 + 4], P0[q * 8 + 5]); w0_.w = cvt_pk_bf16(P0[q * 8 + 6], P0[q * 8 + 7]); \
        w1_.x = cvt_pk_bf16(P1[q * 8 + 0], P1[q * 8 + 1]); w1_.y = cvt_pk_bf16(P1[q * 8 + 2], P1[q * 8 + 3]); w1_.z = cvt_pk_bf16(P1[q * 8 + 4], P1[q * 8 + 5]); w1_.w = cvt_pk_bf16(P1[q * 8 + 6], P1[q * 8 + 7]); \
        PB[q] = __builtin_bit_cast(bf16x8, w0_); PB[2 + q] = __builtin_bit_cast(bf16x8, w1_); } } while (0)
__device__ void attn_phase(const Ctx& c, const bf16_t* Q, const bf16_t* Kg, const bf16_t* Vt, bf16_t* ON, const float* biasT, const float* scal, const float* hn) {
    constexpr int SUB = 16384, STAGE = 32768, V_OFF = 65536, BT_OFF = 131072 + 128;
    LAS unsigned char* lds = c.lds;
    LAS unsigned char* ldsr = lds; asm volatile("" : "+s"(ldsr) :: "memory");
    for (int itu = 0; ; ++itu) {
        const int L = itu * c.G + c.vc; if (L >= 2048) break;
        const int tid = opaque_tid(), lane = tid & 63, wid = __builtin_amdgcn_readfirstlane(tid >> 6), br = wid >> 2, wq = wid & 3, l31 = lane & 31, hi = lane >> 5;
        const int prow = (l31 & ~12) | ((l31 & 4) << 1) | ((l31 & 8) >> 1);
        const int kbase = prow * 256, kx0 = (br * 8 + hi) ^ (prow & 15);
        const int vbase = V_OFF + l31 * 128, vx0 = hi ^ ((l31 >> 1) & 7);
        int ko[4], vo[4];
#pragma unroll
        for (int q = 0; q < 4; ++q) { ko[q] = (kx0 ^ (q << 1)) << 4; vo[q] = (vx0 ^ (q << 1)) << 4; }
        const int kr0 = 4 * wid + (lane >> 4), kc = (lane & 15) ^ (kr0 & 15);
        const int vr0 = 8 * wid + (lane >> 3), vcx = (lane & 7) ^ ((vr0 >> 1) & 7);
        const int dst0 = wid * 1024, dst1 = (wid + 8) * 1024;
        LAS const float* btab = (LAS const float*)(lds + BT_OFF);
        const int i7 = 7 - (L >> 8), pair = (L & 255) >> 3, jj8 = L & 7;
        const int qb = (i7 & 1) ? (16 * (i7 >> 1) + 15 - jj8) : (16 * (i7 >> 1) + jj8);
        const int b = pair >> 3, h = pair & 7, q0 = qb * 128, NI = qb + 1;
        const size_t tokb = (size_t)b * SEQ;
        const bf16_t* kg = Kg + (tokb + kr0) * DM + h * 128 + kc * 8;
        const bf16_t* vg = Vt + ((size_t)((b * 8 + h) * 128) << 13) + vr0 * 64 + vcx * 8;
        const bf16_t* qp = Q + (tokb + q0 + wq * 32 + l31) * DM + h * 128 + br * 64 + hi * 8;
        bf16x8 qf[4];
#pragma unroll
        for (int d0 = 0; d0 < 4; ++d0) qf[d0] = *(const bf16x8*)(qp + d0 * 16);
        if (tid < 128) ((LAS float*)(lds + BT_OFF))[1 + tid] = biasT[h * 128 + tid];
        if (tid == 128) ((LAS float*)(lds + BT_OFF))[0] = -1e30f;
#pragma unroll
        for (int sb = 0; sb < 2; ++sb) {
            ATTN_DMA(kg + (size_t)sb * 64 * DM, sb * SUB + dst0); ATTN_DMA(kg + (size_t)(sb * 64 + 32) * DM, sb * SUB + dst1);
            ATTN_DMA(vg + (size_t)sb * 8192, V_OFF + sb * SUB + dst0); ATTN_DMA(vg + (size_t)sb * 8192 + 4096, V_OFF + sb * SUB + dst1);
        }
        f32x16 o[4], negm;
#pragma unroll
        for (int r = 0; r < 16; ++r) { o[0][r] = 0.f; o[1][r] = 0.f; o[2][r] = 0.f; o[3][r] = 0.f; negm[r] = 0.f; }
        float lrun = 0.f;
        const int qrow = q0 + wq * 32 + l31;
        for (int it = 0; it < NI; ++it) {
            const int st = it & 1, kt0 = it * 128;
            asm volatile("s_waitcnt vmcnt(0) lgkmcnt(0)\n\ts_barrier" ::: "memory");
            if (it + 1 < NI) { const int s2 = (st ^ 1) * STAGE;
#pragma unroll
                for (int sb = 0; sb < 2; ++sb) { const bf16_t* kn = kg + (size_t)(kt0 + 128 + sb * 64) * DM; const bf16_t* vn = vg + (size_t)((it + 1) * 2 + sb) * 8192;
                    ATTN_DMA(kn, s2 + sb * SUB + dst0); ATTN_DMA(kn + 32 * DM, s2 + sb * SUB + dst1);
                    ATTN_DMA(vn, V_OFF + s2 + sb * SUB + dst0); ATTN_DMA(vn + 4096, V_OFF + s2 + sb * SUB + dst1); } }
            LAS const unsigned char* kbp = ldsr + st * STAGE + kbase;
            LAS const unsigned char* vbp = ldsr + st * STAGE + vbase;
#pragma unroll
            for (int sb = 0; sb < 2; ++sb) {
                f32x16 pa0, pa1;
                ATTN_QK(pa0, pa1, kbp + sb * SUB);
                if (it >= NI - 2) { const int dd = qrow - kt0 - sb * 64 - 8 * hi; ATTN_BAND(pa0, pa1, dd); }
                float mxa = max3f(pa0[0], pa0[1], pa1[0]), mxb = max3f(pa0[2], pa0[3], pa1[1]); mxa = max3f(mxa, pa1[2], pa1[3]);
#pragma unroll
                for (int r = 4; r < 16; r += 4) { mxa = max3f(mxa, pa0[r], pa0[r + 1]); mxb = max3f(mxb, pa0[r + 2], pa0[r + 3]); mxa = max3f(mxa, pa1[r], pa1[r + 1]); mxb = max3f(mxb, pa1[r + 2], pa1[r + 3]); }
                float mx = max2f(mxa, mxb);
                { const auto rr_ = __builtin_amdgcn_permlane32_swap(__float_as_uint(mx), __float_as_uint(mx), false, false); mx = max2f(__uint_as_float(rr_[0]), __uint_as_float(rr_[1])); }
                if ((it == 0 && sb == 0) || __any(mx > 8.0f)) {
                    const float delta = (it == 0 && sb == 0) ? mx : fmaxf(mx, 0.f), alpha = fexp2(-delta); lrun *= alpha;
#pragma unroll
                    for (int r = 0; r < 16; ++r) { pa0[r] -= delta; pa1[r] -= delta; negm[r] -= delta; }
#pragma unroll
                    for (int q = 0; q < 4; ++q) o[q] = o[q] * alpha;
                }
                bf16x8 pk[4];
                ATTN_EXP(pa0, pa1, pk);
                ATTN_PV(pk, vbp + sb * SUB);
            }
        }
        __syncthreads();
        const int te = opaque_tid(), le31 = te & 31, hie = (te & 63) >> 5, wide = __builtin_amdgcn_readfirstlane(te >> 6), wqe = wide & 3;
        const float lam = scal[0], onem = scal[1];
        float inv = frcp(lrun + __shfl_xor(lrun, 32));
        if (wide >= 4) inv *= lam;
        LAS float* comb = (LAS float*)lds;
        if (wide >= 4) {
#pragma unroll
            for (int blk = 0; blk < 4; ++blk)
#pragma unroll
                for (int r = 0; r < 16; ++r) comb[(wqe * 128 + blk * 32 + (r & 3) + 8 * (r >> 2) + 4 * hie) * 32 + le31] = o[blk][r] * inv;
        }
        __syncthreads();
        if (wide < 4) {
            float ss = 0.f;
#pragma unroll
            for (int blk = 0; blk < 4; ++blk)
#pragma unroll
                for (int r = 0; r < 16; ++r) { const float v = o[blk][r] * inv - comb[(wqe * 128 + blk * 32 + (r & 3) + 8 * (r >> 2) + 4 * hie) * 32 + le31]; o[blk][r] = v; ss += v * v; }
            ss += __shfl_xor(ss, 32);
            const float rs = rsqrtf(ss * (1.0f / 128.0f) + EPS) * onem;
            bf16_t* op = ON + ((size_t)b * SEQ + q0 + wqe * 32 + le31) * DM + h * 128;
#pragma unroll
            for (int blk = 0; blk < 4; ++blk)
#pragma unroll
                for (int r4 = 0; r4 < 4; ++r4) { const int dv = blk * 32 + 8 * r4 + 4 * hie; const f32x4 g4 = *(const f32x4*)(hn + dv);
                    u32x2 w; w.x = cvt_pk_bf16(o[blk][r4 * 4 + 0] * rs * g4[0], o[blk][r4 * 4 + 1] * rs * g4[1]); w.y = cvt_pk_bf16(o[blk][r4 * 4 + 2] * rs * g4[2], o[blk][r4 * 4 + 3] * rs * g4[3]);
                    *(u32x2*)(op + dv) = w; }
        }
        __syncthreads();
    }
}
#undef ATTN_PV
#undef ATTN_QK
#undef ATTN_BAND
#undef ATTN_EXP
#undef ATTN_DMA

__global__ void __launch_bounds__(512, 2) yoco_fwd(Params p) {
    extern __shared__ __attribute__((aligned(16))) unsigned char lds_raw[];
    cg::grid_group grid = cg::this_grid();
    Ctx c; c.lds = (LAS unsigned char*)lds_raw; c.tid = threadIdx.x; c.lane = c.tid & 63; c.wid = __builtin_amdgcn_readfirstlane(c.tid >> 6);
    c.G = gridDim.x; c.bx = blockIdx.x; c.vc = (c.G % 8 == 0) ? (c.bx % 8) * (c.G / 8) + c.bx / 8 : c.bx;
    unsigned char* ws = p.ws;
    float* X = p.out;
    { volatile LAS unsigned* xst0 = (volatile LAS unsigned*)(c.lds + 131072); if (c.tid < 4) xst0[c.tid] = 0u; }
    __syncthreads();
    (void)xcd_barrier_post((unsigned*)(ws + WS_BAR), (volatile LAS unsigned*)(c.lds + 131072));
    bf16_t* HM = (bf16_t*)(ws + WS_HM); bf16_t* ACT = (bf16_t*)(ws + WS_ACT);
    bf16_t* UG = (bf16_t*)(ws + WS_UG); float* Zb = (float*)(ws + WS_Z); bf16_t* YG = (bf16_t*)(ws + WS_YG);
    bf16_t* Qb = (bf16_t*)(ws + WS_Q); bf16_t* ONb = (bf16_t*)(ws + WS_ON); bf16_t* HKV = (bf16_t*)(ws + WS_HKV);
    bf16_t* Kb = (bf16_t*)(ws + WS_K); bf16_t* Vtb = (bf16_t*)(ws + WS_VT);

    enum { K_PRO = 0, K_WIN = 1, K_Z = 2, K_SCAN = 3, K_Y = 4, K_GLU = 5, K_NORMA = 6, K_UP = 7, K_DOWN = 8, K_NORMB = 9, K_K = 10, K_VT = 11, K_Q = 12, K_ATTN = 13, K_O = 14 };
    for (int ph = 0; ph < 35; ++ph) {
        int kind, layer;
        if (ph == 0) { kind = K_PRO; layer = 0; }
        else if (ph < 19) { layer = (ph - 1) / 9; kind = 1 + (ph - 1) % 9; }
        else { int k; if (ph < 28) { layer = 2; k = ph - 19; } else { layer = 3; k = ph - 26; }
            kind = k < 3 ? K_K + k : (k == 3 ? K_ATTN : (k == 4 ? K_O : K_NORMA + (k - 5))); }
        const int j = layer & 1;
        if (kind == K_SCAN) continue;
        for (int rep = 0; rep < (((REPEAT_MASK >> kind) & 1) ? 2 : 1); ++rep) {
        { int t_ = threadIdx.x; asm volatile("" : "+v"(t_)); c.tid = t_; c.lane = t_ & 63; c.wid = __builtin_amdgcn_readfirstlane(t_ >> 6); }
        const bool is_gemm = (kind == K_WIN) | (kind == K_Z) | (kind == K_Y) | (kind == K_GLU) | (kind == K_UP) | (kind == K_DOWN) | (kind == K_K) | (kind == K_VT) | (kind == K_Q) | (kind == K_O);
        if (is_gemm) {
            pg8::Job jb; jb.lda = DM; jb.ldb = DM; jb.K = DM; jb.ord = pg8::ORD_STATIC; jb.M = TOK; jb.N = DM; jb.epi = pg8::EPI_STORE; jb.ldc = DM; jb.scale = 1.0f; jb.O = HM; jb.x1 = nullptr; jb.x2 = nullptr; jb.A = HM; jb.Bt = nullptr;
            switch (kind) {
            case K_WIN: jb.Bt = (const bf16_t*)(ws + WS_WIN) + (size_t)j * DM * DM; jb.epi = pg8::EPI_UG; jb.O = UG; break;
            case K_Z: jb.A = UG; jb.Bt = (const bf16_t*)(ws + WS_SIN) + (size_t)j * NG * 128 * 512; jb.lda = UGP; jb.ldb = 512; jb.K = 512; jb.ord = pg8::ORD_Z; jb.epi = pg8::EPI_Z; jb.O = Zb; break;
            case K_Y: jb.A = UG; jb.Bt = (const bf16_t*)(ws + WS_TM) + (size_t)j * NG * 512 * UGP; jb.lda = UGP; jb.ldb = UGP; jb.K = UGP; jb.ord = pg8::ORD_Y; jb.epi = pg8::EPI_Y; jb.O = YG; jb.x1 = UG; jb.x2 = p.in[15] + (size_t)j * DM; break;
            case K_GLU: jb.A = YG; jb.Bt = (const bf16_t*)(ws + WS_GLU) + (size_t)j * DM * 2 * DM; jb.N = 2 * DM; jb.epi = pg8::EPI_GLU; break;
            case K_UP: jb.Bt = (const bf16_t*)(ws + (layer < 2 ? WS_UP01 : WS_UP23)) + (size_t)j * DM * FF; jb.N = FF; jb.epi = pg8::EPI_RELU2; jb.O = ACT; jb.ldc = FF; break;
            case K_DOWN: jb.A = ACT; jb.Bt = (const bf16_t*)(ws + (layer < 2 ? WS_DN01 : WS_DN23)) + (size_t)j * DM * FF; jb.lda = FF; jb.ldb = FF; jb.K = FF; break;
            case K_K: jb.A = HKV; jb.Bt = (const bf16_t*)(ws + WS_KVW); jb.O = Kb; break;
            case K_VT: jb.A = (const bf16_t*)(ws + WS_KVW) + (size_t)DM * DM; jb.Bt = HKV; jb.M = DM; jb.N = TOK; jb.O = Vtb; jb.epi = pg8::EPI_VT; break;
            case K_Q: jb.Bt = (const bf16_t*)(ws + WS_QW) + (size_t)j * DM * DM; jb.O = Qb; jb.scale = 0.125f * LOG2E; break;
            default:   jb.A = ONb; jb.Bt = (const bf16_t*)(ws + WS_OW) + (size_t)j * DM * DM; break;
            }
#ifndef NO_GEMM
            pg8::gemm_phase(c.lds, jb, c.G, c.bx, c.vc, c.tid);
#endif
            if (kind == K_Z) scan_after_z(c, p, j);
        } else if (kind == K_NORMA || kind == K_NORMB || kind == K_PRO) {
            if (kind == K_PRO) {
#ifndef NO_TAB
                for (int u = c.bx; u < 2 * NG; u += c.G) ssm_tables(c, p, u >> 6, u & 63);
#endif
                if (c.bx == c.G - 1) small_tables(c, p);
#ifndef NO_CONV
                convert_weights(c, p);
#endif
            }
            const void* xin = X; void* xout = X; int xin_f32 = 0, xout_f32 = 0; const bf16_t* mix = HM; const float* gpost; const float* gpre; const float* gkv = nullptr;
            if (kind == K_PRO) { xin = p.in[0]; xin_f32 = 1; xout = nullptr; mix = nullptr; gpost = nullptr; gpre = p.in[1]; }
            else if (kind == K_NORMA) { if (layer == 0) { xin = p.in[0]; xin_f32 = 1; } if (layer == 3) xout = Kb; gpost = p.in[2] + layer * DM; gpre = p.in[3] + layer * DM; }
            else { gpost = p.in[4] + layer * DM; gpre = layer < 3 ? p.in[1] + (layer + 1) * DM : nullptr; if (layer == 1) gkv = p.in[17]; if (layer == 3) { xin = Kb; xout_f32 = 1; } }
#ifndef NO_NORM
            norm_phase(c, xin, xin_f32, xout, xout_f32, mix, gpost, gpre, HM, gkv, HKV);
#endif
        } else if (kind == K_SCAN) {
#ifndef NO_SCAN
            scan_phase(c, p, j);
#endif
        } else {
#ifndef NO_ATTN
            attn_phase(c, Qb, Kb, Vtb, ONb, (const float*)(ws + WS_BIAS), (const float*)(ws + WS_SCAL) + j * 4, p.in[24] + j * 128);
#endif
        }
        }
        if (!(kind == K_K || kind == K_VT || ph == 34)) { if (ph == 0) grid.sync(); else { XcdBarrier xb_; xb_.bar = (unsigned*)(ws + WS_BAR); xb_.x = xb_xcc_id(); xb_.st = (volatile LAS unsigned*)(c.lds + 131072); xcd_barrier(xb_); } }
    }
}

extern "C" void kernel_launch(void* const* d_in, const int* in_sizes, int n_in, void* d_out, int out_size, void* d_ws, size_t ws_size, hipStream_t stream) {
    static int grid_blocks = 0;
    if (grid_blocks == 0) {
        if (n_in != 27 || out_size != TOK * DM || ws_size < WS_END) { fprintf(stderr, "kernel_launch: unexpected shapes (n_in %d, out %d, ws %zu)\n", n_in, out_size, ws_size); grid_blocks = -1; return; }
        int dev = 0, cus = 0, per_cu = 0;
        hipGetDevice(&dev);
        hipDeviceGetAttribute(&cus, hipDeviceAttributeMultiprocessorCount, dev);
        if (hipFuncSetAttribute((const void*)yoco_fwd, hipFuncAttributeMaxDynamicSharedMemorySize, LDS_BYTES) != hipSuccess) { fprintf(stderr, "kernel_launch: hipFuncSetAttribute failed\n"); grid_blocks = -1; return; }
        if (hipOccupancyMaxActiveBlocksPerMultiprocessor(&per_cu, (const void*)yoco_fwd, 512, LDS_BYTES) != hipSuccess || per_cu < 1) { fprintf(stderr, "kernel_launch: occupancy query says %d\n", per_cu); per_cu = 1; }
        (void)hipGetLastError();
        grid_blocks = cus * 1;
    }
    if (grid_blocks < 0) return;
    Params p{};
    for (int i = 0; i < 27; ++i) p.in[i] = (const float*)d_in[i];
    p.out = (float*)d_out; p.ws = (unsigned char*)d_ws;
    if (hipMemsetAsync((char*)d_ws + WS_BAR, 0, 16384, stream) != hipSuccess) { fprintf(stderr, "kernel_launch: memset of barrier words failed\n"); return; }
    void* args[] = {&p};
    hipError_t e = hipLaunchCooperativeKernel((const void*)yoco_fwd, dim3(grid_blocks), dim3(512), args, LDS_BYTES, stream);
    if (e != hipSuccess) fprintf(stderr, "cooperative launch failed: %s (grid %d)\n", hipGetErrorString(e), grid_blocks);
}
```

```cpp
#include <hip/hip_runtime.h>
#include <hip/hip_cooperative_groups.h>
#include <cstdio>
#include <cstdint>
namespace cg = cooperative_groups;

#define LAS __attribute__((address_space(3)))
typedef unsigned short bf16_t;
typedef short bf16x8 __attribute__((ext_vector_type(8)));
typedef float f32x4 __attribute__((ext_vector_type(4)));
typedef float f32x16 __attribute__((ext_vector_type(16)));
typedef unsigned u32x4 __attribute__((ext_vector_type(4)));
typedef unsigned u32x2 __attribute__((ext_vector_type(2)));

constexpr int TOK = 32768, DM = 1024, FF = 4096, SEQ = 8192;
constexpr int NG = 64, GS = 16, NP = 64;
constexpr int CL = 32;
constexpr int NCH = TOK / CL;
constexpr int UGP = CL * GS + 2 * NP;
constexpr float EPS = 1e-6f;
constexpr float LOG2E = 1.4426950408889634f;

constexpr size_t MiB = 1u << 20;
constexpr size_t WS_BIAS = 0;
constexpr size_t WS_SCAL = 4096;
constexpr size_t WS_LAML = 8192;
constexpr size_t WS_RS = 786432;
constexpr size_t WS_BAR = 131072;
constexpr size_t WS_UP23 = 1 * MiB;
constexpr size_t WS_DN23 = 17 * MiB;
constexpr size_t WS_KVW = 33 * MiB;
constexpr size_t WS_QW = 37 * MiB;
constexpr size_t WS_OW = 41 * MiB;
constexpr size_t WS_UP01 = 45 * MiB;
constexpr size_t WS_DN01 = 61 * MiB;
constexpr size_t WS_WIN = 77 * MiB;
constexpr size_t WS_GLU = 81 * MiB;
constexpr size_t WS_TM = 89 * MiB;
constexpr size_t WS_SIN = 169 * MiB;
constexpr size_t WS_K = 45 * MiB;
constexpr size_t WS_VT = 109 * MiB;
constexpr size_t WS_HM = 186 * MiB;
constexpr size_t WS_ACT = 250 * MiB;
constexpr size_t WS_UG = WS_ACT;
constexpr size_t WS_Z = WS_ACT + 80 * MiB;
constexpr size_t WS_YG = WS_ACT + 112 * MiB;
constexpr size_t WS_Q = WS_ACT;
constexpr size_t WS_ON = WS_ACT + 64 * MiB;
constexpr size_t WS_HKV = WS_ACT + 128 * MiB;
constexpr size_t WS_END = 506 * MiB;

constexpr int LDS_BYTES = 147456;
#ifndef REPEAT_MASK
#define REPEAT_MASK 0
#endif

__device__ __forceinline__ unsigned cvt_pk_bf16(float lo, float hi) { unsigned r; asm("v_cvt_pk_bf16_f32 %0, %1, %2" : "=v"(r) : "v"(lo), "v"(hi)); return r; }
__device__ __forceinline__ float bf_lo(unsigned w) { return __uint_as_float(w << 16); }
__device__ __forceinline__ float bf_hi(unsigned w) { return __uint_as_float(w & 0xffff0000u); }
__device__ __forceinline__ float fexp2(float x) { return __builtin_amdgcn_exp2f(x); }
__device__ __forceinline__ float frcp(float x) { return __builtin_amdgcn_rcpf(x); }
__device__ __forceinline__ float max3f(float a, float b, float c) { float r; asm("v_max3_f32 %0, %1, %2, %3" : "=v"(r) : "v"(a), "v"(b), "v"(c)); return r; }
__device__ __forceinline__ float max2f(float a, float b) { float r; asm("v_max_f32_e32 %0, %1, %2" : "=v"(r) : "v"(a), "v"(b)); return r; }
__device__ __forceinline__ int opaque_tid() { int t_ = threadIdx.x; asm volatile("" : "+v"(t_)); return t_; }
__device__ __forceinline__ float wave_sum(float v) {
#pragma unroll
    for (int o = 32; o >= 1; o >>= 1) v += __shfl_xor(v, o);
    return v;
}
__device__ __forceinline__ float gelu_tanh(float y) {
    const float t = y * (1.5957691216057308f + 0.07135481627f * y * y);
    return y * frcp(1.0f + fexp2(-t * LOG2E));
}

namespace pg8 {
constexpr int BM = 256, BK = 64, HALF = 128, HTB = HALF * BK * 2, STAGE_BYTES = 8 * HTB;
__host__ __device__ __forceinline__ int lds_byte(int r, int c) { const int st = (r >> 4) * 2 + (c >> 5), rr = r & 15, cc = c & 31, ob = rr * 64 + cc * 2; return st * 1024 + (ob ^ (((ob >> 9) & 1) << 5)); }
__host__ __device__ __forceinline__ void stage_rc(int b, int& R, int& C) { const int st = b / 1024, sb = b % 1024, swz = sb ^ (((sb >> 9) & 1) << 5); R = (st >> 1) * 16 + swz / 64; C = (st & 1) * 32 + (swz % 64) / 2; }
__host__ __device__ __forceinline__ int perm32(int rho) { const int n = rho >> 4, i = rho & 15; return 8 * (i >> 2) + 4 * n + (i & 3); }

struct Unit { int pm, pn, arow, brow; };
enum { ORD_STATIC = 0, ORD_Z = 1, ORD_Y = 2 };
enum { EPI_STORE = 0, EPI_RELU2 = 1, EPI_GLU = 2, EPI_UG = 3, EPI_Z = 4, EPI_Y = 5, EPI_VT = 6 };
struct Job { const bf16_t* A; const bf16_t* Bt; int lda, ldb, K, ord, M, N, epi, ldc; float scale; void* O; const void* x1; const void* x2; };

__device__ __forceinline__ bool next_unit(const Job& jb, int G, int bx, int vc, int i, Unit& u) {
    if (jb.ord == ORD_STATIC) {
        const int nM = jb.M / BM, nN = jb.N / BM, nwg = nM * nN;
        const long L = (long)i * G + bx; if (L >= nwg) return false;
        int wgid = (int)L; { const int q = nwg / 8, r = nwg % 8, xcd = wgid % 8, off = wgid / 8; wgid = (xcd < r ? xcd * (q + 1) : r * (q + 1) + (xcd - r) * q) + off; }
        const int nig = 8 * nN, gid = wgid / nig, fm = gid * 8, gsz = (nM - fm) < 8 ? (nM - fm) : 8;
        u.pm = fm + ((wgid % nig) % gsz); u.pn = (wgid % nig) / gsz; u.arow = u.pm * BM; u.brow = u.pn * BM; return true;
    } else if (jb.ord == ORD_Z) {
        const int L = i * G + vc; if (L >= NG * 4) return false; u.pm = L; u.pn = 0; u.arow = L * BM; u.brow = (L >> 2) * 128; return true;
    } else {
        const int L = i * G + vc; if (L >= NG * 8) return false; const int g = L >> 3, r = L & 7; u.pm = g * 4 + (r >> 1); u.pn = g * 2 + (r & 1); u.arow = u.pm * BM; u.brow = u.pn * BM; return true;
    }
}

typedef f32x4 Acc[2][2][4][2];
__device__ __forceinline__ u32x4 pack8(const f32x4 v0, const f32x4 v1) { u32x4 w; w.x = cvt_pk_bf16(v0[0], v0[1]); w.y = cvt_pk_bf16(v0[2], v0[3]); w.z = cvt_pk_bf16(v1[0], v1[1]); w.w = cvt_pk_bf16(v1[2], v1[3]); return w; }

__device__ __forceinline__ void epilogue(const Job& jb, const Acc& acc, const Unit& u) {
    int t_ = threadIdx.x; asm volatile("" : "+v"(t_));
    const int wid_ = __builtin_amdgcn_readfirstlane(t_ >> 6), wr = wid_ >> 2, wc = wid_ & 3, fr = t_ & 15, fq = (t_ & 63) >> 4;
    const int row0 = u.pm * BM + wr * 64 + fr;
#ifdef EPI_MASK
    const int epi_ = ((1 << jb.epi) & EPI_MASK) ? jb.epi : 0;
#else
    const int epi_ = jb.epi;
#endif
    if (epi_ == EPI_STORE || epi_ == EPI_RELU2) {
        bf16_t* O = (bf16_t*)jb.O; const int col0 = u.pn * BM + wc * 32 + 8 * fq; const bool r2 = epi_ == EPI_RELU2; const float scale = jb.scale; const float* rsc = (const float*)jb.x2;
#pragma unroll
        for (int ai = 0; ai < 2; ++ai)
#pragma unroll
            for (int m = 0; m < 4; ++m) { bf16_t* rowp = O + (size_t)(row0 + ai * HALF + m * 16) * jb.ldc + col0;
                float rsv = 1.0f; if (rsc) { rsv = rsc[row0 + ai * HALF + m * 16]; if (r2) rsv = rsv * rsv; }
                const float sc_ = scale * rsv;
#pragma unroll
                for (int bj = 0; bj < 2; ++bj) { f32x4 v0 = acc[ai][bj][m][0], v1 = acc[ai][bj][m][1];
                    if (r2) {
#pragma unroll
                        for (int e = 0; e < 4; ++e) { const float a = fmaxf(v0[e], 0.f), b = fmaxf(v1[e], 0.f); v0[e] = a * a; v1[e] = b * b; } }
                    v0 = v0 * sc_; v1 = v1 * sc_;
                    *(u32x4*)(rowp + bj * HALF) = pack8(v0, v1); } }
    } else if (epi_ == EPI_GLU) {
        bf16_t* O = (bf16_t*)jb.O; const int col0 = u.pn * HALF + wc * 32 + 8 * fq;
#pragma unroll
        for (int ai = 0; ai < 2; ++ai)
#pragma unroll
            for (int m = 0; m < 4; ++m) { bf16_t* rowp = O + (size_t)(row0 + ai * HALF + m * 16) * DM + col0;
                f32x4 o0, o1;
#pragma unroll
                for (int e = 0; e < 4; ++e) { o0[e] = acc[ai][0][m][0][e] * frcp(1.0f + fexp2(-acc[ai][1][m][0][e] * LOG2E)); o1[e] = acc[ai][0][m][1][e] * frcp(1.0f + fexp2(-acc[ai][1][m][1][e] * LOG2E)); }
                *(u32x4*)rowp = pack8(o0, o1); }
    } else if (epi_ == EPI_UG) {
        bf16_t* Ug = (bf16_t*)jb.O; const float* rsc = (const float*)jb.x2;
#pragma unroll
        for (int ai = 0; ai < 2; ++ai)
#pragma unroll
            for (int m = 0; m < 4; ++m) { const int tok = row0 + ai * HALF + m * 16; const float rsv = rsc[tok];
#pragma unroll
                for (int bj = 0; bj < 2; ++bj) { const int g = u.pn * 16 + bj * 8 + wc * 2 + (fq >> 1);
                    *(u32x4*)(Ug + ((size_t)(g * NCH + (tok >> 5)) * UGP + (tok & 31) * 16 + (fq & 1) * 8)) = pack8(acc[ai][bj][m][0] * rsv, acc[ai][bj][m][1] * rsv); } }
    } else if (epi_ == EPI_Z) {
        float* Z = (float*)jb.O; const int col0 = wc * 32 + 8 * fq;
#pragma unroll
        for (int ai = 0; ai < 2; ++ai)
#pragma unroll
            for (int m = 0; m < 4; ++m) { float* p = Z + (size_t)(row0 + ai * HALF + m * 16) * 128 + col0;
                *(f32x4*)p = acc[ai][0][m][0]; *(f32x4*)(p + 4) = acc[ai][0][m][1]; }
    } else if (epi_ == EPI_VT) {
        bf16_t* O = (bf16_t*)jb.O; const int col0 = u.pn * BM + wc * 32 + 8 * fq; const float* rsc = (const float*)jb.x2;
        const f32x4 ra0 = *(const f32x4*)(rsc + col0), rb0 = *(const f32x4*)(rsc + col0 + 4), ra1 = *(const f32x4*)(rsc + col0 + HALF), rb1 = *(const f32x4*)(rsc + col0 + HALF + 4);
#pragma unroll
        for (int ai = 0; ai < 2; ++ai)
#pragma unroll
            for (int m = 0; m < 4; ++m) { const int row = row0 + ai * HALF + m * 16;
#pragma unroll
                for (int bj = 0; bj < 2; ++bj) { const int col = col0 + bj * HALF;
                    const size_t off = ((size_t)(((col >> 13) * 8 + (row >> 7)) * 128 + ((col & 8191) >> 6)) << 13) + (row & 127) * 64 + (col & 63);
                    *(u32x4*)(O + off) = pack8(acc[ai][bj][m][0] * (bj ? ra1 : ra0), acc[ai][bj][m][1] * (bj ? rb1 : rb0)); } }
    } else {
        const bf16_t* Ug = (const bf16_t*)jb.x1; const float* dsk = (const float*)jb.x2; bf16_t* YG = (bf16_t*)jb.O;
        const int g = u.pm >> 2, n0 = (u.pm & 3) * BM + wr * 64 + fr, c0 = (u.pn & 1) * BM + wc * 32 + 8 * fq;
        const int co0 = (fq & 1) * 8;
        const f32x4 d0 = *(const f32x4*)(dsk + g * 16 + co0), d1 = *(const f32x4*)(dsk + g * 16 + co0 + 4);
#pragma unroll
        for (int ai = 0; ai < 2; ++ai)
#pragma unroll
            for (int m = 0; m < 4; ++m) { const int n = n0 + ai * HALF + m * 16;
#pragma unroll
                for (int bj = 0; bj < 2; ++bj) { const int cc = c0 + bj * HALF, j = cc >> 4;
                    const u32x4 uu = *(const u32x4*)(Ug + ((size_t)(g * NCH + n) * UGP + cc));
                    const f32x4 v0 = acc[ai][bj][m][0], v1 = acc[ai][bj][m][1];
                    f32x4 y0, y1;
                    y0[0] = v0[0] + d0[0] * bf_lo(uu.x); y0[1] = v0[1] + d0[1] * bf_hi(uu.x); y0[2] = v0[2] + d0[2] * bf_lo(uu.y); y0[3] = v0[3] + d0[3] * bf_hi(uu.y);
                    y1[0] = v1[0] + d1[0] * bf_lo(uu.z); y1[1] = v1[1] + d1[1] * bf_hi(uu.z); y1[2] = v1[2] + d1[2] * bf_lo(uu.w); y1[3] = v1[3] + d1[3] * bf_hi(uu.w);
#pragma unroll
                    for (int e = 0; e < 4; ++e) { y0[e] = gelu_tanh(y0[e]); y1[e] = gelu_tanh(y1[e]); }
                    *(u32x4*)(YG + ((size_t)(n * CL + j) * DM + g * 16 + co0)) = pack8(y0, y1); } }
    }
}

__device__ __forceinline__ void gemm_phase(LAS unsigned char* lds, const Job& g, const int G, const int bx, const int vc, const int tid_unused) {
    const int tid = opaque_tid(); (void)tid_unused;
    const int wid = __builtin_amdgcn_readfirstlane(tid >> 6), lane = tid & 63, wr = wid >> 2, wc = wid & 3, fr = lane & 15, fq = lane >> 4;
    const int K = g.K, nt = K / BK;
    unsigned voffA[2], voffB[2];
#pragma unroll
    for (int i = 0; i < 2; ++i) { int R, C; stage_rc(tid * 16 + i * 8192, R, C); const int Rb = (R & ~31) + perm32(R & 31);
        voffA[i] = (unsigned)(R * g.lda + C) * 2u; voffB[i] = (unsigned)(Rb * g.ldb + C) * 2u; }
    const size_t kstep = (size_t)(BK * 2);
    const size_t hstepA = (size_t)HALF * g.lda * 2, hstepB = (size_t)HALF * g.ldb * 2;
    const size_t rowA = (size_t)g.lda * 2, rowB = (size_t)g.ldb * 2;
    const unsigned ldsw = (unsigned)wid * 1024u;
    const int aoff = lds_byte(wr * 64 + fr, fq * 8), boff = lds_byte(wc * 32 + fr, fq * 8);
#define PG8_SA(b, h) (((b) * 2 + (h)) * HTB)
#define PG8_SB(b, h) ((4 + (b) * 2 + (h)) * HTB)
#define PG8_STAGE(bufoff, gbase, voff) do { _Pragma("unroll") for (int _i = 0; _i < 2; ++_i) \
        __builtin_amdgcn_global_load_lds((const unsigned*)((const char*)(gbase) + (voff)[_i]), (LAS unsigned*)(lds + (bufoff) + ldsw + _i * 8192), 16, 0, 0); } while (0)
#define PG8_LDA(dst, b, h) do { _Pragma("unroll") for (int m = 0; m < 4; ++m) _Pragma("unroll") for (int k = 0; k < 2; ++k) dst[m][k] = *(const LAS bf16x8*)(lds + PG8_SA(b, h) + aoff + m * 2048 + k * 1024); } while (0)
#define PG8_LDB(dst, b, h) do { _Pragma("unroll") for (int n = 0; n < 2; ++n) _Pragma("unroll") for (int k = 0; k < 2; ++k) dst[n][k] = *(const LAS bf16x8*)(lds + PG8_SB(b, h) + boff + n * 2048 + k * 1024); } while (0)
#define PG8_MMA(ai, bj, At, Bt) do { __builtin_amdgcn_s_setprio(1); _Pragma("unroll") for (int m = 0; m < 4; ++m) _Pragma("unroll") for (int n = 0; n < 2; ++n) _Pragma("unroll") for (int k = 0; k < 2; ++k) \
        acc[ai][bj][m][n] = __builtin_amdgcn_mfma_f32_16x16x32_bf16(Bt[n][k], At[m][k], acc[ai][bj][m][n], 0, 0, 0); __builtin_amdgcn_s_setprio(0); } while (0)
#define PG8_WAIT_V(n) asm volatile("s_waitcnt vmcnt(" #n ")" ::: "memory")
#define PG8_WAIT_L(n) asm volatile("s_waitcnt lgkmcnt(" #n ")" ::: "memory")
#define PG8_BAR __builtin_amdgcn_s_barrier()
#define PG8_SCHED __builtin_amdgcn_sched_barrier(0)
    Unit cur, nxt; int ui = 0;
    if (!next_unit(g, G, bx, vc, 0, cur)) return;
    Acc acc;
#pragma unroll
    for (int a = 0; a < 2; ++a)
#pragma unroll
        for (int b = 0; b < 2; ++b)
#pragma unroll
            for (int m = 0; m < 4; ++m)
#pragma unroll
                for (int n = 0; n < 2; ++n) acc[a][b][m][n] = (f32x4){0.f, 0.f, 0.f, 0.f};
    bf16x8 At[4][2], B0[2][2], B1[2][2];
    const char* cA = (const char*)g.A + (size_t)cur.arow * rowA; const char* cB = (const char*)g.Bt + (size_t)cur.brow * rowB;
    PG8_STAGE(PG8_SB(0, 0), cB, voffB); PG8_STAGE(PG8_SB(0, 1), cB + hstepB, voffB); PG8_STAGE(PG8_SA(0, 0), cA, voffA); PG8_STAGE(PG8_SA(0, 1), cA + hstepA, voffA);
    if (wr == 1) PG8_BAR;
    PG8_WAIT_V(2); PG8_BAR;
    PG8_STAGE(PG8_SB(1, 0), cB + kstep, voffB); PG8_STAGE(PG8_SA(1, 0), cA + kstep, voffA); PG8_STAGE(PG8_SB(1, 1), cB + hstepB + kstep, voffB);
    PG8_WAIT_V(6); PG8_BAR;
    for (;;) {
        const bool has_next = next_unit(g, G, bx, vc, ui + 1, nxt);
        const char* nA = has_next ? (const char*)g.A + (size_t)nxt.arow * rowA : cA; const char* nB = has_next ? (const char*)g.Bt + (size_t)nxt.brow * rowB : cB;
        for (int t = 0; t < nt; t += 2) {
            const bool last = (t == nt - 2);
            const char* a1 = cA + (size_t)(t + 1) * kstep;
            const char* a2 = last ? nA : cA + (size_t)(t + 2) * kstep; const char* b2 = last ? nB : cB + (size_t)(t + 2) * kstep;
            const char* a3 = a2 + kstep; const char* b3 = b2 + kstep;
            PG8_LDB(B0, 0, 0); PG8_LDB(B1, 0, 1); PG8_SCHED; PG8_LDA(At, 0, 0); PG8_STAGE(PG8_SA(1, 1), a1 + hstepA, voffA);
            PG8_WAIT_V(8); PG8_WAIT_L(0); PG8_BAR; PG8_MMA(0, 0, At, B0); PG8_MMA(0, 1, At, B1); PG8_BAR; PG8_SCHED;
            PG8_LDA(At, 0, 1); PG8_STAGE(PG8_SB(0, 0), b2, voffB); PG8_STAGE(PG8_SB(0, 1), b2 + hstepB, voffB); PG8_STAGE(PG8_SA(0, 0), a2, voffA);
            PG8_WAIT_V(8); PG8_WAIT_L(0); PG8_BAR; PG8_MMA(1, 0, At, B0); PG8_MMA(1, 1, At, B1); PG8_BAR; PG8_SCHED;
            PG8_LDB(B0, 1, 0); PG8_LDB(B1, 1, 1); PG8_SCHED; PG8_LDA(At, 1, 0); PG8_STAGE(PG8_SA(0, 1), a2 + hstepA, voffA);
            PG8_WAIT_V(8); PG8_WAIT_L(0); PG8_BAR; PG8_MMA(0, 0, At, B0); PG8_MMA(0, 1, At, B1); PG8_BAR; PG8_SCHED;
            PG8_LDA(At, 1, 1); PG8_STAGE(PG8_SB(1, 0), b3, voffB); PG8_STAGE(PG8_SB(1, 1), b3 + hstepB, voffB); PG8_STAGE(PG8_SA(1, 0), a3, voffA);
            PG8_WAIT_V(8); PG8_WAIT_L(0); PG8_BAR; PG8_MMA(1, 0, At, B0); PG8_MMA(1, 1, At, B1); PG8_BAR; PG8_SCHED;
        }
        if (wr == 0) PG8_BAR;
        epilogue(g, acc, cur);
        if (!has_next) break;
#pragma unroll
        for (int a = 0; a < 2; ++a)
#pragma unroll
            for (int b = 0; b < 2; ++b)
#pragma unroll
                for (int m = 0; m < 4; ++m)
#pragma unroll
                    for (int n = 0; n < 2; ++n) acc[a][b][m][n] = (f32x4){0.f, 0.f, 0.f, 0.f};
        cur = nxt; cA = nA; cB = nB; ++ui;
        if (wr == 1) PG8_BAR;
    }
    PG8_WAIT_V(0);
    PG8_BAR;
#undef PG8_SA
#undef PG8_SB
#undef PG8_STAGE
#undef PG8_LDA
#undef PG8_LDB
#undef PG8_MMA
#undef PG8_WAIT_V
#undef PG8_WAIT_L
#undef PG8_BAR
#undef PG8_SCHED
}
}

#define XB_TMO      128
#define XB_XCNT(j)  (256  + 64 * (j))
#define XB_XSUB(j)  (1280 + 64 * (j))
#define XB_XGEN(j)  (2304 + 64 * (j))
#define XB_TOP      3328
#define XB_TOPGEN   3392
#define XCD_BAR_WORDS 3456
#define XB_SPIN_CAP (1u << 22)
__device__ __forceinline__ unsigned xb_ld(unsigned* p)              { return __hip_atomic_load(p, __ATOMIC_RELAXED, __HIP_MEMORY_SCOPE_AGENT); }
__device__ __forceinline__ unsigned xb_add(unsigned* p, unsigned v) { return __hip_atomic_fetch_add(p, v, __ATOMIC_RELAXED, __HIP_MEMORY_SCOPE_AGENT); }
__device__ __forceinline__ unsigned xb_xcc_id() { return (unsigned)__builtin_amdgcn_s_getreg((3 << 11) | 20) & 0xFu; }
#define XB_SPIN(cond, bar) do { unsigned _sp = 0; while (cond) { __builtin_amdgcn_s_sleep(1); \
    if ((++_sp & 255u) == 0u) { if (xb_ld(&(bar)[XB_TMO])) break; if (_sp > XB_SPIN_CAP) { atomicAdd(&(bar)[XB_TMO], 1u); break; } } } } while (0)
struct XcdBarrier { unsigned* bar; unsigned x; volatile LAS unsigned* st; };
__device__ __forceinline__ XcdBarrier xcd_barrier_post(unsigned* bar, volatile LAS unsigned* st) {
    XcdBarrier b; b.bar = bar; b.x = xb_xcc_id(); b.st = st;
    if (threadIdx.x == 0) (void)xb_add(&bar[XB_XCNT(b.x)], 1u);
    return b;
}
__device__ __forceinline__ void xcd_barrier_complete(unsigned* bar, unsigned x, unsigned& nloc, unsigned& nx) {
    const unsigned G = gridDim.x * gridDim.y * gridDim.z;
    unsigned sum, cnt, mine, sp = 0u;
    for (;;) {
        sum = 0u; cnt = 0u; mine = 0u;
#pragma unroll
        for (unsigned j = 0; j < 16; ++j) { const unsigned c = xb_ld(&bar[XB_XCNT(j)]); sum += c; cnt += (c > 0u) ? 1u : 0u; mine = (j == x) ? c : mine; }
        if (sum == G) break;
        __builtin_amdgcn_s_sleep(1);
        if ((++sp & 255u) == 0u) { if (xb_ld(&bar[XB_TMO])) break; if (sp > XB_SPIN_CAP) { atomicAdd(&bar[XB_TMO], 1u); break; } }
    }
    nloc = mine > 0u ? mine : 1u; nx = cnt > 0u ? cnt : 1u;
}
__device__ __forceinline__ void xcd_barrier(const XcdBarrier& b) {
    asm volatile("s_waitcnt vmcnt(0)" ::: "memory");
    __syncthreads();
    if (threadIdx.x == 0) {
        unsigned* bar = b.bar;
        __builtin_amdgcn_s_waitcnt(0);
        unsigned nloc = b.st[0], nx = b.st[1];
        if (nloc == 0u) { xcd_barrier_complete(bar, b.x, nloc, nx); b.st[0] = nloc; b.st[1] = nx; }
        const unsigned old = xb_add(&bar[XB_XSUB(b.x)], 1u);
        const unsigned gen = old / nloc;
        if (old + 1u == (gen + 1u) * nloc) {
            __builtin_amdgcn_fence(__ATOMIC_RELEASE, "agent");
            asm volatile("s_waitcnt vmcnt(0)" ::: "memory");
            const unsigned og = xb_add(&bar[XB_TOP], 1u);
            const unsigned tg = og / nx;
            if (og + 1u == (tg + 1u) * nx) xb_add(&bar[XB_TOPGEN], 1u);
            else XB_SPIN(xb_ld(&bar[XB_TOPGEN]) == tg, bar);
            __builtin_amdgcn_fence(__ATOMIC_ACQUIRE, "agent");
            xb_add(&bar[XB_XGEN(b.x)], 1u);
            asm volatile("s_waitcnt vmcnt(0)" ::: "memory");
        } else {
            XB_SPIN(xb_ld(&bar[XB_XGEN(b.x)]) == gen, bar);
            __builtin_amdgcn_fence(__ATOMIC_ACQUIRE, "agent");
            asm volatile("s_waitcnt vmcnt(0)" ::: "memory");
        }
    }
    __syncthreads();
}

struct Params {
    const float* in[27];
    float* out;
    unsigned char* ws;
};

struct Ctx { LAS unsigned char* lds; int tid, lane, wid, G, bx, vc; };

__device__ __forceinline__ bool wdesc(int i, const Params& p, const float*& src, bf16_t*& dst, int& K, int& N, int& glu, const float*& gain) {
    unsigned char* ws = p.ws; glu = 0; gain = nullptr;
    if (i < 4) { gain = p.in[3] + i * DM; src = p.in[5] + (size_t)i * DM * FF; dst = (bf16_t*)(ws + (i < 2 ? WS_UP01 : WS_UP23)) + (size_t)(i & 1) * DM * FF; K = DM; N = FF; return true; }
    if (i < 8) { const int l = i - 4; src = p.in[6] + (size_t)l * DM * FF; dst = (bf16_t*)(ws + (l < 2 ? WS_DN01 : WS_DN23)) + (size_t)(l & 1) * DM * FF; K = FF; N = DM; return true; }
    if (i < 10) { const int l = i - 8; gain = p.in[1] + l * DM; src = p.in[7] + (size_t)l * DM * DM; dst = (bf16_t*)(ws + WS_WIN) + (size_t)l * DM * DM; K = DM; N = DM; return true; }
    if (i < 12) { const int l = i - 10; src = p.in[16] + (size_t)l * DM * 2 * DM; dst = (bf16_t*)(ws + WS_GLU) + (size_t)l * DM * 2 * DM; K = DM; N = 2 * DM; glu = 1; return true; }
    if (i < 13) { gain = p.in[17]; src = p.in[18]; dst = (bf16_t*)(ws + WS_KVW); K = DM; N = 2 * DM; return true; }
    if (i < 15) { const int l = i - 13; gain = p.in[1] + (2 + l) * DM; src = p.in[19] + (size_t)l * DM * DM; dst = (bf16_t*)(ws + WS_QW) + (size_t)l * DM * DM; K = DM; N = DM; return true; }
    if (i < 17) { const int l = i - 15; src = p.in[25] + (size_t)l * DM * DM; dst = (bf16_t*)(ws + WS_OW) + (size_t)l * DM * DM; K = DM; N = DM; return true; }
    return false;
}
__device__ __forceinline__ bool wlocate(int f, const Params& p, const float*& src, bf16_t*& dst, int& K, int& N, int& n0, int& k0, int& sc0, const float*& gain) {
    int base = 0;
    for (int i = 0; ; ++i) {
        int glu;
        if (!wdesc(i, p, src, dst, K, N, glu, gain)) return false;
        const int ntk = K >> 6, nt = ntk * (N >> 6);
        if (f < base + nt) { const int t = f - base; n0 = (t / ntk) << 6; k0 = (t % ntk) << 6;
            sc0 = glu ? (((n0 >> 7) & 1) * DM + (n0 >> 8) * 128 + (n0 & 127)) : n0; return true; }
        base += nt;
    }
}
constexpr int NCONV_TILES = 11264;
__device__ void convert_weights(const Ctx& c, const Params& p) {
    LAS float* T = (LAS float*)c.lds;
    int f, fstep, fend;
    if (c.G == 256) { if (c.bx < 128) { f = c.bx; fstep = 128; fend = 128 * 38; } else { f = 128 * 38 + (c.bx - 128); fstep = 128; fend = NCONV_TILES; } }
    else { f = c.bx; fstep = c.G; fend = NCONV_TILES; }
    const float* src; bf16_t* dst; int K, N, n0, k0, sc0; const float* gain;
    bool have = (f < fend) && wlocate(f, p, src, dst, K, N, n0, k0, sc0, gain);
    f32x4 v0, v1;
    const int ctid = opaque_tid(); const int kk = ctid >> 4, c4 = (ctid & 15) * 4;
    if (have) { v0 = *(const f32x4*)(src + (size_t)(k0 + kk) * N + sc0 + c4); v1 = *(const f32x4*)(src + (size_t)(k0 + 32 + kk) * N + sc0 + c4); if (gain) { v0 = v0 * gain[k0 + kk]; v1 = v1 * gain[k0 + 32 + kk]; } }
    int par = 0;
    while (have) {
        const f32x4 a0 = v0, a1 = v1; bf16_t* cdst = dst; const int cK = K, cn0 = n0, ck0 = k0;
        f += fstep;
        have = (f < fend) && wlocate(f, p, src, dst, K, N, n0, k0, sc0, gain);
        if (have) { v0 = *(const f32x4*)(src + (size_t)(k0 + kk) * N + sc0 + c4); v1 = *(const f32x4*)(src + (size_t)(k0 + 32 + kk) * N + sc0 + c4); if (gain) { v0 = v0 * gain[k0 + kk]; v1 = v1 * gain[k0 + 32 + kk]; } }
        LAS float* Tb = T + par * (64 * 65);
        Tb[(c4 + 0) * 65 + kk] = a0[0]; Tb[(c4 + 1) * 65 + kk] = a0[1]; Tb[(c4 + 2) * 65 + kk] = a0[2]; Tb[(c4 + 3) * 65 + kk] = a0[3];
        Tb[(c4 + 0) * 65 + 32 + kk] = a1[0]; Tb[(c4 + 1) * 65 + 32 + kk] = a1[1]; Tb[(c4 + 2) * 65 + 32 + kk] = a1[2]; Tb[(c4 + 3) * 65 + 32 + kk] = a1[3];
        __syncthreads();
        { const int nn = ctid >> 3, k8 = (ctid & 7) * 8; const LAS float* r = Tb + nn * 65 + k8;
          u32x4 w; w.x = cvt_pk_bf16(r[0], r[1]); w.y = cvt_pk_bf16(r[2], r[3]); w.z = cvt_pk_bf16(r[4], r[5]); w.w = cvt_pk_bf16(r[6], r[7]);
          *(u32x4*)(cdst + (size_t)(cn0 + nn) * cK + ck0 + k8) = w; }
        par ^= 1;
    }
    __syncthreads();
}

__device__ void ssm_tables(const Ctx& c, const Params& p, int layer, int g) {
    LAS float* lamp = (LAS float*)c.lds;
    LAS float* bbar = lamp + 33 * 64 * 2;
    LAS float* ccp = bbar + 64 * 16 * 2;
    LAS float* Kt = ccp + 16 * 64 * 2;
    LAS float* coef = Kt + 32 * 256;
    const int tid = opaque_tid();
    const size_t lg = (size_t)layer * NG + g;
    if (tid < 64) {
        const int pp = tid;
        const float dt = expf(p.in[10][lg]);
        const float lr = p.in[8][lg * NP + pp], li = p.in[9][lg * NP + pp];
        const float mag = expf(lr * dt), ar = mag * cosf(li * dt), ai = mag * sinf(li * dt);
        const float den = lr * lr + li * li;
        coef[pp * 2] = ((ar - 1.0f) * lr + ai * li) / den; coef[pp * 2 + 1] = (ai * lr - (ar - 1.0f) * li) / den;
        float pr = 1.0f, pi = 0.0f; asm volatile("" : "+v"(pr), "+v"(pi));
        for (int k = 0; k <= 32; ++k) { lamp[(k * 64 + pp) * 2] = pr; lamp[(k * 64 + pp) * 2 + 1] = pi; const float nr = pr * ar - pi * ai, ni = pr * ai + pi * ar; pr = nr; pi = ni; }
        float* lamL = (float*)(p.ws + WS_LAML) + (lg * NP + pp) * 2;
        lamL[0] = lamp[(32 * 64 + pp) * 2]; lamL[1] = lamp[(32 * 64 + pp) * 2 + 1];
    }
    __syncthreads();
    for (int e = tid; e < 1024; e += 512) {
        const int pp = e >> 4, cc = e & 15;
        const float br = p.in[11][lg * 1024 + e], bi = p.in[12][lg * 1024 + e], cr = coef[pp * 2], ci = coef[pp * 2 + 1];
        bbar[e * 2] = cr * br - ci * bi; bbar[e * 2 + 1] = cr * bi + ci * br;
        ccp[e * 2] = p.in[13][lg * 1024 + e]; ccp[e * 2 + 1] = p.in[14][lg * 1024 + e];
        (void)cc;
    }
    __syncthreads();
    {
        const int k = tid >> 4, co = tid & 15;
        float acc16[16];
#pragma unroll
        for (int q = 0; q < 16; ++q) acc16[q] = 0.f;
        for (int pp = 0; pp < 64; ++pp) {
            const float lr = lamp[(k * 64 + pp) * 2], li = lamp[(k * 64 + pp) * 2 + 1], cr = ccp[(co * 64 + pp) * 2], ci = ccp[(co * 64 + pp) * 2 + 1];
            const float wr = cr * lr - ci * li, wi = cr * li + ci * lr;
            const LAS f32x4* bb = (const LAS f32x4*)(bbar + pp * 32);
#pragma unroll
            for (int q = 0; q < 8; ++q) { const f32x4 b = bb[q]; acc16[2 * q] += wr * b[0] - wi * b[1]; acc16[2 * q + 1] += wr * b[2] - wi * b[3]; }
        }
#pragma unroll
        for (int q = 0; q < 16; ++q) Kt[(k * 16 + co) * 16 + q] = acc16[q];
    }
    __syncthreads();
    bf16_t* Tm = (bf16_t*)(p.ws + WS_TM) + (size_t)layer * NG * 512 * UGP + (size_t)g * 512 * UGP;
    for (int e = tid; e < 512 * 80; e += 512) {
        const int row = e / 80, ch = e % 80, j = row >> 4, co = row & 15;
        float v[8];
        if (ch < 64) { const int i = ch >> 1, ci0 = (ch & 1) * 8;
#pragma unroll
            for (int q = 0; q < 8; ++q) v[q] = (i <= j) ? Kt[((j - i) * 16 + co) * 16 + ci0 + q] : 0.f;
        } else { const int p0 = (ch - 64) * 8;
#pragma unroll
            for (int q = 0; q < 8; ++q) { const int pq = p0 + q, pp = pq & 63;
                const float lr = lamp[((j + 1) * 64 + pp) * 2], li = lamp[((j + 1) * 64 + pp) * 2 + 1], cr = ccp[(co * 64 + pp) * 2], ci = ccp[(co * 64 + pp) * 2 + 1];
                v[q] = pq < 64 ? (cr * lr - ci * li) : -(cr * li + ci * lr); }
        }
        u32x4 w; w.x = cvt_pk_bf16(v[0], v[1]); w.y = cvt_pk_bf16(v[2], v[3]); w.z = cvt_pk_bf16(v[4], v[5]); w.w = cvt_pk_bf16(v[6], v[7]);
        *(u32x4*)(Tm + (size_t)row * UGP + ch * 8) = w;
    }
    bf16_t* Sin = (bf16_t*)(p.ws + WS_SIN) + (size_t)layer * NG * 128 * 512 + (size_t)g * 128 * 512;
    for (int e = tid; e < 128 * 64; e += 512) {
        const int row = e >> 6, ch = e & 63, pp = row & 63, i = ch >> 1, ci0 = (ch & 1) * 8;
        const float lr = lamp[((31 - i) * 64 + pp) * 2], li = lamp[((31 - i) * 64 + pp) * 2 + 1];
        float v[8];
#pragma unroll
        for (int q = 0; q < 8; ++q) { const float br = bbar[(pp * 16 + ci0 + q) * 2], bi = bbar[(pp * 16 + ci0 + q) * 2 + 1]; v[q] = row < 64 ? (lr * br - li * bi) : (lr * bi + li * br); }
        u32x4 w; w.x = cvt_pk_bf16(v[0], v[1]); w.y = cvt_pk_bf16(v[2], v[3]); w.z = cvt_pk_bf16(v[4], v[5]); w.w = cvt_pk_bf16(v[6], v[7]);
        *(u32x4*)(Sin + (size_t)row * 512 + ch * 8) = w;
    }
    __syncthreads();
}

__device__ void small_tables(const Ctx& c, const Params& p) {
    float* bt = (float*)(p.ws + WS_BIAS);
    const int stid = opaque_tid();
    for (int e = stid; e < 8 * 128; e += 512) {
        const int h = e >> 7, n = e & 127;
        int bk = n;
        if (n >= 16) { const int th[16] = {16, 19, 21, 24, 27, 31, 35, 40, 46, 52, 59, 67, 77, 87, 99, 113}; bk = 15;
#pragma unroll
            for (int q = 0; q < 16; ++q) bk += (n >= th[q]) ? 1 : 0; }
        bt[e] = (p.in[26][bk * 8 + h] - p.in[26][31 * 8 + h]) * LOG2E;
    }
    if (stid < 2) {
        const int j = stid; float s1 = 0.f, s2 = 0.f;
        for (int q = 0; q < 64; ++q) { s1 += p.in[20][j * 64 + q] * p.in[21][j * 64 + q]; s2 += p.in[22][j * 64 + q] * p.in[23][j * 64 + q]; }
        const float li = 0.8f - 0.6f * expf(-0.3f * (float)(j + 2));
        float* sc = (float*)(p.ws + WS_SCAL) + j * 4;
        sc[0] = expf(s1) - expf(s2) + li; sc[1] = 1.0f - li; sc[2] = 0.f; sc[3] = 0.f;
    }
}

__device__ void norm_phase(const Ctx& c, const void* xin_, int xin_f32, void* xout_, int xout_f32, const bf16_t* mix, const float* gpost, float* rsout) {
    const float* xin = (const float*)xin_; const bf16_t* xin16 = (const bf16_t*)xin_; float* xout = (float*)xout_; bf16_t* xout16 = (bf16_t*)xout_;
    const int tid_ = opaque_tid(), lane = tid_ & 63, wid_ = __builtin_amdgcn_readfirstlane(tid_ >> 6);
    for (int r0 = (wid_ * c.G + c.bx) * 4; r0 < TOK; r0 += 8 * c.G * 4) {
        f32x4 xv[4][4]; u32x4 xw[4][2]; u32x4 mw[4][2];
        if (xin_f32) {
#pragma unroll
            for (int rr = 0; rr < 4; ++rr)
#pragma unroll
                for (int k = 0; k < 2; ++k) { const float* xp = xin + (size_t)(r0 + rr) * DM + k * 512 + lane * 8; xv[rr][2 * k] = *(const f32x4*)xp; xv[rr][2 * k + 1] = *(const f32x4*)(xp + 4); }
        } else {
#pragma unroll
            for (int rr = 0; rr < 4; ++rr)
#pragma unroll
                for (int k = 0; k < 2; ++k) xw[rr][k] = *(const u32x4*)(xin16 + (size_t)(r0 + rr) * DM + k * 512 + lane * 8);
        }
        if (mix) {
#pragma unroll
            for (int rr = 0; rr < 4; ++rr)
#pragma unroll
                for (int k = 0; k < 2; ++k) mw[rr][k] = *(const u32x4*)(mix + (size_t)(r0 + rr) * DM + k * 512 + lane * 8);
        }
#pragma unroll
        for (int rr = 0; rr < 4; ++rr) {
            const int row = r0 + rr;
            float x[16];
            if (xin_f32) {
#pragma unroll
                for (int q = 0; q < 4; ++q)
#pragma unroll
                    for (int e = 0; e < 4; ++e) x[q * 4 + e] = xv[rr][q][e];
            } else {
#pragma unroll
                for (int k = 0; k < 2; ++k) { const u32x4 w = xw[rr][k];
                    x[k * 8 + 0] = bf_lo(w.x); x[k * 8 + 1] = bf_hi(w.x); x[k * 8 + 2] = bf_lo(w.y); x[k * 8 + 3] = bf_hi(w.y); x[k * 8 + 4] = bf_lo(w.z); x[k * 8 + 5] = bf_hi(w.z); x[k * 8 + 6] = bf_lo(w.w); x[k * 8 + 7] = bf_hi(w.w); }
            }
            if (mix) {
                float mv[16]; float ss = 0.f;
#pragma unroll
                for (int k = 0; k < 2; ++k) { const u32x4 w = mw[rr][k];
                    mv[k * 8 + 0] = bf_lo(w.x); mv[k * 8 + 1] = bf_hi(w.x); mv[k * 8 + 2] = bf_lo(w.y); mv[k * 8 + 3] = bf_hi(w.y); mv[k * 8 + 4] = bf_lo(w.z); mv[k * 8 + 5] = bf_hi(w.z); mv[k * 8 + 6] = bf_lo(w.w); mv[k * 8 + 7] = bf_hi(w.w); }
#pragma unroll
                for (int e = 0; e < 16; ++e) ss += mv[e] * mv[e];
                ss = wave_sum(ss);
                const float rs = rsqrtf(ss * (1.0f / DM) + EPS);
#pragma unroll
                for (int k = 0; k < 2; ++k) { const float* gp = gpost + k * 512 + lane * 8; const f32x4 ga = *(const f32x4*)gp, gb = *(const f32x4*)(gp + 4);
#pragma unroll
                    for (int e = 0; e < 4; ++e) { x[k * 8 + e] += mv[k * 8 + e] * rs * ga[e]; x[k * 8 + 4 + e] += mv[k * 8 + 4 + e] * rs * gb[e]; } }
            }
#pragma unroll
            for (int k = 0; k < 2; ++k) {
                if (xout_f32) { float* xo = xout + (size_t)row * DM + k * 512 + lane * 8;
                    *(f32x4*)xo = (f32x4){x[k * 8 + 0], x[k * 8 + 1], x[k * 8 + 2], x[k * 8 + 3]}; *(f32x4*)(xo + 4) = (f32x4){x[k * 8 + 4], x[k * 8 + 5], x[k * 8 + 6], x[k * 8 + 7]}; }
                else { u32x4 wx; wx.x = cvt_pk_bf16(x[k * 8 + 0], x[k * 8 + 1]); wx.y = cvt_pk_bf16(x[k * 8 + 2], x[k * 8 + 3]); wx.z = cvt_pk_bf16(x[k * 8 + 4], x[k * 8 + 5]); wx.w = cvt_pk_bf16(x[k * 8 + 6], x[k * 8 + 7]);
                    *(u32x4*)(xout16 + (size_t)row * DM + k * 512 + lane * 8) = wx;
                    x[k * 8 + 0] = bf_lo(wx.x); x[k * 8 + 1] = bf_hi(wx.x); x[k * 8 + 2] = bf_lo(wx.y); x[k * 8 + 3] = bf_hi(wx.y); x[k * 8 + 4] = bf_lo(wx.z); x[k * 8 + 5] = bf_hi(wx.z); x[k * 8 + 6] = bf_lo(wx.w); x[k * 8 + 7] = bf_hi(wx.w); }
            }
            if (rsout) {
                float ss = 0.f;
#pragma unroll
                for (int e = 0; e < 16; ++e) ss += x[e] * x[e];
                ss = wave_sum(ss);
                if (lane == 0) rsout[row] = rsqrtf(ss * (1.0f / DM) + EPS);
            }
        }
    }
}

__device__ void scan_phase(const Ctx& c, const Params& p, int layer) {
    const float* Z = (const float*)(p.ws + WS_Z); bf16_t* Ug = (bf16_t*)(p.ws + WS_UG);
    const float* lamL = (const float*)(p.ws + WS_LAML) + (size_t)layer * NG * NP * 2;
    const int tid_ = opaque_tid(), wid_ = __builtin_amdgcn_readfirstlane(tid_ >> 6);
    for (int pr = wid_ * c.G + c.bx; pr < 4 * NG; pr += 8 * c.G) {
        const int b = pr >> 6, g = pr & 63, pp = tid_ & 63;
        const float lr = lamL[(g * NP + pp) * 2], li = lamL[(g * NP + pp) * 2 + 1];
        float sr = 0.f, si = 0.f;
        const size_t row0 = (size_t)g * NCH + b * 256;
#pragma unroll 8
        for (int ch = 0; ch < 256; ++ch) {
            const float zr = Z[(row0 + ch) * 128 + pp], zi = Z[(row0 + ch) * 128 + 64 + pp];
            bf16_t* o = Ug + (row0 + ch) * UGP + 512 + pp;
            const unsigned w = cvt_pk_bf16(sr, si);
            o[0] = (bf16_t)(w & 0xffffu); o[64] = (bf16_t)(w >> 16);
            const float nr = lr * sr - li * si + zr, ni = lr * si + li * sr + zi; sr = nr; si = ni;
        }
    }
}

__device__ void scan_after_z(const Ctx& c, const Params& p, int layer) {
    asm volatile("s_waitcnt vmcnt(0)" ::: "memory"); __syncthreads();
    __builtin_amdgcn_fence(__ATOMIC_ACQUIRE, "agent");
    asm volatile("s_waitcnt vmcnt(0)" ::: "memory");
    const float* Z = (const float*)(p.ws + WS_Z); bf16_t* Ug = (bf16_t*)(p.ws + WS_UG);
    const float* lamL = (const float*)(p.ws + WS_LAML) + (size_t)layer * NG * NP * 2;
    const int tid_ = opaque_tid(), wid_ = __builtin_amdgcn_readfirstlane(tid_ >> 6), pp = tid_ & 63;
    for (int i = wid_; ; i += 8) {
        const int L = i * c.G + c.vc; if (L >= 4 * NG) break;
        const int g = L >> 2, b = L & 3;
        const float lr = lamL[(g * NP + pp) * 2], li = lamL[(g * NP + pp) * 2 + 1];
        float sr = 0.f, si = 0.f;
        const size_t row0 = (size_t)g * NCH + b * 256;
#pragma unroll 8
        for (int ch = 0; ch < 256; ++ch) {
            const float zr = Z[(row0 + ch) * 128 + pp], zi = Z[(row0 + ch) * 128 + 64 + pp];
            bf16_t* o = Ug + (row0 + ch) * UGP + 512 + pp;
            const unsigned w = cvt_pk_bf16(sr, si);
            o[0] = (bf16_t)(w & 0xffffu); o[64] = (bf16_t)(w >> 16);
            const float nr = lr * sr - li * si + zr, ni = lr * si + li * sr + zi; sr = nr; si = ni;
        }
    }
}

#define ATTN_DMA(gp, ldsoff) __builtin_amdgcn_global_load_lds((const unsigned*)(gp), (LAS unsigned*)(lds + (ldsoff)), 16, 0, 0)
#define ATTN_PV(PB, VBASE) do { \
    bf16x8 fa__[8], fb__[8]; \
    _Pragma("unroll") for (int q_ = 0; q_ < 8; ++q_) fa__[q_] = *(LAS const bf16x8*)((VBASE) + (q_ >> 2) * 4096 + vo[q_ & 3]); \
    __builtin_amdgcn_sched_barrier(0); \
    _Pragma("unroll") for (int q_ = 0; q_ < 8; ++q_) fb__[q_] = *(LAS const bf16x8*)((VBASE) + (2 + (q_ >> 2)) * 4096 + vo[q_ & 3]); \
    _Pragma("unroll") for (int q_ = 0; q_ < 8; ++q_) o[q_ & 1] = __builtin_amdgcn_mfma_f32_32x32x16_bf16(fa__[(q_ & 1) * 4 + (q_ >> 1)], PB[q_ >> 1], o[q_ & 1], 0, 0, 0); \
    __builtin_amdgcn_sched_barrier(0); \
    _Pragma("unroll") for (int q_ = 0; q_ < 8; ++q_) o[2 + (q_ & 1)] = __builtin_amdgcn_mfma_f32_32x32x16_bf16(fb__[(q_ & 1) * 4 + (q_ >> 1)], PB[q_ >> 1], o[2 + (q_ & 1)], 0, 0, 0); \
    __builtin_amdgcn_sched_barrier(0); } while (0)
#define ATTN_QK(P0, P1, KB) do { \
    bf16x8 kf_[4]; \
    _Pragma("unroll") for (int d0 = 0; d0 < 4; ++d0) kf_[d0] = *(LAS const bf16x8*)((KB) + ko[d0]); \
    __builtin_amdgcn_sched_barrier(0); \
    P0 = __builtin_amdgcn_mfma_f32_32x32x16_bf16(kf_[0], qf[0], negm, 0, 0, 0); \
    _Pragma("unroll") for (int d0 = 1; d0 < 4; ++d0) P0 = __builtin_amdgcn_mfma_f32_32x32x16_bf16(kf_[d0], qf[d0], P0, 0, 0, 0); \
    __builtin_amdgcn_sched_barrier(0); \
    _Pragma("unroll") for (int d0 = 0; d0 < 4; ++d0) kf_[d0] = *(LAS const bf16x8*)((KB) + 8192 + ko[d0]); \
    __builtin_amdgcn_sched_barrier(0); \
    P1 = __builtin_amdgcn_mfma_f32_32x32x16_bf16(kf_[0], qf[0], negm, 0, 0, 0); \
    _Pragma("unroll") for (int d0 = 1; d0 < 4; ++d0) P1 = __builtin_amdgcn_mfma_f32_32x32x16_bf16(kf_[d0], qf[d0], P1, 0, 0, 0); \
    __builtin_amdgcn_sched_barrier(0); } while (0)
#define ATTN_BAND(P0, P1, DD) do { \
    __builtin_amdgcn_sched_barrier(0); \
    _Pragma("unroll") for (int r = 0; r < 16; ++r) { const int d0_ = (DD) - (16 * (r >> 3) + (r & 7)); P0[r] += btab[1 + min(max(d0_, -1), 127)]; } \
    __builtin_amdgcn_sched_barrier(0); \
    _Pragma("unroll") for (int r = 0; r < 16; ++r) { const int d1_ = (DD) - 32 - (16 * (r >> 3) + (r & 7)); P1[r] += btab[1 + min(max(d1_, -1), 127)]; } \
    __builtin_amdgcn_sched_barrier(0); } while (0)
#define ATTN_EXP(P0, P1, PB) do { \
    float ls0_ = 0.f, ls1_ = 0.f; \
    _Pragma("unroll") for (int r = 0; r < 16; ++r) { P0[r] = fexp2(P0[r]); P1[r] = fexp2(P1[r]); ls0_ += P0[r]; ls1_ += P1[r]; } \
    lrun += ls0_ + ls1_; \
    _Pragma("unroll") for (int q = 0; q < 2; ++q) { u32x4 w0_, w1_; \
        w0_.x = cvt_pk_bf16(P0[q * 8 + 0], P0[q * 8 + 1]); w0_.y = cvt_pk_bf16(P0[q * 8 + 2], P0[q * 8 + 3]); w0_.z = cvt_pk_bf16(P0[q * 8 + 4], P0[q * 8 + 5]); w0_.w = cvt_pk_bf16(P0[q * 8 + 6], P0[q * 8 + 7]); \
        w1_.x = cvt_pk_bf16(P1[q * 8 + 0], P1[q * 8 + 1]); w1_.y = cvt_pk_bf16(P1[q * 8 + 2], P1[q * 8 + 3]); w1_.z = cvt_pk_bf16(P1[q * 8 + 4], P1[q * 8 + 5]); w1_.w = cvt_pk_bf16(P1[q * 8 + 6], P1[q * 8 + 7]); \
        PB[q] = __builtin_bit_cast(bf16x8, w0_); PB[2 + q] = __builtin_bit_cast(bf16x8, w1_); } } while (0)
__device__ void attn_phase(const Ctx& c, const bf16_t* Q, const bf16_t* Kg, const bf16_t* Vt, bf16_t* ON, const float* biasT, const float* scal, const float* hn) {
    constexpr int SUB = 16384, STAGE = 32768, V_OFF = 65536, BT_OFF = 131072 + 128;
    LAS unsigned char* lds = c.lds;
    LAS unsigned char* ldsr = lds; asm volatile("" : "+s"(ldsr) :: "memory");
    for (int itu = 0; ; ++itu) {
        const int L = itu * c.G + c.vc; if (L >= 2048) break;
        const int tid = opaque_tid(), lane = tid & 63, wid = __builtin_amdgcn_readfirstlane(tid >> 6), br = wid >> 2, wq = wid & 3, l31 = lane & 31, hi = lane >> 5;
        const int prow = (l31 & ~12) | ((l31 & 4) << 1) | ((l31 & 8) >> 1);
        const int kbase = prow * 256, kx0 = (br * 8 + hi) ^ (prow & 15);
        const int vbase = V_OFF + l31 * 128, vx0 = hi ^ ((l31 >> 1) & 7);
        int ko[4], vo[4];
#pragma unroll
        for (int q = 0; q < 4; ++q) { ko[q] = (kx0 ^ (q << 1)) << 4; vo[q] = (vx0 ^ (q << 1)) << 4; }
        const int kr0 = 4 * wid + (lane >> 4), kc = (lane & 15) ^ (kr0 & 15);
        const int vr0 = 8 * wid + (lane >> 3), vcx = (lane & 7) ^ ((vr0 >> 1) & 7);
        const int dst0 = wid * 1024, dst1 = (wid + 8) * 1024;
        LAS const float* btab = (LAS const float*)(lds + BT_OFF);
        const int i7 = 7 - (L >> 8), pair = (L & 255) >> 3, jj8 = L & 7;
        const int qb = (i7 & 1) ? (16 * (i7 >> 1) + 15 - jj8) : (16 * (i7 >> 1) + jj8);
        const int b = pair >> 3, h = pair & 7, q0 = qb * 128, NI = qb + 1;
        const size_t tokb = (size_t)b * SEQ;
        const bf16_t* kg = Kg + (tokb + kr0) * DM + h * 128 + kc * 8;
        const bf16_t* vg = Vt + ((size_t)((b * 8 + h) * 128) << 13) + vr0 * 64 + vcx * 8;
        const bf16_t* qp = Q + (tokb + q0 + wq * 32 + l31) * DM + h * 128 + br * 64 + hi * 8;
        bf16x8 qf[4];
#pragma unroll
        for (int d0 = 0; d0 < 4; ++d0) qf[d0] = *(const bf16x8*)(qp + d0 * 16);
        if (tid < 128) ((LAS float*)(lds + BT_OFF))[1 + tid] = biasT[h * 128 + tid];
        if (tid == 128) ((LAS float*)(lds + BT_OFF))[0] = -1e30f;
#pragma unroll
        for (int sb = 0; sb < 2; ++sb) {
            ATTN_DMA(kg + (size_t)sb * 64 * DM, sb * SUB + dst0); ATTN_DMA(kg + (size_t)(sb * 64 + 32) * DM, sb * SUB + dst1);
            ATTN_DMA(vg + (size_t)sb * 8192, V_OFF + sb * SUB + dst0); ATTN_DMA(vg + (size_t)sb * 8192 + 4096, V_OFF + sb * SUB + dst1);
        }
        f32x16 o[4], negm;
#pragma unroll
        for (int r = 0; r < 16; ++r) { o[0][r] = 0.f; o[1][r] = 0.f; o[2][r] = 0.f; o[3][r] = 0.f; negm[r] = 0.f; }
        float lrun = 0.f;
        const int qrow = q0 + wq * 32 + l31;
        for (int it = 0; it < NI; ++it) {
            const int st = it & 1, kt0 = it * 128;
            asm volatile("s_waitcnt vmcnt(0) lgkmcnt(0)\n\ts_barrier" ::: "memory");
            if (it + 1 < NI) { const int s2 = (st ^ 1) * STAGE;
#pragma unroll
                for (int sb = 0; sb < 2; ++sb) { const bf16_t* kn = kg + (size_t)(kt0 + 128 + sb * 64) * DM; const bf16_t* vn = vg + (size_t)((it + 1) * 2 + sb) * 8192;
                    ATTN_DMA(kn, s2 + sb * SUB + dst0); ATTN_DMA(kn + 32 * DM, s2 + sb * SUB + dst1);
                    ATTN_DMA(vn, V_OFF + s2 + sb * SUB + dst0); ATTN_DMA(vn + 4096, V_OFF + s2 + sb * SUB + dst1); } }
            LAS const unsigned char* kbp = ldsr + st * STAGE + kbase;
            LAS const unsigned char* vbp = ldsr + st * STAGE + vbase;
#pragma unroll
            for (int sb = 0; sb < 2; ++sb) {
                f32x16 pa0, pa1;
                ATTN_QK(pa0, pa1, kbp + sb * SUB);
                if (it >= NI - 2) { const int dd = qrow - kt0 - sb * 64 - 8 * hi; ATTN_BAND(pa0, pa1, dd); }
                float mxa = max3f(pa0[0], pa0[1], pa1[0]), mxb = max3f(pa0[2], pa0[3], pa1[1]); mxa = max3f(mxa, pa1[2], pa1[3]);
#pragma unroll
                for (int r = 4; r < 16; r += 4) { mxa = max3f(mxa, pa0[r], pa0[r + 1]); mxb = max3f(mxb, pa0[r + 2], pa0[r + 3]); mxa = max3f(mxa, pa1[r], pa1[r + 1]); mxb = max3f(mxb, pa1[r + 2], pa1[r + 3]); }
                float mx = max2f(mxa, mxb);
                { const auto rr_ = __builtin_amdgcn_permlane32_swap(__float_as_uint(mx), __float_as_uint(mx), false, false); mx = max2f(__uint_as_float(rr_[0]), __uint_as_float(rr_[1])); }
                if ((it == 0 && sb == 0) || __any(mx > 8.0f)) {
                    const float delta = (it == 0 && sb == 0) ? mx : fmaxf(mx, 0.f), alpha = fexp2(-delta); lrun *= alpha;
#pragma unroll
                    for (int r = 0; r < 16; ++r) { pa0[r] -= delta; pa1[r] -= delta; negm[r] -= delta; }
#pragma unroll
                    for (int q = 0; q < 4; ++q) o[q] = o[q] * alpha;
                }
                bf16x8 pk[4];
                ATTN_EXP(pa0, pa1, pk);
                ATTN_PV(pk, vbp + sb * SUB);
            }
        }
        __syncthreads();
        const int te = opaque_tid(), le31 = te & 31, hie = (te & 63) >> 5, wide = __builtin_amdgcn_readfirstlane(te >> 6), wqe = wide & 3;
        const float lam = scal[0], onem = scal[1];
        float inv = frcp(lrun + __shfl_xor(lrun, 32));
        if (wide >= 4) inv *= lam;
        LAS float* comb = (LAS float*)lds;
        if (wide >= 4) {
#pragma unroll
            for (int blk = 0; blk < 4; ++blk)
#pragma unroll
                for (int r = 0; r < 16; ++r) comb[(wqe * 128 + blk * 32 + (r & 3) + 8 * (r >> 2) + 4 * hie) * 32 + le31] = o[blk][r] * inv;
        }
        __syncthreads();
        if (wide < 4) {
            float ss = 0.f;
#pragma unroll
            for (int blk = 0; blk < 4; ++blk)
#pragma unroll
                for (int r = 0; r < 16; ++r) { const float v = o[blk][r] * inv - comb[(wqe * 128 + blk * 32 + (r & 3) + 8 * (r >> 2) + 4 * hie) * 32 + le31]; o[blk][r] = v; ss += v * v; }
            ss += __shfl_xor(ss, 32);
            const float rs = rsqrtf(ss * (1.0f / 128.0f) + EPS) * onem;
            bf16_t* op = ON + ((size_t)b * SEQ + q0 + wqe * 32 + le31) * DM + h * 128;
#pragma unroll
            for (int blk = 0; blk < 4; ++blk)
#pragma unroll
                for (int r4 = 0; r4 < 4; ++r4) { const int dv = blk * 32 + 8 * r4 + 4 * hie; const f32x4 g4 = *(const f32x4*)(hn + dv);
                    u32x2 w; w.x = cvt_pk_bf16(o[blk][r4 * 4 + 0] * rs * g4[0], o[blk][r4 * 4 + 1] * rs * g4[1]); w.y = cvt_pk_bf16(o[blk][r4 * 4 + 2] * rs * g4[2], o[blk][r4 * 4 + 3] * rs * g4[3]);
                    *(u32x2*)(op + dv) = w; }
        }
        __syncthreads();
    }
}
#undef ATTN_PV
#undef ATTN_QK
#undef ATTN_BAND
#undef ATTN_EXP
#undef ATTN_DMA

__global__ void __launch_bounds__(512, 2) yoco_fwd(Params p) {
    extern __shared__ __attribute__((aligned(16))) unsigned char lds_raw[];
    cg::grid_group grid = cg::this_grid();
    Ctx c; c.lds = (LAS unsigned char*)lds_raw; c.tid = threadIdx.x; c.lane = c.tid & 63; c.wid = __builtin_amdgcn_readfirstlane(c.tid >> 6);
    c.G = gridDim.x; c.bx = blockIdx.x; c.vc = (c.G % 8 == 0) ? (c.bx % 8) * (c.G / 8) + c.bx / 8 : c.bx;
    unsigned char* ws = p.ws;
    float* X = p.out;
    { volatile LAS unsigned* xst0 = (volatile LAS unsigned*)(c.lds + 131072); if (c.tid < 4) xst0[c.tid] = 0u; }
    __syncthreads();
    (void)xcd_barrier_post((unsigned*)(ws + WS_BAR), (volatile LAS unsigned*)(c.lds + 131072));
    bf16_t* HM = (bf16_t*)(ws + WS_HM); bf16_t* ACT = (bf16_t*)(ws + WS_ACT);
    bf16_t* UG = (bf16_t*)(ws + WS_UG); float* Zb = (float*)(ws + WS_Z); bf16_t* YG = (bf16_t*)(ws + WS_YG);
    bf16_t* Qb = (bf16_t*)(ws + WS_Q); bf16_t* ONb = (bf16_t*)(ws + WS_ON); bf16_t* HKV = (bf16_t*)(ws + WS_HKV);
    bf16_t* Kb = (bf16_t*)(ws + WS_K); bf16_t* Vtb = (bf16_t*)(ws + WS_VT);

    enum { K_PRO = 0, K_WIN = 1, K_Z = 2, K_SCAN = 3, K_Y = 4, K_GLU = 5, K_NORMA = 6, K_UP = 7, K_DOWN = 8, K_NORMB = 9, K_K = 10, K_VT = 11, K_Q = 12, K_ATTN = 13, K_O = 14 };
    for (int ph = 0; ph < 35; ++ph) {
        int kind, layer;
        if (ph == 0) { kind = K_PRO; layer = 0; }
        else if (ph < 19) { layer = (ph - 1) / 9; kind = 1 + (ph - 1) % 9; }
        else { int k; if (ph < 28) { layer = 2; k = ph - 19; } else { layer = 3; k = ph - 26; }
            kind = k < 3 ? K_K + k : (k == 3 ? K_ATTN : (k == 4 ? K_O : K_NORMA + (k - 5))); }
        const int j = layer & 1;
        if (kind == K_SCAN) continue;
        for (int rep = 0; rep < (((REPEAT_MASK >> kind) & 1) ? 2 : 1); ++rep) {
        { int t_ = threadIdx.x; asm volatile("" : "+v"(t_)); c.tid = t_; c.lane = t_ & 63; c.wid = __builtin_amdgcn_readfirstlane(t_ >> 6); }
        const bool is_gemm = (kind == K_WIN) | (kind == K_Z) | (kind == K_Y) | (kind == K_GLU) | (kind == K_UP) | (kind == K_DOWN) | (kind == K_K) | (kind == K_VT) | (kind == K_Q) | (kind == K_O);
        if (is_gemm) {
            pg8::Job jb; jb.lda = DM; jb.ldb = DM; jb.K = DM; jb.ord = pg8::ORD_STATIC; jb.M = TOK; jb.N = DM; jb.epi = pg8::EPI_STORE; jb.ldc = DM; jb.scale = 1.0f; jb.O = HM; jb.x1 = nullptr; jb.x2 = nullptr; jb.A = HM; jb.Bt = nullptr;
            const bf16_t* X16 = (const bf16_t*)X; const float* RS = (const float*)(ws + WS_RS);
            switch (kind) {
            case K_WIN: jb.A = X16; jb.x2 = RS; jb.Bt = (const bf16_t*)(ws + WS_WIN) + (size_t)j * DM * DM; jb.epi = pg8::EPI_UG; jb.O = UG; break;
            case K_Z: jb.A = UG; jb.Bt = (const bf16_t*)(ws + WS_SIN) + (size_t)j * NG * 128 * 512; jb.lda = UGP; jb.ldb = 512; jb.K = 512; jb.ord = pg8::ORD_Z; jb.epi = pg8::EPI_Z; jb.O = Zb; break;
            case K_Y: jb.A = UG; jb.Bt = (const bf16_t*)(ws + WS_TM) + (size_t)j * NG * 512 * UGP; jb.lda = UGP; jb.ldb = UGP; jb.K = UGP; jb.ord = pg8::ORD_Y; jb.epi = pg8::EPI_Y; jb.O = YG; jb.x1 = UG; jb.x2 = p.in[15] + (size_t)j * DM; break;
            case K_GLU: jb.A = YG; jb.Bt = (const bf16_t*)(ws + WS_GLU) + (size_t)j * DM * 2 * DM; jb.N = 2 * DM; jb.epi = pg8::EPI_GLU; break;
            case K_UP: jb.A = layer == 3 ? (const bf16_t*)Kb : X16; jb.x2 = RS; jb.Bt = (const bf16_t*)(ws + (layer < 2 ? WS_UP01 : WS_UP23)) + (size_t)j * DM * FF; jb.N = FF; jb.epi = pg8::EPI_RELU2; jb.O = ACT; jb.ldc = FF; break;
            case K_DOWN: jb.A = ACT; jb.Bt = (const bf16_t*)(ws + (layer < 2 ? WS_DN01 : WS_DN23)) + (size_t)j * DM * FF; jb.lda = FF; jb.ldb = FF; jb.K = FF; break;
            case K_K: jb.A = X16; jb.x2 = RS; jb.Bt = (const bf16_t*)(ws + WS_KVW); jb.O = Kb; break;
            case K_VT: jb.A = (const bf16_t*)(ws + WS_KVW) + (size_t)DM * DM; jb.Bt = X16; jb.x2 = RS; jb.M = DM; jb.N = TOK; jb.O = Vtb; jb.epi = pg8::EPI_VT; break;
            case K_Q: jb.A = X16; jb.x2 = RS; jb.Bt = (const bf16_t*)(ws + WS_QW) + (size_t)j * DM * DM; jb.O = Qb; jb.scale = 0.125f * LOG2E; break;
            default:   jb.A = ONb; jb.Bt = (const bf16_t*)(ws + WS_OW) + (size_t)j * DM * DM; break;
            }
#ifndef NO_GEMM
            pg8::gemm_phase(c.lds, jb, c.G, c.bx, c.vc, c.tid);
#endif
            if (kind == K_Z) scan_after_z(c, p, j);
        } else if (kind == K_NORMA || kind == K_NORMB || kind == K_PRO) {
            if (kind == K_PRO) {
#ifndef NO_TAB
                for (int u = c.bx; u < 2 * NG; u += c.G) ssm_tables(c, p, u >> 6, u & 63);
#endif
                if (c.bx == c.G - 1) small_tables(c, p);
#ifndef NO_CONV
                convert_weights(c, p);
#endif
            }
            const void* xin = X; void* xout = X; int xin_f32 = 0, xout_f32 = 0; const bf16_t* mix = HM; const float* gpost = nullptr; float* rsout = (float*)(ws + WS_RS);
            if (kind == K_PRO) { xin = p.in[0]; xin_f32 = 1; mix = nullptr; }
            else if (kind == K_NORMA) { if (layer == 3) xout = Kb; gpost = p.in[2] + layer * DM; }
            else { gpost = p.in[4] + layer * DM; if (layer == 3) { xin = Kb; xout_f32 = 1; rsout = nullptr; } }
#ifndef NO_NORM
            norm_phase(c, xin, xin_f32, xout, xout_f32, mix, gpost, rsout);
#endif
        } else if (kind == K_SCAN) {
#ifndef NO_SCAN
            scan_phase(c, p, j);
#endif
        } else {
#ifndef NO_ATTN
            attn_phase(c, Qb, Kb, Vtb, ONb, (const float*)(ws + WS_BIAS), (const float*)(ws + WS_SCAL) + j * 4, p.in[24] + j * 128);
#endif
        }
        }
        if (!(kind == K_K || kind == K_VT || ph == 34)) { if (ph == 0) grid.sync(); else { XcdBarrier xb_; xb_.bar = (unsigned*)(ws + WS_BAR); xb_.x = xb_xcc_id(); xb_.st = (volatile LAS unsigned*)(c.lds + 131072); xcd_barrier(xb_); } }
    }
}

extern "C" void kernel_launch(void* const* d_in, const int* in_sizes, int n_in, void* d_out, int out_size, void* d_ws, size_t ws_size, hipStream_t stream) {
    static int grid_blocks = 0;
    if (grid_blocks == 0) {
        if (n_in != 27 || out_size != TOK * DM || ws_size < WS_END) { fprintf(stderr, "kernel_launch: unexpected shapes (n_in %d, out %d, ws %zu)\n", n_in, out_size, ws_size); grid_blocks = -1; return; }
        int dev = 0, cus = 0, per_cu = 0;
        hipGetDevice(&dev);
        hipDeviceGetAttribute(&cus, hipDeviceAttributeMultiprocessorCount, dev);
        if (hipFuncSetAttribute((const void*)yoco_fwd, hipFuncAttributeMaxDynamicSharedMemorySize, LDS_BYTES) != hipSuccess) { fprintf(stderr, "kernel_launch: hipFuncSetAttribute failed\n"); grid_blocks = -1; return; }
        if (hipOccupancyMaxActiveBlocksPerMultiprocessor(&per_cu, (const void*)yoco_fwd, 512, LDS_BYTES) != hipSuccess || per_cu < 1) { fprintf(stderr, "kernel_launch: occupancy query says %d\n", per_cu); per_cu = 1; }
        (void)hipGetLastError();
        grid_blocks = cus * 1;
    }
    if (grid_blocks < 0) return;
    Params p{};
    for (int i = 0; i < 27; ++i) p.in[i] = (const float*)d_in[i];
    p.out = (float*)d_out; p.ws = (unsigned char*)d_ws;
    if (hipMemsetAsync((char*)d_ws + WS_BAR, 0, 16384, stream) != hipSuccess) { fprintf(stderr, "kernel_launch: memset of barrier words failed\n"); return; }
    void* args[] = {&p};
    hipError_t e = hipLaunchCooperativeKernel((const void*)yoco_fwd, dim3(grid_blocks), dim3(512), args, LDS_BYTES, stream);
    if (e != hipSuccess) fprintf(stderr, "cooperative launch failed: %s (grid %d)\n", hipGetErrorString(e), grid_blocks);
}
```

```cpp
#include <hip/hip_runtime.h>
#include <hip/hip_cooperative_groups.h>
#include <cstdio>
#include <cstdint>
namespace cg = cooperative_groups;

#define LAS __attribute__((address_space(3)))
typedef unsigned short bf16_t;
typedef short bf16x8 __attribute__((ext_vector_type(8)));
typedef float f32x4 __attribute__((ext_vector_type(4)));
typedef float f32x16 __attribute__((ext_vector_type(16)));
typedef unsigned u32x4 __attribute__((ext_vector_type(4)));
typedef unsigned u32x2 __attribute__((ext_vector_type(2)));

constexpr int TOK = 32768, DM = 1024, FF = 4096, SEQ = 8192;
constexpr int NG = 64, GS = 16, NP = 64;
constexpr int CL = 32;
constexpr int NCH = TOK / CL;
constexpr int UGP = CL * GS + 2 * NP;
constexpr float EPS = 1e-6f;
constexpr float LOG2E = 1.4426950408889634f;

constexpr size_t MiB = 1u << 20;
constexpr size_t WS_BIAS = 0;
constexpr size_t WS_SCAL = 4096;
constexpr size_t WS_LAML = 8192;
constexpr size_t WS_RS = 786432;
constexpr size_t WS_BAR = 131072;
constexpr size_t WS_UP23 = 1 * MiB;
constexpr size_t WS_DN23 = 17 * MiB;
constexpr size_t WS_KVW = 33 * MiB;
constexpr size_t WS_QW = 37 * MiB;
constexpr size_t WS_OW = 41 * MiB;
constexpr size_t WS_UP01 = 45 * MiB;
constexpr size_t WS_DN01 = 61 * MiB;
constexpr size_t WS_WIN = 77 * MiB;
constexpr size_t WS_GLU = 81 * MiB;
constexpr size_t WS_TM = 89 * MiB;
constexpr size_t WS_SIN = 169 * MiB;
constexpr size_t WS_K = 45 * MiB;
constexpr size_t WS_VT = 109 * MiB;
constexpr size_t WS_HM = 186 * MiB;
constexpr size_t WS_ACT = 250 * MiB;
constexpr size_t WS_UG = WS_ACT;
constexpr size_t WS_Z = WS_ACT + 80 * MiB;
constexpr size_t WS_YG = WS_ACT + 112 * MiB;
constexpr size_t WS_Q = WS_ACT;
constexpr size_t WS_ON = WS_ACT + 64 * MiB;
constexpr size_t WS_HKV = WS_ACT + 128 * MiB;
constexpr size_t WS_END = 506 * MiB;

constexpr int LDS_BYTES = 147456;
#ifndef REPEAT_MASK
#define REPEAT_MASK 0
#endif

__device__ __forceinline__ unsigned cvt_pk_bf16(float lo, float hi) { unsigned r; asm("v_cvt_pk_bf16_f32 %0, %1, %2" : "=v"(r) : "v"(lo), "v"(hi)); return r; }
__device__ __forceinline__ float bf_lo(unsigned w) { return __uint_as_float(w << 16); }
__device__ __forceinline__ float bf_hi(unsigned w) { return __uint_as_float(w & 0xffff0000u); }
__device__ __forceinline__ float fexp2(float x) { return __builtin_amdgcn_exp2f(x); }
__device__ __forceinline__ float frcp(float x) { return __builtin_amdgcn_rcpf(x); }
__device__ __forceinline__ float max3f(float a, float b, float c) { float r; asm("v_max3_f32 %0, %1, %2, %3" : "=v"(r) : "v"(a), "v"(b), "v"(c)); return r; }
__device__ __forceinline__ float max2f(float a, float b) { float r; asm("v_max_f32_e32 %0, %1, %2" : "=v"(r) : "v"(a), "v"(b)); return r; }
__device__ __forceinline__ int opaque_tid() { int t_ = threadIdx.x; asm volatile("" : "+v"(t_)); return t_; }
__device__ __forceinline__ float wave_sum(float v) {
#pragma unroll
    for (int o = 32; o >= 1; o >>= 1) v += __shfl_xor(v, o);
    return v;
}
__device__ __forceinline__ float gelu_tanh(float y) {
    const float t = y * (1.5957691216057308f + 0.07135481627f * y * y);
    return y * frcp(1.0f + fexp2(-t * LOG2E));
}

namespace pg8 {
constexpr int BM = 256, BK = 64, HALF = 128, HTB = HALF * BK * 2, STAGE_BYTES = 8 * HTB;
__host__ __device__ __forceinline__ int lds_byte(int r, int c) { const int st = (r >> 4) * 2 + (c >> 5), rr = r & 15, cc = c & 31, ob = rr * 64 + cc * 2; return st * 1024 + (ob ^ (((ob >> 9) & 1) << 5)); }
__host__ __device__ __forceinline__ void stage_rc(int b, int& R, int& C) { const int st = b / 1024, sb = b % 1024, swz = sb ^ (((sb >> 9) & 1) << 5); R = (st >> 1) * 16 + swz / 64; C = (st & 1) * 32 + (swz % 64) / 2; }
__host__ __device__ __forceinline__ int perm32(int rho) { const int n = rho >> 4, i = rho & 15; return 8 * (i >> 2) + 4 * n + (i & 3); }

struct Unit { int pm, pn, arow, brow; };
enum { ORD_STATIC = 0, ORD_Z = 1, ORD_Y = 2 };
enum { EPI_STORE = 0, EPI_RELU2 = 1, EPI_GLU = 2, EPI_UG = 3, EPI_Z = 4, EPI_Y = 5, EPI_VT = 6 };
struct Job { const bf16_t* A; const bf16_t* Bt; int lda, ldb, K, ord, M, N, epi, ldc; float scale; void* O; const void* x1; const void* x2; };

__device__ __forceinline__ bool next_unit(const Job& jb, int G, int bx, int vc, int i, Unit& u) {
    if (jb.ord == ORD_STATIC) {
        const int nM = jb.M / BM, nN = jb.N / BM, nwg = nM * nN;
        const long L = (long)i * G + bx; if (L >= nwg) return false;
        int wgid = (int)L; { const int q = nwg / 8, r = nwg % 8, xcd = wgid % 8, off = wgid / 8; wgid = (xcd < r ? xcd * (q + 1) : r * (q + 1) + (xcd - r) * q) + off; }
        const int nig = 8 * nN, gid = wgid / nig, fm = gid * 8, gsz = (nM - fm) < 8 ? (nM - fm) : 8;
        u.pm = fm + ((wgid % nig) % gsz); u.pn = (wgid % nig) / gsz; u.arow = u.pm * BM; u.brow = u.pn * BM; return true;
    } else if (jb.ord == ORD_Z) {
        const int L = i * G + vc; if (L >= NG * 4) return false; u.pm = L; u.pn = 0; u.arow = L * BM; u.brow = (L >> 2) * 128; return true;
    } else {
        const int L = i * G + vc; if (L >= NG * 8) return false; const int g = L >> 3, r = L & 7; u.pm = g * 4 + (r >> 1); u.pn = g * 2 + (r & 1); u.arow = u.pm * BM; u.brow = u.pn * BM; return true;
    }
}

typedef f32x4 Acc[2][2][4][2];
__device__ __forceinline__ u32x4 pack8(const f32x4 v0, const f32x4 v1) { u32x4 w; w.x = cvt_pk_bf16(v0[0], v0[1]); w.y = cvt_pk_bf16(v0[2], v0[3]); w.z = cvt_pk_bf16(v1[0], v1[1]); w.w = cvt_pk_bf16(v1[2], v1[3]); return w; }

__device__ __forceinline__ void epilogue(const Job& jb, const Acc& acc, const Unit& u) {
    int t_ = threadIdx.x; asm volatile("" : "+v"(t_));
    const int wid_ = __builtin_amdgcn_readfirstlane(t_ >> 6), wr = wid_ >> 2, wc = wid_ & 3, fr = t_ & 15, fq = (t_ & 63) >> 4;
    const int row0 = u.pm * BM + wr * 64 + fr;
#ifdef EPI_MASK
    const int epi_ = ((1 << jb.epi) & EPI_MASK) ? jb.epi : 0;
#else
    const int epi_ = jb.epi;
#endif
    if (epi_ == EPI_STORE || epi_ == EPI_RELU2) {
        bf16_t* O = (bf16_t*)jb.O; const int col0 = u.pn * BM + wc * 32 + 8 * fq; const bool r2 = epi_ == EPI_RELU2; const float scale = jb.scale; const float* rsc = (const float*)jb.x2;
#pragma unroll
        for (int ai = 0; ai < 2; ++ai)
#pragma unroll
            for (int m = 0; m < 4; ++m) { bf16_t* rowp = O + (size_t)(row0 + ai * HALF + m * 16) * jb.ldc + col0;
                float rsv = 1.0f; if (rsc) { rsv = rsc[row0 + ai * HALF + m * 16]; if (r2) rsv = rsv * rsv; }
                const float sc_ = scale * rsv;
#pragma unroll
                for (int bj = 0; bj < 2; ++bj) { f32x4 v0 = acc[ai][bj][m][0], v1 = acc[ai][bj][m][1];
                    if (r2) {
#pragma unroll
                        for (int e = 0; e < 4; ++e) { const float a = fmaxf(v0[e], 0.f), b = fmaxf(v1[e], 0.f); v0[e] = a * a; v1[e] = b * b; } }
                    v0 = v0 * sc_; v1 = v1 * sc_;
                    *(u32x4*)(rowp + bj * HALF) = pack8(v0, v1); } }
    } else if (epi_ == EPI_GLU) {
        bf16_t* O = (bf16_t*)jb.O; const int col0 = u.pn * HALF + wc * 32 + 8 * fq;
#pragma unroll
        for (int ai = 0; ai < 2; ++ai)
#pragma unroll
            for (int m = 0; m < 4; ++m) { bf16_t* rowp = O + (size_t)(row0 + ai * HALF + m * 16) * DM + col0;
                f32x4 o0, o1;
#pragma unroll
                for (int e = 0; e < 4; ++e) { o0[e] = acc[ai][0][m][0][e] * frcp(1.0f + fexp2(-acc[ai][1][m][0][e] * LOG2E)); o1[e] = acc[ai][0][m][1][e] * frcp(1.0f + fexp2(-acc[ai][1][m][1][e] * LOG2E)); }
                *(u32x4*)rowp = pack8(o0, o1); }
    } else if (epi_ == EPI_UG) {
        bf16_t* Ug = (bf16_t*)jb.O; const float* rsc = (const float*)jb.x2;
#pragma unroll
        for (int ai = 0; ai < 2; ++ai)
#pragma unroll
            for (int m = 0; m < 4; ++m) { const int tok = row0 + ai * HALF + m * 16; const float rsv = rsc[tok];
#pragma unroll
                for (int bj = 0; bj < 2; ++bj) { const int g = u.pn * 16 + bj * 8 + wc * 2 + (fq >> 1);
                    *(u32x4*)(Ug + ((size_t)(g * NCH + (tok >> 5)) * UGP + (tok & 31) * 16 + (fq & 1) * 8)) = pack8(acc[ai][bj][m][0] * rsv, acc[ai][bj][m][1] * rsv); } }
    } else if (epi_ == EPI_Z) {
        float* Z = (float*)jb.O; const int col0 = wc * 32 + 8 * fq;
#pragma unroll
        for (int ai = 0; ai < 2; ++ai)
#pragma unroll
            for (int m = 0; m < 4; ++m) { float* p = Z + (size_t)(row0 + ai * HALF + m * 16) * 128 + col0;
                *(f32x4*)p = acc[ai][0][m][0]; *(f32x4*)(p + 4) = acc[ai][0][m][1]; }
    } else if (epi_ == EPI_VT) {
        bf16_t* O = (bf16_t*)jb.O; const int col0 = u.pn * BM + wc * 32 + 8 * fq; const float* rsc = (const float*)jb.x2;
        const f32x4 ra0 = *(const f32x4*)(rsc + col0), rb0 = *(const f32x4*)(rsc + col0 + 4), ra1 = *(const f32x4*)(rsc + col0 + HALF), rb1 = *(const f32x4*)(rsc + col0 + HALF + 4);
#pragma unroll
        for (int ai = 0; ai < 2; ++ai)
#pragma unroll
            for (int m = 0; m < 4; ++m) { const int row = row0 + ai * HALF + m * 16;
#pragma unroll
                for (int bj = 0; bj < 2; ++bj) { const int col = col0 + bj * HALF;
                    const size_t off = ((size_t)(((col >> 13) * 8 + (row >> 7)) * 128 + ((col & 8191) >> 6)) << 13) + (row & 127) * 64 + (col & 63);
                    *(u32x4*)(O + off) = pack8(acc[ai][bj][m][0] * (bj ? ra1 : ra0), acc[ai][bj][m][1] * (bj ? rb1 : rb0)); } }
    } else {
        const bf16_t* Ug = (const bf16_t*)jb.x1; const float* dsk = (const float*)jb.x2; bf16_t* YG = (bf16_t*)jb.O;
        const int g = u.pm >> 2, n0 = (u.pm & 3) * BM + wr * 64 + fr, c0 = (u.pn & 1) * BM + wc * 32 + 8 * fq;
        const int co0 = (fq & 1) * 8;
        const f32x4 d0 = *(const f32x4*)(dsk + g * 16 + co0), d1 = *(const f32x4*)(dsk + g * 16 + co0 + 4);
#pragma unroll
        for (int ai = 0; ai < 2; ++ai)
#pragma unroll
            for (int m = 0; m < 4; ++m) { const int n = n0 + ai * HALF + m * 16;
#pragma unroll
                for (int bj = 0; bj < 2; ++bj) { const int cc = c0 + bj * HALF, j = cc >> 4;
                    const u32x4 uu = *(const u32x4*)(Ug + ((size_t)(g * NCH + n) * UGP + cc));
                    const f32x4 v0 = acc[ai][bj][m][0], v1 = acc[ai][bj][m][1];
                    f32x4 y0, y1;
                    y0[0] = v0[0] + d0[0] * bf_lo(uu.x); y0[1] = v0[1] + d0[1] * bf_hi(uu.x); y0[2] = v0[2] + d0[2] * bf_lo(uu.y); y0[3] = v0[3] + d0[3] * bf_hi(uu.y);
                    y1[0] = v1[0] + d1[0] * bf_lo(uu.z); y1[1] = v1[1] + d1[1] * bf_hi(uu.z); y1[2] = v1[2] + d1[2] * bf_lo(uu.w); y1[3] = v1[3] + d1[3] * bf_hi(uu.w);
#pragma unroll
                    for (int e = 0; e < 4; ++e) { y0[e] = gelu_tanh(y0[e]); y1[e] = gelu_tanh(y1[e]); }
                    *(u32x4*)(YG + ((size_t)(n * CL + j) * DM + g * 16 + co0)) = pack8(y0, y1); } }
    }
}

__device__ __forceinline__ void gemm_phase(LAS unsigned char* lds, const Job& g, const int G, const int bx, const int vc, const int tid_unused) {
    const int tid = opaque_tid(); (void)tid_unused;
    const int wid = __builtin_amdgcn_readfirstlane(tid >> 6), lane = tid & 63, wr = wid >> 2, wc = wid & 3, fr = lane & 15, fq = lane >> 4;
    const int K = g.K, nt = K / BK;
    unsigned voffA[2], voffB[2];
#pragma unroll
    for (int i = 0; i < 2; ++i) { int R, C; stage_rc(tid * 16 + i * 8192, R, C); const int Rb = (R & ~31) + perm32(R & 31);
        voffA[i] = (unsigned)(R * g.lda + C) * 2u; voffB[i] = (unsigned)(Rb * g.ldb + C) * 2u; }
    const size_t kstep = (size_t)(BK * 2);
    const size_t hstepA = (size_t)HALF * g.lda * 2, hstepB = (size_t)HALF * g.ldb * 2;
    const size_t rowA = (size_t)g.lda * 2, rowB = (size_t)g.ldb * 2;
    const unsigned ldsw = (unsigned)wid * 1024u;
    const int aoff = lds_byte(wr * 64 + fr, fq * 8), boff = lds_byte(wc * 32 + fr, fq * 8);
#define PG8_SA(b, h) (((b) * 2 + (h)) * HTB)
#define PG8_SB(b, h) ((4 + (b) * 2 + (h)) * HTB)
#define PG8_STAGE(bufoff, gbase, voff) do { _Pragma("unroll") for (int _i = 0; _i < 2; ++_i) \
        __builtin_amdgcn_global_load_lds((const unsigned*)((const char*)(gbase) + (voff)[_i]), (LAS unsigned*)(lds + (bufoff) + ldsw + _i * 8192), 16, 0, 0); } while (0)
#define PG8_LDA(dst, b, h) do { _Pragma("unroll") for (int m = 0; m < 4; ++m) _Pragma("unroll") for (int k = 0; k < 2; ++k) dst[m][k] = *(const LAS bf16x8*)(lds + PG8_SA(b, h) + aoff + m * 2048 + k * 1024); } while (0)
#define PG8_LDB(dst, b, h) do { _Pragma("unroll") for (int n = 0; n < 2; ++n) _Pragma("unroll") for (int k = 0; k < 2; ++k) dst[n][k] = *(const LAS bf16x8*)(lds + PG8_SB(b, h) + boff + n * 2048 + k * 1024); } while (0)
#define PG8_MMA(ai, bj, At, Bt) do { __builtin_amdgcn_s_setprio(1); _Pragma("unroll") for (int m = 0; m < 4; ++m) _Pragma("unroll") for (int n = 0; n < 2; ++n) _Pragma("unroll") for (int k = 0; k < 2; ++k) \
        acc[ai][bj][m][n] = __builtin_amdgcn_mfma_f32_16x16x32_bf16(Bt[n][k], At[m][k], acc[ai][bj][m][n], 0, 0, 0); __builtin_amdgcn_s_setprio(0); } while (0)
#define PG8_WAIT_V(n) asm volatile("s_waitcnt vmcnt(" #n ")" ::: "memory")
#define PG8_WAIT_L(n) asm volatile("s_waitcnt lgkmcnt(" #n ")" ::: "memory")
#define PG8_BAR __builtin_amdgcn_s_barrier()
#define PG8_SCHED __builtin_amdgcn_sched_barrier(0)
    Unit cur, nxt; int ui = 0;
    if (!next_unit(g, G, bx, vc, 0, cur)) return;
    Acc acc;
#pragma unroll
    for (int a = 0; a < 2; ++a)
#pragma unroll
        for (int b = 0; b < 2; ++b)
#pragma unroll
            for (int m = 0; m < 4; ++m)
#pragma unroll
                for (int n = 0; n < 2; ++n) acc[a][b][m][n] = (f32x4){0.f, 0.f, 0.f, 0.f};
    bf16x8 At[4][2], B0[2][2], B1[2][2];
    const char* cA = (const char*)g.A + (size_t)cur.arow * rowA; const char* cB = (const char*)g.Bt + (size_t)cur.brow * rowB;
    PG8_STAGE(PG8_SB(0, 0), cB, voffB); PG8_STAGE(PG8_SB(0, 1), cB + hstepB, voffB); PG8_STAGE(PG8_SA(0, 0), cA, voffA); PG8_STAGE(PG8_SA(0, 1), cA + hstepA, voffA);
    if (wr == 1) PG8_BAR;
    PG8_WAIT_V(2); PG8_BAR;
    PG8_STAGE(PG8_SB(1, 0), cB + kstep, voffB); PG8_STAGE(PG8_SA(1, 0), cA + kstep, voffA); PG8_STAGE(PG8_SB(1, 1), cB + hstepB + kstep, voffB);
    PG8_WAIT_V(6); PG8_BAR;
    for (;;) {
        const bool has_next = next_unit(g, G, bx, vc, ui + 1, nxt);
        const char* nA = has_next ? (const char*)g.A + (size_t)nxt.arow * rowA : cA; const char* nB = has_next ? (const char*)g.Bt + (size_t)nxt.brow * rowB : cB;
        for (int t = 0; t < nt; t += 2) {
            const bool last = (t == nt - 2);
            const char* a1 = cA + (size_t)(t + 1) * kstep;
            const char* a2 = last ? nA : cA + (size_t)(t + 2) * kstep; const char* b2 = last ? nB : cB + (size_t)(t + 2) * kstep;
            const char* a3 = a2 + kstep; const char* b3 = b2 + kstep;
            PG8_LDB(B0, 0, 0); PG8_LDB(B1, 0, 1); PG8_SCHED; PG8_LDA(At, 0, 0); PG8_STAGE(PG8_SA(1, 1), a1 + hstepA, voffA);
            PG8_WAIT_V(8); PG8_WAIT_L(0); PG8_BAR; PG8_MMA(0, 0, At, B0); PG8_MMA(0, 1, At, B1); PG8_BAR; PG8_SCHED;
            PG8_LDA(At, 0, 1); PG8_STAGE(PG8_SB(0, 0), b2, voffB); PG8_STAGE(PG8_SB(0, 1), b2 + hstepB, voffB); PG8_STAGE(PG8_SA(0, 0), a2, voffA);
            PG8_WAIT_V(8); PG8_WAIT_L(0); PG8_BAR; PG8_MMA(1, 0, At, B0); PG8_MMA(1, 1, At, B1); PG8_BAR; PG8_SCHED;
            PG8_LDB(B0, 1, 0); PG8_LDB(B1, 1, 1); PG8_SCHED; PG8_LDA(At, 1, 0); PG8_STAGE(PG8_SA(0, 1), a2 + hstepA, voffA);
            PG8_WAIT_V(8); PG8_WAIT_L(0); PG8_BAR; PG8_MMA(0, 0, At, B0); PG8_MMA(0, 1, At, B1); PG8_BAR; PG8_SCHED;
            PG8_LDA(At, 1, 1); PG8_STAGE(PG8_SB(1, 0), b3, voffB); PG8_STAGE(PG8_SB(1, 1), b3 + hstepB, voffB); PG8_STAGE(PG8_SA(1, 0), a3, voffA);
            PG8_WAIT_V(8); PG8_WAIT_L(0); PG8_BAR; PG8_MMA(1, 0, At, B0); PG8_MMA(1, 1, At, B1); PG8_BAR; PG8_SCHED;
        }
        if (wr == 0) PG8_BAR;
        epilogue(g, acc, cur);
        if (!has_next) break;
#pragma unroll
        for (int a = 0; a < 2; ++a)
#pragma unroll
            for (int b = 0; b < 2; ++b)
#pragma unroll
                for (int m = 0; m < 4; ++m)
#pragma unroll
                    for (int n = 0; n < 2; ++n) acc[a][b][m][n] = (f32x4){0.f, 0.f, 0.f, 0.f};
        cur = nxt; cA = nA; cB = nB; ++ui;
        if (wr == 1) PG8_BAR;
    }
    PG8_WAIT_V(0);
    PG8_BAR;
#undef PG8_SA
#undef PG8_SB
#undef PG8_STAGE
#undef PG8_LDA
#undef PG8_LDB
#undef PG8_MMA
#undef PG8_WAIT_V
#undef PG8_WAIT_L
#undef PG8_BAR
#undef PG8_SCHED
}
}

#define XB_TMO      128
#define XB_XCNT(j)  (256  + 64 * (j))
#define XB_XSUB(j)  (1280 + 64 * (j))
#define XB_XGEN(j)  (2304 + 64 * (j))
#define XB_TOP      3328
#define XB_TOPGEN   3392
#define XCD_BAR_WORDS 3456
#define XB_SPIN_CAP (1u << 22)
__device__ __forceinline__ unsigned xb_ld(unsigned* p)              { return __hip_atomic_load(p, __ATOMIC_RELAXED, __HIP_MEMORY_SCOPE_AGENT); }
__device__ __forceinline__ unsigned xb_add(unsigned* p, unsigned v) { return __hip_atomic_fetch_add(p, v, __ATOMIC_RELAXED, __HIP_MEMORY_SCOPE_AGENT); }
__device__ __forceinline__ unsigned xb_xcc_id() { return (unsigned)__builtin_amdgcn_s_getreg((3 << 11) | 20) & 0xFu; }
#define XB_SPIN(cond, bar) do { unsigned _sp = 0; while (cond) { __builtin_amdgcn_s_sleep(1); \
    if ((++_sp & 255u) == 0u) { if (xb_ld(&(bar)[XB_TMO])) break; if (_sp > XB_SPIN_CAP) { atomicAdd(&(bar)[XB_TMO], 1u); break; } } } } while (0)
struct XcdBarrier { unsigned* bar; unsigned x; volatile LAS unsigned* st; };
__device__ __forceinline__ XcdBarrier xcd_barrier_post(unsigned* bar, volatile LAS unsigned* st) {
    XcdBarrier b; b.bar = bar; b.x = xb_xcc_id(); b.st = st;
    if (threadIdx.x == 0) (void)xb_add(&bar[XB_XCNT(b.x)], 1u);
    return b;
}
__device__ __forceinline__ void xcd_barrier_complete(unsigned* bar, unsigned x, unsigned& nloc, unsigned& nx) {
    const unsigned G = gridDim.x * gridDim.y * gridDim.z;
    unsigned sum, cnt, mine, sp = 0u;
    for (;;) {
        sum = 0u; cnt = 0u; mine = 0u;
#pragma unroll
        for (unsigned j = 0; j < 16; ++j) { const unsigned c = xb_ld(&bar[XB_XCNT(j)]); sum += c; cnt += (c > 0u) ? 1u : 0u; mine = (j == x) ? c : mine; }
        if (sum == G) break;
        __builtin_amdgcn_s_sleep(1);
        if ((++sp & 255u) == 0u) { if (xb_ld(&bar[XB_TMO])) break; if (sp > XB_SPIN_CAP) { atomicAdd(&bar[XB_TMO], 1u); break; } }
    }
    nloc = mine > 0u ? mine : 1u; nx = cnt > 0u ? cnt : 1u;
}
__device__ __forceinline__ void xcd_barrier(const XcdBarrier& b) {
    asm volatile("s_waitcnt vmcnt(0)" ::: "memory");
    __syncthreads();
    if (threadIdx.x == 0) {
        unsigned* bar = b.bar;
        __builtin_amdgcn_s_waitcnt(0);
        unsigned nloc = b.st[0], nx = b.st[1];
        if (nloc == 0u) { xcd_barrier_complete(bar, b.x, nloc, nx); b.st[0] = nloc; b.st[1] = nx; }
        const unsigned old = xb_add(&bar[XB_XSUB(b.x)], 1u);
        const unsigned gen = old / nloc;
        if (old + 1u == (gen + 1u) * nloc) {
            __builtin_amdgcn_fence(__ATOMIC_RELEASE, "agent");
            asm volatile("s_waitcnt vmcnt(0)" ::: "memory");
            const unsigned og = xb_add(&bar[XB_TOP], 1u);
            const unsigned tg = og / nx;
            if (og + 1u == (tg + 1u) * nx) xb_add(&bar[XB_TOPGEN], 1u);
            else XB_SPIN(xb_ld(&bar[XB_TOPGEN]) == tg, bar);
            __builtin_amdgcn_fence(__ATOMIC_ACQUIRE, "agent");
            xb_add(&bar[XB_XGEN(b.x)], 1u);
            asm volatile("s_waitcnt vmcnt(0)" ::: "memory");
        } else {
            XB_SPIN(xb_ld(&bar[XB_XGEN(b.x)]) == gen, bar);
            __builtin_amdgcn_fence(__ATOMIC_ACQUIRE, "agent");
            asm volatile("s_waitcnt vmcnt(0)" ::: "memory");
        }
    }
    __syncthreads();
}

struct Params {
    const float* in[27];
    float* out;
    unsigned char* ws;
};

struct Ctx { LAS unsigned char* lds; int tid, lane, wid, G, bx, vc; };

__device__ __forceinline__ bool wdesc(int i, const Params& p, const float*& src, bf16_t*& dst, int& K, int& N, int& glu, const float*& gain) {
    unsigned char* ws = p.ws; glu = 0; gain = nullptr;
    if (i < 4) { gain = p.in[3] + i * DM; src = p.in[5] + (size_t)i * DM * FF; dst = (bf16_t*)(ws + (i < 2 ? WS_UP01 : WS_UP23)) + (size_t)(i & 1) * DM * FF; K = DM; N = FF; return true; }
    if (i < 8) { const int l = i - 4; src = p.in[6] + (size_t)l * DM * FF; dst = (bf16_t*)(ws + (l < 2 ? WS_DN01 : WS_DN23)) + (size_t)(l & 1) * DM * FF; K = FF; N = DM; return true; }
    if (i < 10) { const int l = i - 8; gain = p.in[1] + l * DM; src = p.in[7] + (size_t)l * DM * DM; dst = (bf16_t*)(ws + WS_WIN) + (size_t)l * DM * DM; K = DM; N = DM; return true; }
    if (i < 12) { const int l = i - 10; src = p.in[16] + (size_t)l * DM * 2 * DM; dst = (bf16_t*)(ws + WS_GLU) + (size_t)l * DM * 2 * DM; K = DM; N = 2 * DM; glu = 1; return true; }
    if (i < 13) { gain = p.in[17]; src = p.in[18]; dst = (bf16_t*)(ws + WS_KVW); K = DM; N = 2 * DM; return true; }
    if (i < 15) { const int l = i - 13; gain = p.in[1] + (2 + l) * DM; src = p.in[19] + (size_t)l * DM * DM; dst = (bf16_t*)(ws + WS_QW) + (size_t)l * DM * DM; K = DM; N = DM; return true; }
    if (i < 17) { const int l = i - 15; src = p.in[25] + (size_t)l * DM * DM; dst = (bf16_t*)(ws + WS_OW) + (size_t)l * DM * DM; K = DM; N = DM; return true; }
    return false;
}
__device__ __forceinline__ bool wlocate(int f, const Params& p, const float*& src, bf16_t*& dst, int& K, int& N, int& n0, int& k0, int& sc0, const float*& gain) {
    int base = 0;
    for (int i = 0; ; ++i) {
        int glu;
        if (!wdesc(i, p, src, dst, K, N, glu, gain)) return false;
        const int ntk = K >> 6, nt = ntk * (N >> 6);
        if (f < base + nt) { const int t = f - base; n0 = (t / ntk) << 6; k0 = (t % ntk) << 6;
            sc0 = glu ? (((n0 >> 7) & 1) * DM + (n0 >> 8) * 128 + (n0 & 127)) : n0; return true; }
        base += nt;
    }
}
constexpr int NCONV_TILES = 11264;
__device__ void convert_weights(const Ctx& c, const Params& p) {
    LAS float* T = (LAS float*)c.lds;
    int f, fstep, fend;
    if (c.G == 256) { if (c.bx < 128) { f = c.bx; fstep = 128; fend = 128 * 38; } else { f = 128 * 38 + (c.bx - 128); fstep = 128; fend = NCONV_TILES; } }
    else { f = c.bx; fstep = c.G; fend = NCONV_TILES; }
    const float* src; bf16_t* dst; int K, N, n0, k0, sc0; const float* gain;
    bool have = (f < fend) && wlocate(f, p, src, dst, K, N, n0, k0, sc0, gain);
    f32x4 v0, v1;
    const int ctid = opaque_tid(); const int kk = ctid >> 4, c4 = (ctid & 15) * 4;
    if (have) { v0 = *(const f32x4*)(src + (size_t)(k0 + kk) * N + sc0 + c4); v1 = *(const f32x4*)(src + (size_t)(k0 + 32 + kk) * N + sc0 + c4); if (gain) { v0 = v0 * gain[k0 + kk]; v1 = v1 * gain[k0 + 32 + kk]; } }
    int par = 0;
    while (have) {
        const f32x4 a0 = v0, a1 = v1; bf16_t* cdst = dst; const int cK = K, cn0 = n0, ck0 = k0;
        f += fstep;
        have = (f < fend) && wlocate(f, p, src, dst, K, N, n0, k0, sc0, gain);
        if (have) { v0 = *(const f32x4*)(src + (size_t)(k0 + kk) * N + sc0 + c4); v1 = *(const f32x4*)(src + (size_t)(k0 + 32 + kk) * N + sc0 + c4); if (gain) { v0 = v0 * gain[k0 + kk]; v1 = v1 * gain[k0 + 32 + kk]; } }
        LAS float* Tb = T + par * (64 * 65);
        Tb[(c4 + 0) * 65 + kk] = a0[0]; Tb[(c4 + 1) * 65 + kk] = a0[1]; Tb[(c4 + 2) * 65 + kk] = a0[2]; Tb[(c4 + 3) * 65 + kk] = a0[3];
        Tb[(c4 + 0) * 65 + 32 + kk] = a1[0]; Tb[(c4 + 1) * 65 + 32 + kk] = a1[1]; Tb[(c4 + 2) * 65 + 32 + kk] = a1[2]; Tb[(c4 + 3) * 65 + 32 + kk] = a1[3];
        __syncthreads();
        { const int nn = ctid >> 3, k8 = (ctid & 7) * 8; const LAS float* r = Tb + nn * 65 + k8;
          u32x4 w; w.x = cvt_pk_bf16(r[0], r[1]); w.y = cvt_pk_bf16(r[2], r[3]); w.z = cvt_pk_bf16(r[4], r[5]); w.w = cvt_pk_bf16(r[6], r[7]);
          *(u32x4*)(cdst + (size_t)(cn0 + nn) * cK + ck0 + k8) = w; }
        par ^= 1;
    }
    __syncthreads();
}

__device__ void ssm_tables(const Ctx& c, const Params& p, int layer, int g) {
    LAS float* lamp = (LAS float*)c.lds;
    LAS float* bbar = lamp + 33 * 64 * 2;
    LAS float* ccp = bbar + 64 * 16 * 2;
    LAS float* Kt = ccp + 16 * 64 * 2;
    LAS float* coef = Kt + 32 * 256;
    const int tid = opaque_tid();
    const size_t lg = (size_t)layer * NG + g;
    if (tid < 64) {
        const int pp = tid;
        const float dt = expf(p.in[10][lg]);
        const float lr = p.in[8][lg * NP + pp], li = p.in[9][lg * NP + pp];
        const float mag = expf(lr * dt), ar = mag * cosf(li * dt), ai = mag * sinf(li * dt);
        const float den = lr * lr + li * li;
        coef[pp * 2] = ((ar - 1.0f) * lr + ai * li) / den; coef[pp * 2 + 1] = (ai * lr - (ar - 1.0f) * li) / den;
        float pr = 1.0f, pi = 0.0f; asm volatile("" : "+v"(pr), "+v"(pi));
        for (int k = 0; k <= 32; ++k) { lamp[(k * 64 + pp) * 2] = pr; lamp[(k * 64 + pp) * 2 + 1] = pi; const float nr = pr * ar - pi * ai, ni = pr * ai + pi * ar; pr = nr; pi = ni; }
        float* lamL = (float*)(p.ws + WS_LAML) + (lg * NP + pp) * 2;
        lamL[0] = lamp[(32 * 64 + pp) * 2]; lamL[1] = lamp[(32 * 64 + pp) * 2 + 1];
    }
    __syncthreads();
    for (int e = tid; e < 1024; e += 512) {
        const int pp = e >> 4, cc = e & 15;
        const float br = p.in[11][lg * 1024 + e], bi = p.in[12][lg * 1024 + e], cr = coef[pp * 2], ci = coef[pp * 2 + 1];
        bbar[e * 2] = cr * br - ci * bi; bbar[e * 2 + 1] = cr * bi + ci * br;
        ccp[e * 2] = p.in[13][lg * 1024 + e]; ccp[e * 2 + 1] = p.in[14][lg * 1024 + e];
        (void)cc;
    }
    __syncthreads();
    {
        const int k = tid >> 4, co = tid & 15;
        float acc16[16];
#pragma unroll
        for (int q = 0; q < 16; ++q) acc16[q] = 0.f;
        for (int pp = 0; pp < 64; ++pp) {
            const float lr = lamp[(k * 64 + pp) * 2], li = lamp[(k * 64 + pp) * 2 + 1], cr = ccp[(co * 64 + pp) * 2], ci = ccp[(co * 64 + pp) * 2 + 1];
            const float wr = cr * lr - ci * li, wi = cr * li + ci * lr;
            const LAS f32x4* bb = (const LAS f32x4*)(bbar + pp * 32);
#pragma unroll
            for (int q = 0; q < 8; ++q) { const f32x4 b = bb[q]; acc16[2 * q] += wr * b[0] - wi * b[1]; acc16[2 * q + 1] += wr * b[2] - wi * b[3]; }
        }
#pragma unroll
        for (int q = 0; q < 16; ++q) Kt[(k * 16 + co) * 16 + q] = acc16[q];
    }
    __syncthreads();
    bf16_t* Tm = (bf16_t*)(p.ws + WS_TM) + (size_t)layer * NG * 512 * UGP + (size_t)g * 512 * UGP;
    for (int e = tid; e < 512 * 80; e += 512) {
        const int row = e / 80, ch = e % 80, j = row >> 4, co = row & 15;
        float v[8];
        if (ch < 64) { const int i = ch >> 1, ci0 = (ch & 1) * 8;
#pragma unroll
            for (int q = 0; q < 8; ++q) v[q] = (i <= j) ? Kt[((j - i) * 16 + co) * 16 + ci0 + q] : 0.f;
        } else { const int p0 = (ch - 64) * 8;
#pragma unroll
            for (int q = 0; q < 8; ++q) { const int pq = p0 + q, pp = pq & 63;
                const float lr = lamp[((j + 1) * 64 + pp) * 2], li = lamp[((j + 1) * 64 + pp) * 2 + 1], cr = ccp[(co * 64 + pp) * 2], ci = ccp[(co * 64 + pp) * 2 + 1];
                v[q] = pq < 64 ? (cr * lr - ci * li) : -(cr * li + ci * lr); }
        }
        u32x4 w; w.x = cvt_pk_bf16(v[0], v[1]); w.y = cvt_pk_bf16(v[2], v[3]); w.z = cvt_pk_bf16(v[4], v[5]); w.w = cvt_pk_bf16(v[6], v[7]);
        *(u32x4*)(Tm + (size_t)row * UGP + ch * 8) = w;
    }
    bf16_t* Sin = (bf16_t*)(p.ws + WS_SIN) + (size_t)layer * NG * 128 * 512 + (size_t)g * 128 * 512;
    for (int e = tid; e < 128 * 64; e += 512) {
        const int row = e >> 6, ch = e & 63, pp = row & 63, i = ch >> 1, ci0 = (ch & 1) * 8;
        const float lr = lamp[((31 - i) * 64 + pp) * 2], li = lamp[((31 - i) * 64 + pp) * 2 + 1];
        float v[8];
#pragma unroll
        for (int q = 0; q < 8; ++q) { const float br = bbar[(pp * 16 + ci0 + q) * 2], bi = bbar[(pp * 16 + ci0 + q) * 2 + 1]; v[q] = row < 64 ? (lr * br - li * bi) : (lr * bi + li * br); }
        u32x4 w; w.x = cvt_pk_bf16(v[0], v[1]); w.y = cvt_pk_bf16(v[2], v[3]); w.z = cvt_pk_bf16(v[4], v[5]); w.w = cvt_pk_bf16(v[6], v[7]);
        *(u32x4*)(Sin + (size_t)row * 512 + ch * 8) = w;
    }
    __syncthreads();
}

__device__ void small_tables(const Ctx& c, const Params& p) {
    float* bt = (float*)(p.ws + WS_BIAS);
    const int stid = opaque_tid();
    for (int e = stid; e < 8 * 128; e += 512) {
        const int h = e >> 7, n = e & 127;
        int bk = n;
        if (n >= 16) { const int th[16] = {16, 19, 21, 24, 27, 31, 35, 40, 46, 52, 59, 67, 77, 87, 99, 113}; bk = 15;
#pragma unroll
            for (int q = 0; q < 16; ++q) bk += (n >= th[q]) ? 1 : 0; }
        bt[e] = (p.in[26][bk * 8 + h] - p.in[26][31 * 8 + h]) * LOG2E;
    }
    if (stid < 2) {
        const int j = stid; float s1 = 0.f, s2 = 0.f;
        for (int q = 0; q < 64; ++q) { s1 += p.in[20][j * 64 + q] * p.in[21][j * 64 + q]; s2 += p.in[22][j * 64 + q] * p.in[23][j * 64 + q]; }
        const float li = 0.8f - 0.6f * expf(-0.3f * (float)(j + 2));
        float* sc = (float*)(p.ws + WS_SCAL) + j * 4;
        sc[0] = expf(s1) - expf(s2) + li; sc[1] = 1.0f - li; sc[2] = 0.f; sc[3] = 0.f;
    }
}

__device__ void norm_phase(const Ctx& c, const void* xin_, int xin_f32, void* xout_, int xout_f32, const bf16_t* mix, const float* gpost, float* rsout) {
    const float* xin = (const float*)xin_; const bf16_t* xin16 = (const bf16_t*)xin_; float* xout = (float*)xout_; bf16_t* xout16 = (bf16_t*)xout_;
    const int tid_ = opaque_tid(), lane = tid_ & 63, wid_ = __builtin_amdgcn_readfirstlane(tid_ >> 6);
    for (int r0 = (wid_ * c.G + c.bx) * 4; r0 < TOK; r0 += 8 * c.G * 4) {
        f32x4 xv[4][4]; u32x4 xw[4][2]; u32x4 mw[4][2];
        if (xin_f32) {
#pragma unroll
            for (int rr = 0; rr < 4; ++rr)
#pragma unroll
                for (int k = 0; k < 2; ++k) { const float* xp = xin + (size_t)(r0 + rr) * DM + k * 512 + lane * 8; xv[rr][2 * k] = *(const f32x4*)xp; xv[rr][2 * k + 1] = *(const f32x4*)(xp + 4); }
        } else {
#pragma unroll
            for (int rr = 0; rr < 4; ++rr)
#pragma unroll
                for (int k = 0; k < 2; ++k) xw[rr][k] = *(const u32x4*)(xin16 + (size_t)(r0 + rr) * DM + k * 512 + lane * 8);
        }
        if (mix) {
#pragma unroll
            for (int rr = 0; rr < 4; ++rr)
#pragma unroll
                for (int k = 0; k < 2; ++k) mw[rr][k] = *(const u32x4*)(mix + (size_t)(r0 + rr) * DM + k * 512 + lane * 8);
        }
#pragma unroll
        for (int rr = 0; rr < 4; ++rr) {
            const int row = r0 + rr;
            float x[16];
            if (xin_f32) {
#pragma unroll
                for (int q = 0; q < 4; ++q)
#pragma unroll
                    for (int e = 0; e < 4; ++e) x[q * 4 + e] = xv[rr][q][e];
            } else {
#pragma unroll
                for (int k = 0; k < 2; ++k) { const u32x4 w = xw[rr][k];
                    x[k * 8 + 0] = bf_lo(w.x); x[k * 8 + 1] = bf_hi(w.x); x[k * 8 + 2] = bf_lo(w.y); x[k * 8 + 3] = bf_hi(w.y); x[k * 8 + 4] = bf_lo(w.z); x[k * 8 + 5] = bf_hi(w.z); x[k * 8 + 6] = bf_lo(w.w); x[k * 8 + 7] = bf_hi(w.w); }
            }
            if (mix) {
                float mv[16]; float ss = 0.f;
#pragma unroll
                for (int k = 0; k < 2; ++k) { const u32x4 w = mw[rr][k];
                    mv[k * 8 + 0] = bf_lo(w.x); mv[k * 8 + 1] = bf_hi(w.x); mv[k * 8 + 2] = bf_lo(w.y); mv[k * 8 + 3] = bf_hi(w.y); mv[k * 8 + 4] = bf_lo(w.z); mv[k * 8 + 5] = bf_hi(w.z); mv[k * 8 + 6] = bf_lo(w.w); mv[k * 8 + 7] = bf_hi(w.w); }
#pragma unroll
                for (int e = 0; e < 16; ++e) ss += mv[e] * mv[e];
                ss = wave_sum(ss);
                const float rs = rsqrtf(ss * (1.0f / DM) + EPS);
#pragma unroll
                for (int k = 0; k < 2; ++k) { const float* gp = gpost + k * 512 + lane * 8; const f32x4 ga = *(const f32x4*)gp, gb = *(const f32x4*)(gp + 4);
#pragma unroll
                    for (int e = 0; e < 4; ++e) { x[k * 8 + e] += mv[k * 8 + e] * rs * ga[e]; x[k * 8 + 4 + e] += mv[k * 8 + 4 + e] * rs * gb[e]; } }
            }
#pragma unroll
            for (int k = 0; k < 2; ++k) {
                if (xout_f32) { float* xo = xout + (size_t)row * DM + k * 512 + lane * 8;
                    *(f32x4*)xo = (f32x4){x[k * 8 + 0], x[k * 8 + 1], x[k * 8 + 2], x[k * 8 + 3]}; *(f32x4*)(xo + 4) = (f32x4){x[k * 8 + 4], x[k * 8 + 5], x[k * 8 + 6], x[k * 8 + 7]}; }
                else { u32x4 wx; wx.x = cvt_pk_bf16(x[k * 8 + 0], x[k * 8 + 1]); wx.y = cvt_pk_bf16(x[k * 8 + 2], x[k * 8 + 3]); wx.z = cvt_pk_bf16(x[k * 8 + 4], x[k * 8 + 5]); wx.w = cvt_pk_bf16(x[k * 8 + 6], x[k * 8 + 7]);
                    *(u32x4*)(xout16 + (size_t)row * DM + k * 512 + lane * 8) = wx;
                    x[k * 8 + 0] = bf_lo(wx.x); x[k * 8 + 1] = bf_hi(wx.x); x[k * 8 + 2] = bf_lo(wx.y); x[k * 8 + 3] = bf_hi(wx.y); x[k * 8 + 4] = bf_lo(wx.z); x[k * 8 + 5] = bf_hi(wx.z); x[k * 8 + 6] = bf_lo(wx.w); x[k * 8 + 7] = bf_hi(wx.w); }
            }
            if (rsout) {
                float ss = 0.f;
#pragma unroll
                for (int e = 0; e < 16; ++e) ss += x[e] * x[e];
                ss = wave_sum(ss);
                if (lane == 0) rsout[row] = rsqrtf(ss * (1.0f / DM) + EPS);
            }
        }
    }
}

__device__ void scan_phase(const Ctx& c, const Params& p, int layer) {
    const float* Z = (const float*)(p.ws + WS_Z); bf16_t* Ug = (bf16_t*)(p.ws + WS_UG);
    const float* lamL = (const float*)(p.ws + WS_LAML) + (size_t)layer * NG * NP * 2;
    const int tid_ = opaque_tid(), wid_ = __builtin_amdgcn_readfirstlane(tid_ >> 6);
    for (int pr = wid_ * c.G + c.bx; pr < 4 * NG; pr += 8 * c.G) {
        const int b = pr >> 6, g = pr & 63, pp = tid_ & 63;
        const float lr = lamL[(g * NP + pp) * 2], li = lamL[(g * NP + pp) * 2 + 1];
        float sr = 0.f, si = 0.f;
        const size_t row0 = (size_t)g * NCH + b * 256;
#pragma unroll 8
        for (int ch = 0; ch < 256; ++ch) {
            const float zr = Z[(row0 + ch) * 128 + pp], zi = Z[(row0 + ch) * 128 + 64 + pp];
            bf16_t* o = Ug + (row0 + ch) * UGP + 512 + pp;
            const unsigned w = cvt_pk_bf16(sr, si);
            o[0] = (bf16_t)(w & 0xffffu); o[64] = (bf16_t)(w >> 16);
            const float nr = lr * sr - li * si + zr, ni = lr * si + li * sr + zi; sr = nr; si = ni;
        }
    }
}

__device__ void scan_after_z(const Ctx& c, const Params& p, int layer) {
    asm volatile("s_waitcnt vmcnt(0)" ::: "memory"); __syncthreads();
    __builtin_amdgcn_fence(__ATOMIC_ACQUIRE, "agent");
    asm volatile("s_waitcnt vmcnt(0)" ::: "memory");
    const float* Z = (const float*)(p.ws + WS_Z); bf16_t* Ug = (bf16_t*)(p.ws + WS_UG);
    const float* lamL = (const float*)(p.ws + WS_LAML) + (size_t)layer * NG * NP * 2;
    const int tid_ = opaque_tid(), wid_ = __builtin_amdgcn_readfirstlane(tid_ >> 6), pp = tid_ & 63;
    for (int i = wid_; ; i += 8) {
        const int L = i * c.G + c.vc; if (L >= 4 * NG) break;
        const int g = L >> 2, b = L & 3;
        const float lr = lamL[(g * NP + pp) * 2], li = lamL[(g * NP + pp) * 2 + 1];
        float sr = 0.f, si = 0.f;
        const size_t row0 = (size_t)g * NCH + b * 256;
#pragma unroll 8
        for (int ch = 0; ch < 256; ++ch) {
            const float zr = Z[(row0 + ch) * 128 + pp], zi = Z[(row0 + ch) * 128 + 64 + pp];
            bf16_t* o = Ug + (row0 + ch) * UGP + 512 + pp;
            const unsigned w = cvt_pk_bf16(sr, si);
            o[0] = (bf16_t)(w & 0xffffu); o[64] = (bf16_t)(w >> 16);
            const float nr = lr * sr - li * si + zr, ni = lr * si + li * sr + zi; sr = nr; si = ni;
        }
    }
}

#define ATTN_DMA(gp, ldsoff) __builtin_amdgcn_global_load_lds((const unsigned*)(gp), (LAS unsigned*)(lds + (ldsoff)), 16, 0, 0)
#define ATTN_PV(PB, VBASE) do { \
    bf16x8 fa__[8], fb__[8]; \
    _Pragma("unroll") for (int q_ = 0; q_ < 8; ++q_) fa__[q_] = *(LAS const bf16x8*)((VBASE) + (q_ >> 2) * 4096 + vo[q_ & 3]); \
    __builtin_amdgcn_sched_barrier(0); \
    _Pragma("unroll") for (int q_ = 0; q_ < 8; ++q_) fb__[q_] = *(LAS const bf16x8*)((VBASE) + (2 + (q_ >> 2)) * 4096 + vo[q_ & 3]); \
    _Pragma("unroll") for (int q_ = 0; q_ < 8; ++q_) o[q_ & 1] = __builtin_amdgcn_mfma_f32_32x32x16_bf16(fa__[(q_ & 1) * 4 + (q_ >> 1)], PB[q_ >> 1], o[q_ & 1], 0, 0, 0); \
    __builtin_amdgcn_sched_barrier(0); \
    _Pragma("unroll") for (int q_ = 0; q_ < 8; ++q_) o[2 + (q_ & 1)] = __builtin_amdgcn_mfma_f32_32x32x16_bf16(fb__[(q_ & 1) * 4 + (q_ >> 1)], PB[q_ >> 1], o[2 + (q_ & 1)], 0, 0, 0); \
    __builtin_amdgcn_sched_barrier(0); } while (0)
#define ATTN_QK(P0, P1, KB) do { \
    bf16x8 kf_[4]; \
    _Pragma("unroll") for (int d0 = 0; d0 < 4; ++d0) kf_[d0] = *(LAS const bf16x8*)((KB) + ko[d0]); \
    __builtin_amdgcn_sched_barrier(0); \
    P0 = __builtin_amdgcn_mfma_f32_32x32x16_bf16(kf_[0], qf[0], negm, 0, 0, 0); \
    _Pragma("unroll") for (int d0 = 1; d0 < 4; ++d0) P0 = __builtin_amdgcn_mfma_f32_32x32x16_bf16(kf_[d0], qf[d0], P0, 0, 0, 0); \
    __builtin_amdgcn_sched_barrier(0); \
    _Pragma("unroll") for (int d0 = 0; d0 < 4; ++d0) kf_[d0] = *(LAS const bf16x8*)((KB) + 8192 + ko[d0]); \
    __builtin_amdgcn_sched_barrier(0); \
    P1 = __builtin_amdgcn_mfma_f32_32x32x16_bf16(kf_[0], qf[0], negm, 0, 0, 0); \
    _Pragma("unroll") for (int d0 = 1; d0 < 4; ++d0) P1 = __builtin_amdgcn_mfma_f32_32x32x16_bf16(kf_[d0], qf[d0], P1, 0, 0, 0); \
    __builtin_amdgcn_sched_barrier(0); } while (0)
#define ATTN_BAND(P0, P1, DD) do { \
    __builtin_amdgcn_sched_barrier(0); \
    _Pragma("unroll") for (int r = 0; r < 16; ++r) { const int d0_ = (DD) - (16 * (r >> 3) + (r & 7)); P0[r] += btab[1 + min(max(d0_, -1), 127)]; } \
    __builtin_amdgcn_sched_barrier(0); \
    _Pragma("unroll") for (int r = 0; r < 16; ++r) { const int d1_ = (DD) - 32 - (16 * (r >> 3) + (r & 7)); P1[r] += btab[1 + min(max(d1_, -1), 127)]; } \
    __builtin_amdgcn_sched_barrier(0); } while (0)
#define ATTN_EXP(P0, P1, PB) do { \
    float ls0_ = 0.f, ls1_ = 0.f; \
    _Pragma("unroll") for (int r = 0; r < 16; ++r) { P0[r] = fexp2(P0[r]); P1[r] = fexp2(P1[r]); ls0_ += P0[r]; ls1_ += P1[r]; } \
    lrun += ls0_ + ls1_; \
    _Pragma("unroll") for (int q = 0; q < 2; ++q) { u32x4 w0_, w1_; \
        w0_.x = cvt_pk_bf16(P0[q * 8 + 0], P0[q * 8 + 1]); w0_.y = cvt_pk_bf16(P0[q * 8 + 2], P0[q * 8 + 3]); w0_.z = cvt_pk_bf16(P0[q * 8 + 4], P0[q * 8 + 5]); w0_.w = cvt_pk_bf16(P0[q * 8 + 6], P0[q * 8 + 7]); \
        w1_.x = cvt_pk_bf16(P1[q * 8 + 0], P1[q * 8 + 1]); w1_.y = cvt_pk_bf16(P1[q * 8 + 2], P1[q * 8 + 3]); w1_.z = cvt_pk_bf16(P1[q * 8 + 4], P1[q * 8 + 5]); w1_.w = cvt_pk_bf16(P1[q * 8 + 6], P1[q * 8 + 7]); \
        PB[q] = __builtin_bit_cast(bf16x8, w0_); PB[2 + q] = __builtin_bit_cast(bf16x8, w1_); } } while (0)
__device__ void attn_phase(const Ctx& c, const bf16_t* Q, const bf16_t* Kg, const bf16_t* Vt, bf16_t* ON, const float* biasT, const float* scal, const float* hn) {
    constexpr int SUB = 16384, STAGE = 32768, V_OFF = 65536, BT_OFF = 131072 + 128;
    LAS unsigned char* lds = c.lds;
    LAS unsigned char* ldsr = lds; asm volatile("" : "+s"(ldsr) :: "memory");
    for (int itu = 0; ; ++itu) {
        const int L = itu * c.G + c.vc; if (L >= 2048) break;
        const int tid = opaque_tid(), lane = tid & 63, wid = __builtin_amdgcn_readfirstlane(tid >> 6), br = wid >> 2, wq = wid & 3, l31 = lane & 31, hi = lane >> 5;
        const int prow = (l31 & ~12) | ((l31 & 4) << 1) | ((l31 & 8) >> 1);
        const int kbase = prow * 256, kx0 = (br * 8 + hi) ^ (prow & 15);
        const int vbase = V_OFF + l31 * 128, vx0 = hi ^ ((l31 >> 1) & 7);
        int ko[4], vo[4];
#pragma unroll
        for (int q = 0; q < 4; ++q) { ko[q] = (kx0 ^ (q << 1)) << 4; vo[q] = (vx0 ^ (q << 1)) << 4; }
        const int kr0 = 4 * wid + (lane >> 4), kc = (lane & 15) ^ (kr0 & 15);
        const int vr0 = 8 * wid + (lane >> 3), vcx = (lane & 7) ^ ((vr0 >> 1) & 7);
        const int dst0 = wid * 1024, dst1 = (wid + 8) * 1024;
        LAS const float* btab = (LAS const float*)(lds + BT_OFF);
        const int i7 = 7 - (L >> 8), pair = (L & 255) >> 3, jj8 = L & 7;
        const int qb = (i7 & 1) ? (16 * (i7 >> 1) + 15 - jj8) : (16 * (i7 >> 1) + jj8);
        const int b = pair >> 3, h = pair & 7, q0 = qb * 128, NI = qb + 1;
        const size_t tokb = (size_t)b * SEQ;
        const bf16_t* kg = Kg + (tokb + kr0) * DM + h * 128 + kc * 8;
        const bf16_t* vg = Vt + ((size_t)((b * 8 + h) * 128) << 13) + vr0 * 64 + vcx * 8;
        const bf16_t* qp = Q + (tokb + q0 + wq * 32 + l31) * DM + h * 128 + br * 64 + hi * 8;
        bf16x8 qf[4];
#pragma unroll
        for (int d0 = 0; d0 < 4; ++d0) qf[d0] = *(const bf16x8*)(qp + d0 * 16);
        if (tid < 128) ((LAS float*)(lds + BT_OFF))[1 + tid] = biasT[h * 128 + tid];
        if (tid == 128) ((LAS float*)(lds + BT_OFF))[0] = -1e30f;
#pragma unroll
        for (int sb = 0; sb < 2; ++sb) {
            ATTN_DMA(kg + (size_t)sb * 64 * DM, sb * SUB + dst0); ATTN_DMA(kg + (size_t)(sb * 64 + 32) * DM, sb * SUB + dst1);
            ATTN_DMA(vg + (size_t)sb * 8192, V_OFF + sb * SUB + dst0); ATTN_DMA(vg + (size_t)sb * 8192 + 4096, V_OFF + sb * SUB + dst1);
        }
        f32x16 o[4], negm;
#pragma unroll
        for (int r = 0; r < 16; ++r) { o[0][r] = 0.f; o[1][r] = 0.f; o[2][r] = 0.f; o[3][r] = 0.f; negm[r] = 0.f; }
        float lrun = 0.f;
        const int qrow = q0 + wq * 32 + l31;
        for (int it = 0; it < NI; ++it) {
            const int st = it & 1, kt0 = it * 128;
            asm volatile("s_waitcnt vmcnt(0) lgkmcnt(0)\n\ts_barrier" ::: "memory");
            if (it + 1 < NI) { const int s2 = (st ^ 1) * STAGE;
#pragma unroll
                for (int sb = 0; sb < 2; ++sb) { const bf16_t* kn = kg + (size_t)(kt0 + 128 + sb * 64) * DM; const bf16_t* vn = vg + (size_t)((it + 1) * 2 + sb) * 8192;
                    ATTN_DMA(kn, s2 + sb * SUB + dst0); ATTN_DMA(kn + 32 * DM, s2 + sb * SUB + dst1);
                    ATTN_DMA(vn, V_OFF + s2 + sb * SUB + dst0); ATTN_DMA(vn + 4096, V_OFF + s2 + sb * SUB + dst1); } }
            LAS const unsigned char* kbp = ldsr + st * STAGE + kbase;
            LAS const unsigned char* vbp = ldsr + st * STAGE + vbase;
#pragma unroll
            for (int sb = 0; sb < 2; ++sb) {
                f32x16 pa0, pa1;
                ATTN_QK(pa0, pa1, kbp + sb * SUB);
                if (it >= NI - 2) { const int dd = qrow - kt0 - sb * 64 - 8 * hi; ATTN_BAND(pa0, pa1, dd); }
                float mxa = max3f(pa0[0], pa0[1], pa1[0]), mxb = max3f(pa0[2], pa0[3], pa1[1]); mxa = max3f(mxa, pa1[2], pa1[3]);
#pragma unroll
                for (int r = 4; r < 16; r += 4) { mxa = max3f(mxa, pa0[r], pa0[r + 1]); mxb = max3f(mxb, pa0[r + 2], pa0[r + 3]); mxa = max3f(mxa, pa1[r], pa1[r + 1]); mxb = max3f(mxb, pa1[r + 2], pa1[r + 3]); }
                float mx = max2f(mxa, mxb);
                { const auto rr_ = __builtin_amdgcn_permlane32_swap(__float_as_uint(mx), __float_as_uint(mx), false, false); mx = max2f(__uint_as_float(rr_[0]), __uint_as_float(rr_[1])); }
                if ((it == 0 && sb == 0) || __any(mx > 8.0f)) {
                    const float delta = (it == 0 && sb == 0) ? mx : fmaxf(mx, 0.f), alpha = fexp2(-delta); lrun *= alpha;
#pragma unroll
                    for (int r = 0; r < 16; ++r) { pa0[r] -= delta; pa1[r] -= delta; negm[r] -= delta; }
#pragma unroll
                    for (int q = 0; q < 4; ++q) o[q] = o[q] * alpha;
                }
                bf16x8 pk[4];
                ATTN_EXP(pa0, pa1, pk);
                ATTN_PV(pk, vbp + sb * SUB);
            }
        }
        __syncthreads();
        const int te = opaque_tid(), le31 = te & 31, hie = (te & 63) >> 5, wide = __builtin_amdgcn_readfirstlane(te >> 6), wqe = wide & 3;
        const float lam = scal[0], onem = scal[1];
        float inv = frcp(lrun + __shfl_xor(lrun, 32));
        if (wide >= 4) inv *= lam;
        LAS float* comb = (LAS float*)lds;
        if (wide >= 4) {
#pragma unroll
            for (int blk = 0; blk < 4; ++blk)
#pragma unroll
                for (int r = 0; r < 16; ++r) comb[(wqe * 128 + blk * 32 + (r & 3) + 8 * (r >> 2) + 4 * hie) * 32 + le31] = o[blk][r] * inv;
        }
        __syncthreads();
        if (wide < 4) {
            float ss = 0.f;
#pragma unroll
            for (int blk = 0; blk < 4; ++blk)
#pragma unroll
                for (int r = 0; r < 16; ++r) { const float v = o[blk][r] * inv - comb[(wqe * 128 + blk * 32 + (r & 3) + 8 * (r >> 2) + 4 * hie) * 32 + le31]; o[blk][r] = v; ss += v * v; }
            ss += __shfl_xor(ss, 32);
            const float rs = rsqrtf(ss * (1.0f / 128.0f) + EPS) * onem;
            bf16_t* op = ON + ((size_t)b * SEQ + q0 + wqe * 32 + le31) * DM + h * 128;
#pragma unroll
            for (int blk = 0; blk < 4; ++blk)
#pragma unroll
                for (int r4 = 0; r4 < 4; ++r4) { const int dv = blk * 32 + 8 * r4 + 4 * hie; const f32x4 g4 = *(const f32x4*)(hn + dv);
                    u32x2 w; w.x = cvt_pk_bf16(o[blk][r4 * 4 + 0] * rs * g4[0], o[blk][r4 * 4 + 1] * rs * g4[1]); w.y = cvt_pk_bf16(o[blk][r4 * 4 + 2] * rs * g4[2], o[blk][r4 * 4 + 3] * rs * g4[3]);
                    *(u32x2*)(op + dv) = w; }
        }
        __syncthreads();
    }
}
#undef ATTN_PV
#undef ATTN_QK
#undef ATTN_BAND
#undef ATTN_EXP
#undef ATTN_DMA

__global__ void __launch_bounds__(512, 2) yoco_fwd(Params p) {
    extern __shared__ __attribute__((aligned(16))) unsigned char lds_raw[];
    cg::grid_group grid = cg::this_grid();
    Ctx c; c.lds = (LAS unsigned char*)lds_raw; c.tid = threadIdx.x; c.lane = c.tid & 63; c.wid = __builtin_amdgcn_readfirstlane(c.tid >> 6);
    c.G = gridDim.x; c.bx = blockIdx.x; c.vc = (c.G % 8 == 0) ? (c.bx % 8) * (c.G / 8) + c.bx / 8 : c.bx;
    unsigned char* ws = p.ws;
    float* X = p.out;
    { volatile LAS unsigned* xst0 = (volatile LAS unsigned*)(c.lds + 131072); if (c.tid < 4) xst0[c.tid] = 0u; }
    __syncthreads();
    (void)xcd_barrier_post((unsigned*)(ws + WS_BAR), (volatile LAS unsigned*)(c.lds + 131072));
    bf16_t* HM = (bf16_t*)(ws + WS_HM); bf16_t* ACT = (bf16_t*)(ws + WS_ACT);
    bf16_t* UG = (bf16_t*)(ws + WS_UG); float* Zb = (float*)(ws + WS_Z); bf16_t* YG = (bf16_t*)(ws + WS_YG);
    bf16_t* Qb = (bf16_t*)(ws + WS_Q); bf16_t* ONb = (bf16_t*)(ws + WS_ON); bf16_t* HKV = (bf16_t*)(ws + WS_HKV);
    bf16_t* Kb = (bf16_t*)(ws + WS_K); bf16_t* Vtb = (bf16_t*)(ws + WS_VT);

    enum { K_PRO = 0, K_WIN = 1, K_Z = 2, K_SCAN = 3, K_Y = 4, K_GLU = 5, K_NORMA = 6, K_UP = 7, K_DOWN = 8, K_NORMB = 9, K_K = 10, K_VT = 11, K_Q = 12, K_ATTN = 13, K_O = 14 };
    for (int ph = 0; ph < 35; ++ph) {
        int kind, layer;
        if (ph == 0) { kind = K_PRO; layer = 0; }
        else if (ph < 19) { layer = (ph - 1) / 9; kind = 1 + (ph - 1) % 9; }
        else { int k; if (ph < 28) { layer = 2; k = ph - 19; } else { layer = 3; k = ph - 26; }
            kind = k < 3 ? K_K + k : (k == 3 ? K_ATTN : (k == 4 ? K_O : K_NORMA + (k - 5))); }
        const int j = layer & 1;
        if (kind == K_SCAN) continue;
        for (int rep = 0; rep < (((REPEAT_MASK >> kind) & 1) ? 2 : 1); ++rep) {
        { int t_ = threadIdx.x; asm volatile("" : "+v"(t_)); c.tid = t_; c.lane = t_ & 63; c.wid = __builtin_amdgcn_readfirstlane(t_ >> 6); }
        const bool is_gemm = (kind == K_WIN) | (kind == K_Z) | (kind == K_Y) | (kind == K_GLU) | (kind == K_UP) | (kind == K_DOWN) | (kind == K_K) | (kind == K_VT) | (kind == K_Q) | (kind == K_O);
        if (is_gemm) {
            pg8::Job jb; jb.lda = DM; jb.ldb = DM; jb.K = DM; jb.ord = pg8::ORD_STATIC; jb.M = TOK; jb.N = DM; jb.epi = pg8::EPI_STORE; jb.ldc = DM; jb.scale = 1.0f; jb.O = HM; jb.x1 = nullptr; jb.x2 = nullptr; jb.A = HM; jb.Bt = nullptr;
            const bf16_t* X16 = (const bf16_t*)X; const float* RS = (const float*)(ws + WS_RS);
            switch (kind) {
            case K_WIN: jb.A = X16; jb.x2 = RS; jb.Bt = (const bf16_t*)(ws + WS_WIN) + (size_t)j * DM * DM; jb.epi = pg8::EPI_UG; jb.O = UG; break;
            case K_Z: jb.A = UG; jb.Bt = (const bf16_t*)(ws + WS_SIN) + (size_t)j * NG * 128 * 512; jb.lda = UGP; jb.ldb = 512; jb.K = 512; jb.ord = pg8::ORD_Z; jb.epi = pg8::EPI_Z; jb.O = Zb; break;
            case K_Y: jb.A = UG; jb.Bt = (const bf16_t*)(ws + WS_TM) + (size_t)j * NG * 512 * UGP; jb.lda = UGP; jb.ldb = UGP; jb.K = UGP; jb.ord = pg8::ORD_Y; jb.epi = pg8::EPI_Y; jb.O = YG; jb.x1 = UG; jb.x2 = p.in[15] + (size_t)j * DM; break;
            case K_GLU: jb.A = YG; jb.Bt = (const bf16_t*)(ws + WS_GLU) + (size_t)j * DM * 2 * DM; jb.N = 2 * DM; jb.epi = pg8::EPI_GLU; break;
            case K_UP: jb.A = layer == 3 ? (const bf16_t*)Kb : X16; jb.x2 = RS; jb.Bt = (const bf16_t*)(ws + (layer < 2 ? WS_UP01 : WS_UP23)) + (size_t)j * DM * FF; jb.N = FF; jb.epi = pg8::EPI_RELU2; jb.O = ACT; jb.ldc = FF; break;
            case K_DOWN: jb.A = ACT; jb.Bt = (const bf16_t*)(ws + (layer < 2 ? WS_DN01 : WS_DN23)) + (size_t)j * DM * FF; jb.lda = FF; jb.ldb = FF; jb.K = FF; break;
            case K_K: jb.A = X16; jb.x2 = RS; jb.Bt = (const bf16_t*)(ws + WS_KVW); jb.O = Kb; break;
            case K_VT: jb.A = (const bf16_t*)(ws + WS_KVW) + (size_t)DM * DM; jb.Bt = X16; jb.x2 = RS; jb.M = DM; jb.N = TOK; jb.O = Vtb; jb.epi = pg8::EPI_VT; break;
            case K_Q: jb.A = X16; jb.x2 = RS; jb.Bt = (const bf16_t*)(ws + WS_QW) + (size_t)j * DM * DM; jb.O = Qb; jb.scale = 0.125f * LOG2E; break;
            default:   jb.A = ONb; jb.Bt = (const bf16_t*)(ws + WS_OW) + (size_t)j * DM * DM; break;
            }
#ifndef NO_GEMM
            pg8::gemm_phase(c.lds, jb, c.G, c.bx, c.vc, c.tid);
#endif
            if (kind == K_Z) scan_after_z(c, p, j);
        } else if (kind == K_NORMA || kind == K_NORMB || kind == K_PRO) {
            if (kind == K_PRO) {
#ifndef NO_TAB
                for (int u = c.bx; u < 2 * NG; u += c.G) ssm_tables(c, p, u >> 6, u & 63);
#endif
                if (c.bx == c.G - 1) small_tables(c, p);
#ifndef NO_CONV
                convert_weights(c, p);
#endif
            }
            const void* xin = X; void* xout = X; int xin_f32 = 0, xout_f32 = 0; const bf16_t* mix = HM; const float* gpost = nullptr; float* rsout = (float*)(ws + WS_RS);
            if (kind == K_PRO) { xin = p.in[0]; xin_f32 = 1; mix = nullptr; }
            else if (kind == K_NORMA) { if (layer == 3) xout = Kb; gpost = p.in[2] + layer * DM; }
            else { gpost = p.in[4] + layer * DM; if (layer == 3) { xin = Kb; xout_f32 = 1; rsout = nullptr; } }
#ifndef NO_NORM
            norm_phase(c, xin, xin_f32, xout, xout_f32, mix, gpost, rsout);
#endif
        } else if (kind == K_SCAN) {
#ifndef NO_SCAN
            scan_phase(c, p, j);
#endif
        } else {
#ifndef NO_ATTN
            attn_phase(c, Qb, Kb, Vtb, ONb, (const float*)(ws + WS_BIAS), (const float*)(ws + WS_SCAL) + j * 4, p.in[24] + j * 128);
#endif
        }
        }
        if (!(kind == K_K || kind == K_VT || ph == 34)) { if (ph == 0 && c.G > 0x40000000) grid.sync(); else { XcdBarrier xb_; xb_.bar = (unsigned*)(ws + WS_BAR); xb_.x = xb_xcc_id(); xb_.st = (volatile LAS unsigned*)(c.lds + 131072); xcd_barrier(xb_); } }
    }
}

extern "C" void kernel_launch(void* const* d_in, const int* in_sizes, int n_in, void* d_out, int out_size, void* d_ws, size_t ws_size, hipStream_t stream) {
    static int grid_blocks = 0;
    if (grid_blocks == 0) {
        if (n_in != 27 || out_size != TOK * DM || ws_size < WS_END) { fprintf(stderr, "kernel_launch: unexpected shapes (n_in %d, out %d, ws %zu)\n", n_in, out_size, ws_size); grid_blocks = -1; return; }
        int dev = 0, cus = 0, per_cu = 0;
        hipGetDevice(&dev);
        hipDeviceGetAttribute(&cus, hipDeviceAttributeMultiprocessorCount, dev);
        if (hipFuncSetAttribute((const void*)yoco_fwd, hipFuncAttributeMaxDynamicSharedMemorySize, LDS_BYTES) != hipSuccess) { fprintf(stderr, "kernel_launch: hipFuncSetAttribute failed\n"); grid_blocks = -1; return; }
        if (hipOccupancyMaxActiveBlocksPerMultiprocessor(&per_cu, (const void*)yoco_fwd, 512, LDS_BYTES) != hipSuccess || per_cu < 1) { fprintf(stderr, "kernel_launch: occupancy query says %d\n", per_cu); per_cu = 1; }
        (void)hipGetLastError();
        grid_blocks = cus * 1;
    }
    if (grid_blocks < 0) return;
    Params p{};
    for (int i = 0; i < 27; ++i) p.in[i] = (const float*)d_in[i];
    p.out = (float*)d_out; p.ws = (unsigned char*)d_ws;
    if (hipMemsetAsync((char*)d_ws + WS_BAR, 0, 16384, stream) != hipSuccess) { fprintf(stderr, "kernel_launch: memset of barrier words failed\n"); return; }
    void* args[] = {&p};
    hipError_t e = hipLaunchCooperativeKernel((const void*)yoco_fwd, dim3(grid_blocks), dim3(512), args, LDS_BYTES, stream);
    if (e != hipSuccess) fprintf(stderr, "cooperative launch failed: %s (grid %d)\n", hipGetErrorString(e), grid_blocks);
}
```

```cpp
#include <hip/hip_runtime.h>
#include <hip/hip_cooperative_groups.h>
#include <cstdio>
#include <cstdint>
namespace cg = cooperative_groups;

#define LAS __attribute__((address_space(3)))
typedef unsigned short bf16_t;
typedef short bf16x8 __attribute__((ext_vector_type(8)));
typedef float f32x4 __attribute__((ext_vector_type(4)));
typedef float f32x16 __attribute__((ext_vector_type(16)));
typedef unsigned u32x4 __attribute__((ext_vector_type(4)));
typedef unsigned u32x2 __attribute__((ext_vector_type(2)));

constexpr int TOK = 32768, DM = 1024, FF = 4096, SEQ = 8192;
constexpr int NG = 64, GS = 16, NP = 64;
constexpr int CL = 32;
constexpr int NCH = TOK / CL;
constexpr int UGP = CL * GS + 2 * NP;
constexpr float EPS = 1e-6f;
constexpr float LOG2E = 1.4426950408889634f;

constexpr size_t MiB = 1u << 20;
constexpr size_t WS_BIAS = 0;
constexpr size_t WS_SCAL = 4096;
constexpr size_t WS_LAML = 8192;
constexpr size_t WS_RS = 786432;
constexpr size_t WS_BAR = 131072;
constexpr size_t WS_UP23 = 1 * MiB;
constexpr size_t WS_DN23 = 17 * MiB;
constexpr size_t WS_KVW = 33 * MiB;
constexpr size_t WS_QW = 37 * MiB;
constexpr size_t WS_OW = 41 * MiB;
constexpr size_t WS_UP01 = 45 * MiB;
constexpr size_t WS_DN01 = 61 * MiB;
constexpr size_t WS_WIN = 77 * MiB;
constexpr size_t WS_GLU = 81 * MiB;
constexpr size_t WS_TM = 89 * MiB;
constexpr size_t WS_SIN = 169 * MiB;
constexpr size_t WS_K = 45 * MiB;
constexpr size_t WS_VT = 109 * MiB;
constexpr size_t WS_HM = 186 * MiB;
constexpr size_t WS_ACT = 250 * MiB;
constexpr size_t WS_UG = WS_ACT;
constexpr size_t WS_Z = WS_ACT + 80 * MiB;
constexpr size_t WS_YG = WS_ACT + 112 * MiB;
constexpr size_t WS_Q = WS_ACT;
constexpr size_t WS_ON = WS_ACT + 64 * MiB;
constexpr size_t WS_HKV = WS_ACT + 128 * MiB;
constexpr size_t WS_END = 506 * MiB;

constexpr int LDS_BYTES = 147456;
#ifndef REPEAT_MASK
#define REPEAT_MASK 0
#endif

__device__ __forceinline__ unsigned cvt_pk_bf16(float lo, float hi) { unsigned r; asm("v_cvt_pk_bf16_f32 %0, %1, %2" : "=v"(r) : "v"(lo), "v"(hi)); return r; }
__device__ __forceinline__ float bf_lo(unsigned w) { return __uint_as_float(w << 16); }
__device__ __forceinline__ float bf_hi(unsigned w) { return __uint_as_float(w & 0xffff0000u); }
__device__ __forceinline__ float fexp2(float x) { return __builtin_amdgcn_exp2f(x); }
__device__ __forceinline__ float frcp(float x) { return __builtin_amdgcn_rcpf(x); }
__device__ __forceinline__ float max3f(float a, float b, float c) { float r; asm("v_max3_f32 %0, %1, %2, %3" : "=v"(r) : "v"(a), "v"(b), "v"(c)); return r; }
__device__ __forceinline__ float max2f(float a, float b) { float r; asm("v_max_f32_e32 %0, %1, %2" : "=v"(r) : "v"(a), "v"(b)); return r; }
__device__ __forceinline__ int opaque_tid() { int t_ = threadIdx.x; asm volatile("" : "+v"(t_)); return t_; }
__device__ __forceinline__ float wave_sum(float v) {
#pragma unroll
    for (int o = 32; o >= 1; o >>= 1) v += __shfl_xor(v, o);
    return v;
}
__device__ __forceinline__ float gelu_tanh(float y) {
    const float t = y * (1.5957691216057308f + 0.07135481627f * y * y);
    return y * frcp(1.0f + fexp2(-t * LOG2E));
}

namespace pg8 {
constexpr int BM = 256, BK = 64, HALF = 128, HTB = HALF * BK * 2, STAGE_BYTES = 8 * HTB;
__host__ __device__ __forceinline__ int lds_byte(int r, int c) { const int st = (r >> 4) * 2 + (c >> 5), rr = r & 15, cc = c & 31, ob = rr * 64 + cc * 2; return st * 1024 + (ob ^ (((ob >> 9) & 1) << 5)); }
__host__ __device__ __forceinline__ void stage_rc(int b, int& R, int& C) { const int st = b / 1024, sb = b % 1024, swz = sb ^ (((sb >> 9) & 1) << 5); R = (st >> 1) * 16 + swz / 64; C = (st & 1) * 32 + (swz % 64) / 2; }
__host__ __device__ __forceinline__ int perm32(int rho) { const int n = rho >> 4, i = rho & 15; return 8 * (i >> 2) + 4 * n + (i & 3); }

struct Unit { int pm, pn, arow, brow; };
enum { ORD_STATIC = 0, ORD_Z = 1, ORD_Y = 2 };
enum { EPI_STORE = 0, EPI_RELU2 = 1, EPI_GLU = 2, EPI_UG = 3, EPI_Z = 4, EPI_Y = 5, EPI_VT = 6 };
struct Job { const bf16_t* A; const bf16_t* Bt; int lda, ldb, K, ord, M, N, epi, ldc; float scale; void* O; const void* x1; const void* x2; };

__device__ __forceinline__ bool next_unit(const Job& jb, int G, int bx, int vc, int i, Unit& u) {
    if (jb.ord == ORD_STATIC) {
        const int nM = jb.M / BM, nN = jb.N / BM, nwg = nM * nN;
        const long L = (long)i * G + bx; if (L >= nwg) return false;
        int wgid = (int)L; { const int q = nwg / 8, r = nwg % 8, xcd = wgid % 8, off = wgid / 8; wgid = (xcd < r ? xcd * (q + 1) : r * (q + 1) + (xcd - r) * q) + off; }
        const int nig = 8 * nN, gid = wgid / nig, fm = gid * 8, gsz = (nM - fm) < 8 ? (nM - fm) : 8;
        u.pm = fm + ((wgid % nig) % gsz); u.pn = (wgid % nig) / gsz; u.arow = u.pm * BM; u.brow = u.pn * BM; return true;
    } else if (jb.ord == ORD_Z) {
        const int L = i * G + vc; if (L >= NG * 4) return false; u.pm = L; u.pn = 0; u.arow = L * BM; u.brow = (L >> 2) * 128; return true;
    } else {
        const int L = i * G + vc; if (L >= NG * 8) return false; const int g = L >> 3, r = L & 7; u.pm = g * 4 + (r >> 1); u.pn = g * 2 + (r & 1); u.arow = u.pm * BM; u.brow = u.pn * BM; return true;
    }
}

typedef f32x4 Acc[2][2][4][2];
__device__ __forceinline__ u32x4 pack8(const f32x4 v0, const f32x4 v1) { u32x4 w; w.x = cvt_pk_bf16(v0[0], v0[1]); w.y = cvt_pk_bf16(v0[2], v0[3]); w.z = cvt_pk_bf16(v1[0], v1[1]); w.w = cvt_pk_bf16(v1[2], v1[3]); return w; }

__device__ __forceinline__ void epilogue(const Job& jb, const Acc& acc, const Unit& u) {
    int t_ = threadIdx.x; asm volatile("" : "+v"(t_));
    const int wid_ = __builtin_amdgcn_readfirstlane(t_ >> 6), wr = wid_ >> 2, wc = wid_ & 3, fr = t_ & 15, fq = (t_ & 63) >> 4;
    const int row0 = u.pm * BM + wr * 64 + fr;
#ifdef EPI_MASK
    const int epi_ = ((1 << jb.epi) & EPI_MASK) ? jb.epi : 0;
#else
    const int epi_ = jb.epi;
#endif
    if (epi_ == EPI_STORE || epi_ == EPI_RELU2) {
        bf16_t* O = (bf16_t*)jb.O; const int col0 = u.pn * BM + wc * 32 + 8 * fq; const bool r2 = epi_ == EPI_RELU2; const float scale = jb.scale; const float* rsc = (const float*)jb.x2;
#pragma unroll
        for (int ai = 0; ai < 2; ++ai)
#pragma unroll
            for (int m = 0; m < 4; ++m) { bf16_t* rowp = O + (size_t)(row0 + ai * HALF + m * 16) * jb.ldc + col0;
                float rsv = 1.0f; if (rsc) { rsv = rsc[row0 + ai * HALF + m * 16]; if (r2) rsv = rsv * rsv; }
                const float sc_ = scale * rsv;
#pragma unroll
                for (int bj = 0; bj < 2; ++bj) { f32x4 v0 = acc[ai][bj][m][0], v1 = acc[ai][bj][m][1];
                    if (r2) {
#pragma unroll
                        for (int e = 0; e < 4; ++e) { const float a = fmaxf(v0[e], 0.f), b = fmaxf(v1[e], 0.f); v0[e] = a * a; v1[e] = b * b; } }
                    v0 = v0 * sc_; v1 = v1 * sc_;
                    *(u32x4*)(rowp + bj * HALF) = pack8(v0, v1); } }
    } else if (epi_ == EPI_GLU) {
        bf16_t* O = (bf16_t*)jb.O; const int col0 = u.pn * HALF + wc * 32 + 8 * fq;
#pragma unroll
        for (int ai = 0; ai < 2; ++ai)
#pragma unroll
            for (int m = 0; m < 4; ++m) { bf16_t* rowp = O + (size_t)(row0 + ai * HALF + m * 16) * DM + col0;
                f32x4 o0, o1;
#pragma unroll
                for (int e = 0; e < 4; ++e) { o0[e] = acc[ai][0][m][0][e] * frcp(1.0f + fexp2(-acc[ai][1][m][0][e] * LOG2E)); o1[e] = acc[ai][0][m][1][e] * frcp(1.0f + fexp2(-acc[ai][1][m][1][e] * LOG2E)); }
                *(u32x4*)rowp = pack8(o0, o1); }
    } else if (epi_ == EPI_UG) {
        bf16_t* Ug = (bf16_t*)jb.O; const float* rsc = (const float*)jb.x2;
#pragma unroll
        for (int ai = 0; ai < 2; ++ai)
#pragma unroll
            for (int m = 0; m < 4; ++m) { const int tok = row0 + ai * HALF + m * 16; const float rsv = rsc[tok];
#pragma unroll
                for (int bj = 0; bj < 2; ++bj) { const int g = u.pn * 16 + bj * 8 + wc * 2 + (fq >> 1);
                    *(u32x4*)(Ug + ((size_t)(g * NCH + (tok >> 5)) * UGP + (tok & 31) * 16 + (fq & 1) * 8)) = pack8(acc[ai][bj][m][0] * rsv, acc[ai][bj][m][1] * rsv); } }
    } else if (epi_ == EPI_Z) {
        float* Z = (float*)jb.O; const int col0 = wc * 32 + 8 * fq;
#pragma unroll
        for (int ai = 0; ai < 2; ++ai)
#pragma unroll
            for (int m = 0; m < 4; ++m) { float* p = Z + (size_t)(row0 + ai * HALF + m * 16) * 128 + col0;
                *(f32x4*)p = acc[ai][0][m][0]; *(f32x4*)(p + 4) = acc[ai][0][m][1]; }
    } else if (epi_ == EPI_VT) {
        bf16_t* O = (bf16_t*)jb.O; const int col0 = u.pn * BM + wc * 32 + 8 * fq; const float* rsc = (const float*)jb.x2;
        const f32x4 ra0 = *(const f32x4*)(rsc + col0), rb0 = *(const f32x4*)(rsc + col0 + 4), ra1 = *(const f32x4*)(rsc + col0 + HALF), rb1 = *(const f32x4*)(rsc + col0 + HALF + 4);
#pragma unroll
        for (int ai = 0; ai < 2; ++ai)
#pragma unroll
            for (int m = 0; m < 4; ++m) { const int row = row0 + ai * HALF + m * 16;
#pragma unroll
                for (int bj = 0; bj < 2; ++bj) { const int col = col0 + bj * HALF;
                    const size_t off = ((size_t)(((col >> 13) * 8 + (row >> 7)) * 128 + ((col & 8191) >> 6)) << 13) + (row & 127) * 64 + (col & 63);
                    *(u32x4*)(O + off) = pack8(acc[ai][bj][m][0] * (bj ? ra1 : ra0), acc[ai][bj][m][1] * (bj ? rb1 : rb0)); } }
    } else {
        const bf16_t* Ug = (const bf16_t*)jb.x1; const float* dsk = (const float*)jb.x2; bf16_t* YG = (bf16_t*)jb.O;
        const int g = u.pm >> 2, n0 = (u.pm & 3) * BM + wr * 64 + fr, c0 = (u.pn & 1) * BM + wc * 32 + 8 * fq;
        const int co0 = (fq & 1) * 8;
        const f32x4 d0 = *(const f32x4*)(dsk + g * 16 + co0), d1 = *(const f32x4*)(dsk + g * 16 + co0 + 4);
#pragma unroll
        for (int ai = 0; ai < 2; ++ai)
#pragma unroll
            for (int m = 0; m < 4; ++m) { const int n = n0 + ai * HALF + m * 16;
#pragma unroll
                for (int bj = 0; bj < 2; ++bj) { const int cc = c0 + bj * HALF, j = cc >> 4;
                    const u32x4 uu = *(const u32x4*)(Ug + ((size_t)(g * NCH + n) * UGP + cc));
                    const f32x4 v0 = acc[ai][bj][m][0], v1 = acc[ai][bj][m][1];
                    f32x4 y0, y1;
                    y0[0] = v0[0] + d0[0] * bf_lo(uu.x); y0[1] = v0[1] + d0[1] * bf_hi(uu.x); y0[2] = v0[2] + d0[2] * bf_lo(uu.y); y0[3] = v0[3] + d0[3] * bf_hi(uu.y);
                    y1[0] = v1[0] + d1[0] * bf_lo(uu.z); y1[1] = v1[1] + d1[1] * bf_hi(uu.z); y1[2] = v1[2] + d1[2] * bf_lo(uu.w); y1[3] = v1[3] + d1[3] * bf_hi(uu.w);
#pragma unroll
                    for (int e = 0; e < 4; ++e) { y0[e] = gelu_tanh(y0[e]); y1[e] = gelu_tanh(y1[e]); }
                    *(u32x4*)(YG + ((size_t)(n * CL + j) * DM + g * 16 + co0)) = pack8(y0, y1); } }
    }
}

__device__ __forceinline__ void gemm_phase(LAS unsigned char* lds, const Job& g, const int G, const int bx, const int vc, const int tid_unused) {
    const int tid = opaque_tid(); (void)tid_unused;
    const int wid = __builtin_amdgcn_readfirstlane(tid >> 6), lane = tid & 63, wr = wid >> 2, wc = wid & 3, fr = lane & 15, fq = lane >> 4;
    const int K = g.K, nt = K / BK;
    unsigned voffA[2], voffB[2];
#pragma unroll
    for (int i = 0; i < 2; ++i) { int R, C; stage_rc(tid * 16 + i * 8192, R, C); const int Rb = (R & ~31) + perm32(R & 31);
        voffA[i] = (unsigned)(R * g.lda + C) * 2u; voffB[i] = (unsigned)(Rb * g.ldb + C) * 2u; }
    const size_t kstep = (size_t)(BK * 2);
    const size_t hstepA = (size_t)HALF * g.lda * 2, hstepB = (size_t)HALF * g.ldb * 2;
    const size_t rowA = (size_t)g.lda * 2, rowB = (size_t)g.ldb * 2;
    const unsigned ldsw = (unsigned)wid * 1024u;
    const int aoff = lds_byte(wr * 64 + fr, fq * 8), boff = lds_byte(wc * 32 + fr, fq * 8);
#define PG8_SA(b, h) (((b) * 2 + (h)) * HTB)
#define PG8_SB(b, h) ((4 + (b) * 2 + (h)) * HTB)
#define PG8_STAGE(bufoff, gbase, voff) do { _Pragma("unroll") for (int _i = 0; _i < 2; ++_i) \
        __builtin_amdgcn_global_load_lds((const unsigned*)((const char*)(gbase) + (voff)[_i]), (LAS unsigned*)(lds + (bufoff) + ldsw + _i * 8192), 16, 0, 0); } while (0)
#define PG8_LDA(dst, b, h) do { _Pragma("unroll") for (int m = 0; m < 4; ++m) _Pragma("unroll") for (int k = 0; k < 2; ++k) dst[m][k] = *(const LAS bf16x8*)(lds + PG8_SA(b, h) + aoff + m * 2048 + k * 1024); } while (0)
#define PG8_LDB(dst, b, h) do { _Pragma("unroll") for (int n = 0; n < 2; ++n) _Pragma("unroll") for (int k = 0; k < 2; ++k) dst[n][k] = *(const LAS bf16x8*)(lds + PG8_SB(b, h) + boff + n * 2048 + k * 1024); } while (0)
#define PG8_MMA(ai, bj, At, Bt) do { __builtin_amdgcn_s_setprio(1); _Pragma("unroll") for (int m = 0; m < 4; ++m) _Pragma("unroll") for (int n = 0; n < 2; ++n) _Pragma("unroll") for (int k = 0; k < 2; ++k) \
        acc[ai][bj][m][n] = __builtin_amdgcn_mfma_f32_16x16x32_bf16(Bt[n][k], At[m][k], acc[ai][bj][m][n], 0, 0, 0); __builtin_amdgcn_s_setprio(0); } while (0)
#define PG8_WAIT_V(n) asm volatile("s_waitcnt vmcnt(" #n ")" ::: "memory")
#define PG8_WAIT_L(n) asm volatile("s_waitcnt lgkmcnt(" #n ")" ::: "memory")
#define PG8_BAR __builtin_amdgcn_s_barrier()
#define PG8_SCHED __builtin_amdgcn_sched_barrier(0)
    Unit cur, nxt; int ui = 0;
    if (!next_unit(g, G, bx, vc, 0, cur)) return;
    Acc acc;
#pragma unroll
    for (int a = 0; a < 2; ++a)
#pragma unroll
        for (int b = 0; b < 2; ++b)
#pragma unroll
            for (int m = 0; m < 4; ++m)
#pragma unroll
                for (int n = 0; n < 2; ++n) acc[a][b][m][n] = (f32x4){0.f, 0.f, 0.f, 0.f};
    bf16x8 At[4][2], B0[2][2], B1[2][2];
    const char* cA = (const char*)g.A + (size_t)cur.arow * rowA; const char* cB = (const char*)g.Bt + (size_t)cur.brow * rowB;
    PG8_STAGE(PG8_SB(0, 0), cB, voffB); PG8_STAGE(PG8_SB(0, 1), cB + hstepB, voffB); PG8_STAGE(PG8_SA(0, 0), cA, voffA); PG8_STAGE(PG8_SA(0, 1), cA + hstepA, voffA);
    if (wr == 1) PG8_BAR;
    PG8_WAIT_V(2); PG8_BAR;
    PG8_STAGE(PG8_SB(1, 0), cB + kstep, voffB); PG8_STAGE(PG8_SA(1, 0), cA + kstep, voffA); PG8_STAGE(PG8_SB(1, 1), cB + hstepB + kstep, voffB);
    PG8_WAIT_V(6); PG8_BAR;
    for (;;) {
        const bool has_next = next_unit(g, G, bx, vc, ui + 1, nxt);
        const char* nA = has_next ? (const char*)g.A + (size_t)nxt.arow * rowA : cA; const char* nB = has_next ? (const char*)g.Bt + (size_t)nxt.brow * rowB : cB;
        for (int t = 0; t < nt; t += 2) {
            const bool last = (t == nt - 2);
            const char* a1 = cA + (size_t)(t + 1) * kstep;
            const char* a2 = last ? nA : cA + (size_t)(t + 2) * kstep; const char* b2 = last ? nB : cB + (size_t)(t + 2) * kstep;
            const char* a3 = a2 + kstep; const char* b3 = b2 + kstep;
            PG8_LDB(B0, 0, 0); PG8_LDB(B1, 0, 1); PG8_SCHED; PG8_LDA(At, 0, 0); PG8_STAGE(PG8_SA(1, 1), a1 + hstepA, voffA);
            PG8_WAIT_V(8); PG8_WAIT_L(0); PG8_BAR; PG8_MMA(0, 0, At, B0); PG8_MMA(0, 1, At, B1); PG8_BAR; PG8_SCHED;
            PG8_LDA(At, 0, 1); PG8_STAGE(PG8_SB(0, 0), b2, voffB); PG8_STAGE(PG8_SB(0, 1), b2 + hstepB, voffB); PG8_STAGE(PG8_SA(0, 0), a2, voffA);
            PG8_WAIT_V(8); PG8_WAIT_L(0); PG8_BAR; PG8_MMA(1, 0, At, B0); PG8_MMA(1, 1, At, B1); PG8_BAR; PG8_SCHED;
            PG8_LDB(B0, 1, 0); PG8_LDB(B1, 1, 1); PG8_SCHED; PG8_LDA(At, 1, 0); PG8_STAGE(PG8_SA(0, 1), a2 + hstepA, voffA);
            PG8_WAIT_V(8); PG8_WAIT_L(0); PG8_BAR; PG8_MMA(0, 0, At, B0); PG8_MMA(0, 1, At, B1); PG8_BAR; PG8_SCHED;
            PG8_LDA(At, 1, 1); PG8_STAGE(PG8_SB(1, 0), b3, voffB); PG8_STAGE(PG8_SB(1, 1), b3 + hstepB, voffB); PG8_STAGE(PG8_SA(1, 0), a3, voffA);
            PG8_WAIT_V(8); PG8_WAIT_L(0); PG8_BAR; PG8_MMA(1, 0, At, B0); PG8_MMA(1, 1, At, B1); PG8_BAR; PG8_SCHED;
        }
        if (wr == 0) PG8_BAR;
        epilogue(g, acc, cur);
        if (!has_next) break;
#pragma unroll
        for (int a = 0; a < 2; ++a)
#pragma unroll
            for (int b = 0; b < 2; ++b)
#pragma unroll
                for (int m = 0; m < 4; ++m)
#pragma unroll
                    for (int n = 0; n < 2; ++n) acc[a][b][m][n] = (f32x4){0.f, 0.f, 0.f, 0.f};
        cur = nxt; cA = nA; cB = nB; ++ui;
        if (wr == 1) PG8_BAR;
    }
    PG8_WAIT_V(0);
    PG8_BAR;
#undef PG8_SA
#undef PG8_SB
#undef PG8_STAGE
#undef PG8_LDA
#undef PG8_LDB
#undef PG8_MMA
#undef PG8_WAIT_V
#undef PG8_WAIT_L
#undef PG8_BAR
#undef PG8_SCHED
}
}

#define XB_TMO      128
#define XB_XCNT(j)  (256  + 64 * (j))
#define XB_XSUB(j)  (1280 + 64 * (j))
#define XB_XGEN(j)  (2304 + 64 * (j))
#define XB_TOP      3328
#define XB_TOPGEN   3392
#define XCD_BAR_WORDS 3456
#define XB_SPIN_CAP (1u << 22)
__device__ __forceinline__ unsigned xb_ld(unsigned* p)              { return __hip_atomic_load(p, __ATOMIC_RELAXED, __HIP_MEMORY_SCOPE_AGENT); }
__device__ __forceinline__ unsigned xb_add(unsigned* p, unsigned v) { return __hip_atomic_fetch_add(p, v, __ATOMIC_RELAXED, __HIP_MEMORY_SCOPE_AGENT); }
__device__ __forceinline__ unsigned xb_xcc_id() { return (unsigned)__builtin_amdgcn_s_getreg((3 << 11) | 20) & 0xFu; }
#define XB_SPIN(cond, bar) do { unsigned _sp = 0; while (cond) { __builtin_amdgcn_s_sleep(1); \
    if ((++_sp & 255u) == 0u) { if (xb_ld(&(bar)[XB_TMO])) break; if (_sp > XB_SPIN_CAP) { atomicAdd(&(bar)[XB_TMO], 1u); break; } } } } while (0)
struct XcdBarrier { unsigned* bar; unsigned x; volatile LAS unsigned* st; };
__device__ __forceinline__ XcdBarrier xcd_barrier_post(unsigned* bar, volatile LAS unsigned* st) {
    XcdBarrier b; b.bar = bar; b.x = xb_xcc_id(); b.st = st;
    if (threadIdx.x == 0) (void)xb_add(&bar[XB_XCNT(b.x)], 1u);
    return b;
}
__device__ __forceinline__ void xcd_barrier_complete(unsigned* bar, unsigned x, unsigned& nloc, unsigned& nx) {
    const unsigned G = gridDim.x * gridDim.y * gridDim.z;
    unsigned sum, cnt, mine, sp = 0u;
    for (;;) {
        sum = 0u; cnt = 0u; mine = 0u;
#pragma unroll
        for (unsigned j = 0; j < 16; ++j) { const unsigned c = xb_ld(&bar[XB_XCNT(j)]); sum += c; cnt += (c > 0u) ? 1u : 0u; mine = (j == x) ? c : mine; }
        if (sum == G) break;
        __builtin_amdgcn_s_sleep(1);
        if ((++sp & 255u) == 0u) { if (xb_ld(&bar[XB_TMO])) break; if (sp > XB_SPIN_CAP) { atomicAdd(&bar[XB_TMO], 1u); break; } }
    }
    nloc = mine > 0u ? mine : 1u; nx = cnt > 0u ? cnt : 1u;
}
__device__ __forceinline__ void xcd_barrier(const XcdBarrier& b) {
    asm volatile("s_waitcnt vmcnt(0)" ::: "memory");
    __syncthreads();
    if (threadIdx.x == 0) {
        unsigned* bar = b.bar;
        __builtin_amdgcn_s_waitcnt(0);
        unsigned nloc = b.st[0], nx = b.st[1];
        if (nloc == 0u) { xcd_barrier_complete(bar, b.x, nloc, nx); b.st[0] = nloc; b.st[1] = nx; }
        const unsigned old = xb_add(&bar[XB_XSUB(b.x)], 1u);
        const unsigned gen = old / nloc;
        if (old + 1u == (gen + 1u) * nloc) {
            __builtin_amdgcn_fence(__ATOMIC_RELEASE, "agent");
            asm volatile("s_waitcnt vmcnt(0)" ::: "memory");
            const unsigned og = xb_add(&bar[XB_TOP], 1u);
            const unsigned tg = og / nx;
            if (og + 1u == (tg + 1u) * nx) xb_add(&bar[XB_TOPGEN], 1u);
            else XB_SPIN(xb_ld(&bar[XB_TOPGEN]) == tg, bar);
            __builtin_amdgcn_fence(__ATOMIC_ACQUIRE, "agent");
            xb_add(&bar[XB_XGEN(b.x)], 1u);
            asm volatile("s_waitcnt vmcnt(0)" ::: "memory");
        } else {
            XB_SPIN(xb_ld(&bar[XB_XGEN(b.x)]) == gen, bar);
            __builtin_amdgcn_fence(__ATOMIC_ACQUIRE, "agent");
            asm volatile("s_waitcnt vmcnt(0)" ::: "memory");
        }
    }
    __syncthreads();
}

struct Params {
    const float* in[27];
    float* out;
    unsigned char* ws;
};

struct Ctx { LAS unsigned char* lds; int tid, lane, wid, G, bx, vc; };

__device__ __forceinline__ bool wdesc(int i, const Params& p, const float*& src, bf16_t*& dst, int& K, int& N, int& glu, const float*& gain) {
    unsigned char* ws = p.ws; glu = 0; gain = nullptr;
    if (i < 4) { gain = p.in[3] + i * DM; src = p.in[5] + (size_t)i * DM * FF; dst = (bf16_t*)(ws + (i < 2 ? WS_UP01 : WS_UP23)) + (size_t)(i & 1) * DM * FF; K = DM; N = FF; return true; }
    if (i < 8) { const int l = i - 4; src = p.in[6] + (size_t)l * DM * FF; dst = (bf16_t*)(ws + (l < 2 ? WS_DN01 : WS_DN23)) + (size_t)(l & 1) * DM * FF; K = FF; N = DM; return true; }
    if (i < 10) { const int l = i - 8; gain = p.in[1] + l * DM; src = p.in[7] + (size_t)l * DM * DM; dst = (bf16_t*)(ws + WS_WIN) + (size_t)l * DM * DM; K = DM; N = DM; return true; }
    if (i < 12) { const int l = i - 10; src = p.in[16] + (size_t)l * DM * 2 * DM; dst = (bf16_t*)(ws + WS_GLU) + (size_t)l * DM * 2 * DM; K = DM; N = 2 * DM; glu = 1; return true; }
    if (i < 13) { gain = p.in[17]; src = p.in[18]; dst = (bf16_t*)(ws + WS_KVW); K = DM; N = 2 * DM; return true; }
    if (i < 15) { const int l = i - 13; gain = p.in[1] + (2 + l) * DM; src = p.in[19] + (size_t)l * DM * DM; dst = (bf16_t*)(ws + WS_QW) + (size_t)l * DM * DM; K = DM; N = DM; return true; }
    if (i < 17) { const int l = i - 15; src = p.in[25] + (size_t)l * DM * DM; dst = (bf16_t*)(ws + WS_OW) + (size_t)l * DM * DM; K = DM; N = DM; return true; }
    return false;
}
__device__ __forceinline__ bool wlocate(int f, const Params& p, const float*& src, bf16_t*& dst, int& K, int& N, int& n0, int& k0, int& sc0, const float*& gain) {
    int base = 0;
    for (int i = 0; ; ++i) {
        int glu;
        if (!wdesc(i, p, src, dst, K, N, glu, gain)) return false;
        const int ntk = K >> 6, nt = ntk * (N >> 6);
        if (f < base + nt) { const int t = f - base; n0 = (t / ntk) << 6; k0 = (t % ntk) << 6;
            sc0 = glu ? (((n0 >> 7) & 1) * DM + (n0 >> 8) * 128 + (n0 & 127)) : n0; return true; }
        base += nt;
    }
}
constexpr int NCONV_TILES = 11264;
__device__ void convert_weights(const Ctx& c, const Params& p) {
    LAS float* T = (LAS float*)c.lds;
    int f, fstep, fend;
    if (c.G == 256) { if (c.bx < 128) { f = c.bx; fstep = 128; fend = 128 * 38; } else { f = 128 * 38 + (c.bx - 128); fstep = 128; fend = NCONV_TILES; } }
    else { f = c.bx; fstep = c.G; fend = NCONV_TILES; }
    const float* src; bf16_t* dst; int K, N, n0, k0, sc0; const float* gain;
    bool have = (f < fend) && wlocate(f, p, src, dst, K, N, n0, k0, sc0, gain);
    f32x4 v0, v1;
    const int ctid = opaque_tid(); const int kk = ctid >> 4, c4 = (ctid & 15) * 4;
    if (have) { v0 = *(const f32x4*)(src + (size_t)(k0 + kk) * N + sc0 + c4); v1 = *(const f32x4*)(src + (size_t)(k0 + 32 + kk) * N + sc0 + c4); if (gain) { v0 = v0 * gain[k0 + kk]; v1 = v1 * gain[k0 + 32 + kk]; } }
    int par = 0;
    while (have) {
        const f32x4 a0 = v0, a1 = v1; bf16_t* cdst = dst; const int cK = K, cn0 = n0, ck0 = k0;
        f += fstep;
        have = (f < fend) && wlocate(f, p, src, dst, K, N, n0, k0, sc0, gain);
        if (have) { v0 = *(const f32x4*)(src + (size_t)(k0 + kk) * N + sc0 + c4); v1 = *(const f32x4*)(src + (size_t)(k0 + 32 + kk) * N + sc0 + c4); if (gain) { v0 = v0 * gain[k0 + kk]; v1 = v1 * gain[k0 + 32 + kk]; } }
        LAS float* Tb = T + par * (64 * 65);
        Tb[(c4 + 0) * 65 + kk] = a0[0]; Tb[(c4 + 1) * 65 + kk] = a0[1]; Tb[(c4 + 2) * 65 + kk] = a0[2]; Tb[(c4 + 3) * 65 + kk] = a0[3];
        Tb[(c4 + 0) * 65 + 32 + kk] = a1[0]; Tb[(c4 + 1) * 65 + 32 + kk] = a1[1]; Tb[(c4 + 2) * 65 + 32 + kk] = a1[2]; Tb[(c4 + 3) * 65 + 32 + kk] = a1[3];
        __syncthreads();
        { const int nn = ctid >> 3, k8 = (ctid & 7) * 8; const LAS float* r = Tb + nn * 65 + k8;
          u32x4 w; w.x = cvt_pk_bf16(r[0], r[1]); w.y = cvt_pk_bf16(r[2], r[3]); w.z = cvt_pk_bf16(r[4], r[5]); w.w = cvt_pk_bf16(r[6], r[7]);
          *(u32x4*)(cdst + (size_t)(cn0 + nn) * cK + ck0 + k8) = w; }
        par ^= 1;
    }
    __syncthreads();
}

__device__ void ssm_tables(const Ctx& c, const Params& p, int layer, int g) {
    LAS float* lamp = (LAS float*)c.lds;
    LAS float* bbar = lamp + 33 * 64 * 2;
    LAS float* ccp = bbar + 64 * 16 * 2;
    LAS float* Kt = ccp + 16 * 64 * 2;
    LAS float* coef = Kt + 32 * 256;
    const int tid = opaque_tid();
    const size_t lg = (size_t)layer * NG + g;
    if (tid < 64) {
        const int pp = tid;
        const float dt = expf(p.in[10][lg]);
        const float lr = p.in[8][lg * NP + pp], li = p.in[9][lg * NP + pp];
        const float mag = expf(lr * dt), ar = mag * cosf(li * dt), ai = mag * sinf(li * dt);
        const float den = lr * lr + li * li;
        coef[pp * 2] = ((ar - 1.0f) * lr + ai * li) / den; coef[pp * 2 + 1] = (ai * lr - (ar - 1.0f) * li) / den;
        float pr = 1.0f, pi = 0.0f; asm volatile("" : "+v"(pr), "+v"(pi));
        for (int k = 0; k <= 32; ++k) { lamp[(k * 64 + pp) * 2] = pr; lamp[(k * 64 + pp) * 2 + 1] = pi; const float nr = pr * ar - pi * ai, ni = pr * ai + pi * ar; pr = nr; pi = ni; }
        float* lamL = (float*)(p.ws + WS_LAML) + (lg * NP + pp) * 2;
        lamL[0] = lamp[(32 * 64 + pp) * 2]; lamL[1] = lamp[(32 * 64 + pp) * 2 + 1];
    }
    __syncthreads();
    for (int e = tid; e < 1024; e += 512) {
        const int pp = e >> 4, cc = e & 15;
        const float br = p.in[11][lg * 1024 + e], bi = p.in[12][lg * 1024 + e], cr = coef[pp * 2], ci = coef[pp * 2 + 1];
        bbar[e * 2] = cr * br - ci * bi; bbar[e * 2 + 1] = cr * bi + ci * br;
        ccp[e * 2] = p.in[13][lg * 1024 + e]; ccp[e * 2 + 1] = p.in[14][lg * 1024 + e];
        (void)cc;
    }
    __syncthreads();
    {
        const int k = tid >> 4, co = tid & 15;
        float acc16[16];
#pragma unroll
        for (int q = 0; q < 16; ++q) acc16[q] = 0.f;
        for (int pp = 0; pp < 64; ++pp) {
            const float lr = lamp[(k * 64 + pp) * 2], li = lamp[(k * 64 + pp) * 2 + 1], cr = ccp[(co * 64 + pp) * 2], ci = ccp[(co * 64 + pp) * 2 + 1];
            const float wr = cr * lr - ci * li, wi = cr * li + ci * lr;
            const LAS f32x4* bb = (const LAS f32x4*)(bbar + pp * 32);
#pragma unroll
            for (int q = 0; q < 8; ++q) { const f32x4 b = bb[q]; acc16[2 * q] += wr * b[0] - wi * b[1]; acc16[2 * q + 1] += wr * b[2] - wi * b[3]; }
        }
#pragma unroll
        for (int q = 0; q < 16; ++q) Kt[(k * 16 + co) * 16 + q] = acc16[q];
    }
    __syncthreads();
    bf16_t* Tm = (bf16_t*)(p.ws + WS_TM) + (size_t)layer * NG * 512 * UGP + (size_t)g * 512 * UGP;
    for (int e = tid; e < 512 * 80; e += 512) {
        const int row = e / 80, ch = e % 80, j = row >> 4, co = row & 15;
        float v[8];
        if (ch < 64) { const int i = ch >> 1, ci0 = (ch & 1) * 8;
#pragma unroll
            for (int q = 0; q < 8; ++q) v[q] = (i <= j) ? Kt[((j - i) * 16 + co) * 16 + ci0 + q] : 0.f;
        } else { const int p0 = (ch - 64) * 8;
#pragma unroll
            for (int q = 0; q < 8; ++q) { const int pq = p0 + q, pp = pq & 63;
                const float lr = lamp[((j + 1) * 64 + pp) * 2], li = lamp[((j + 1) * 64 + pp) * 2 + 1], cr = ccp[(co * 64 + pp) * 2], ci = ccp[(co * 64 + pp) * 2 + 1];
                v[q] = pq < 64 ? (cr * lr - ci * li) : -(cr * li + ci * lr); }
        }
        u32x4 w; w.x = cvt_pk_bf16(v[0], v[1]); w.y = cvt_pk_bf16(v[2], v[3]); w.z = cvt_pk_bf16(v[4], v[5]); w.w = cvt_pk_bf16(v[6], v[7]);
        *(u32x4*)(Tm + (size_t)row * UGP + ch * 8) = w;
    }
    bf16_t* Sin = (bf16_t*)(p.ws + WS_SIN) + (size_t)layer * NG * 128 * 512 + (size_t)g * 128 * 512;
    for (int e = tid; e < 128 * 64; e += 512) {
        const int row = e >> 6, ch = e & 63, pp = row & 63, i = ch >> 1, ci0 = (ch & 1) * 8;
        const float lr = lamp[((31 - i) * 64 + pp) * 2], li = lamp[((31 - i) * 64 + pp) * 2 + 1];
        float v[8];
#pragma unroll
        for (int q = 0; q < 8; ++q) { const float br = bbar[(pp * 16 + ci0 + q) * 2], bi = bbar[(pp * 16 + ci0 + q) * 2 + 1]; v[q] = row < 64 ? (lr * br - li * bi) : (lr * bi + li * br); }
        u32x4 w; w.x = cvt_pk_bf16(v[0], v[1]); w.y = cvt_pk_bf16(v[2], v[3]); w.z = cvt_pk_bf16(v[4], v[5]); w.w = cvt_pk_bf16(v[6], v[7]);
        *(u32x4*)(Sin + (size_t)row * 512 + ch * 8) = w;
    }
    __syncthreads();
}

__device__ void small_tables(const Ctx& c, const Params& p) {
    float* bt = (float*)(p.ws + WS_BIAS);
    const int stid = opaque_tid();
    for (int e = stid; e < 8 * 128; e += 512) {
        const int h = e >> 7, n = e & 127;
        int bk = n;
        if (n >= 16) { const int th[16] = {16, 19, 21, 24, 27, 31, 35, 40, 46, 52, 59, 67, 77, 87, 99, 113}; bk = 15;
#pragma unroll
            for (int q = 0; q < 16; ++q) bk += (n >= th[q]) ? 1 : 0; }
        bt[e] = (p.in[26][bk * 8 + h] - p.in[26][31 * 8 + h]) * LOG2E;
    }
    if (stid < 2) {
        const int j = stid; float s1 = 0.f, s2 = 0.f;
        for (int q = 0; q < 64; ++q) { s1 += p.in[20][j * 64 + q] * p.in[21][j * 64 + q]; s2 += p.in[22][j * 64 + q] * p.in[23][j * 64 + q]; }
        const float li = 0.8f - 0.6f * expf(-0.3f * (float)(j + 2));
        float* sc = (float*)(p.ws + WS_SCAL) + j * 4;
        sc[0] = expf(s1) - expf(s2) + li; sc[1] = 1.0f - li; sc[2] = 0.f; sc[3] = 0.f;
    }
}

__device__ void norm_phase(const Ctx& c, const void* xin_, int xin_f32, void* xout_, int xout_f32, const bf16_t* mix, const float* gpost, float* rsout) {
    const float* xin = (const float*)xin_; const bf16_t* xin16 = (const bf16_t*)xin_; float* xout = (float*)xout_; bf16_t* xout16 = (bf16_t*)xout_;
    const int tid_ = opaque_tid(), lane = tid_ & 63, wid_ = __builtin_amdgcn_readfirstlane(tid_ >> 6);
    for (int r0 = (wid_ * c.G + c.bx) * 4; r0 < TOK; r0 += 8 * c.G * 4) {
        f32x4 xv[4][4]; u32x4 xw[4][2]; u32x4 mw[4][2];
        if (xin_f32) {
#pragma unroll
            for (int rr = 0; rr < 4; ++rr)
#pragma unroll
                for (int k = 0; k < 2; ++k) { const float* xp = xin + (size_t)(r0 + rr) * DM + k * 512 + lane * 8; xv[rr][2 * k] = *(const f32x4*)xp; xv[rr][2 * k + 1] = *(const f32x4*)(xp + 4); }
        } else {
#pragma unroll
            for (int rr = 0; rr < 4; ++rr)
#pragma unroll
                for (int k = 0; k < 2; ++k) xw[rr][k] = *(const u32x4*)(xin16 + (size_t)(r0 + rr) * DM + k * 512 + lane * 8);
        }
        if (mix) {
#pragma unroll
            for (int rr = 0; rr < 4; ++rr)
#pragma unroll
                for (int k = 0; k < 2; ++k) mw[rr][k] = *(const u32x4*)(mix + (size_t)(r0 + rr) * DM + k * 512 + lane * 8);
        }
#pragma unroll
        for (int rr = 0; rr < 4; ++rr) {
            const int row = r0 + rr;
            float x[16];
            if (xin_f32) {
#pragma unroll
                for (int q = 0; q < 4; ++q)
#pragma unroll
                    for (int e = 0; e < 4; ++e) x[q * 4 + e] = xv[rr][q][e];
            } else {
#pragma unroll
                for (int k = 0; k < 2; ++k) { const u32x4 w = xw[rr][k];
                    x[k * 8 + 0] = bf_lo(w.x); x[k * 8 + 1] = bf_hi(w.x); x[k * 8 + 2] = bf_lo(w.y); x[k * 8 + 3] = bf_hi(w.y); x[k * 8 + 4] = bf_lo(w.z); x[k * 8 + 5] = bf_hi(w.z); x[k * 8 + 6] = bf_lo(w.w); x[k * 8 + 7] = bf_hi(w.w); }
            }
            if (mix) {
                float mv[16]; float ss = 0.f;
#pragma unroll
                for (int k = 0; k < 2; ++k) { const u32x4 w = mw[rr][k];
                    mv[k * 8 + 0] = bf_lo(w.x); mv[k * 8 + 1] = bf_hi(w.x); mv[k * 8 + 2] = bf_lo(w.y); mv[k * 8 + 3] = bf_hi(w.y); mv[k * 8 + 4] = bf_lo(w.z); mv[k * 8 + 5] = bf_hi(w.z); mv[k * 8 + 6] = bf_lo(w.w); mv[k * 8 + 7] = bf_hi(w.w); }
#pragma unroll
                for (int e = 0; e < 16; ++e) ss += mv[e] * mv[e];
                ss = wave_sum(ss);
                const float rs = rsqrtf(ss * (1.0f / DM) + EPS);
#pragma unroll
                for (int k = 0; k < 2; ++k) { const float* gp = gpost + k * 512 + lane * 8; const f32x4 ga = *(const f32x4*)gp, gb = *(const f32x4*)(gp + 4);
#pragma unroll
                    for (int e = 0; e < 4; ++e) { x[k * 8 + e] += mv[k * 8 + e] * rs * ga[e]; x[k * 8 + 4 + e] += mv[k * 8 + 4 + e] * rs * gb[e]; } }
            }
#pragma unroll
            for (int k = 0; k < 2; ++k) {
                if (xout_f32) { float* xo = xout + (size_t)row * DM + k * 512 + lane * 8;
                    *(f32x4*)xo = (f32x4){x[k * 8 + 0], x[k * 8 + 1], x[k * 8 + 2], x[k * 8 + 3]}; *(f32x4*)(xo + 4) = (f32x4){x[k * 8 + 4], x[k * 8 + 5], x[k * 8 + 6], x[k * 8 + 7]}; }
                else { u32x4 wx; wx.x = cvt_pk_bf16(x[k * 8 + 0], x[k * 8 + 1]); wx.y = cvt_pk_bf16(x[k * 8 + 2], x[k * 8 + 3]); wx.z = cvt_pk_bf16(x[k * 8 + 4], x[k * 8 + 5]); wx.w = cvt_pk_bf16(x[k * 8 + 6], x[k * 8 + 7]);
                    *(u32x4*)(xout16 + (size_t)row * DM + k * 512 + lane * 8) = wx;
                    x[k * 8 + 0] = bf_lo(wx.x); x[k * 8 + 1] = bf_hi(wx.x); x[k * 8 + 2] = bf_lo(wx.y); x[k * 8 + 3] = bf_hi(wx.y); x[k * 8 + 4] = bf_lo(wx.z); x[k * 8 + 5] = bf_hi(wx.z); x[k * 8 + 6] = bf_lo(wx.w); x[k * 8 + 7] = bf_hi(wx.w); }
            }
            if (rsout) {
                float ss = 0.f;
#pragma unroll
                for (int e = 0; e < 16; ++e) ss += x[e] * x[e];
                ss = wave_sum(ss);
                if (lane == 0) rsout[row] = rsqrtf(ss * (1.0f / DM) + EPS);
            }
        }
    }
}

__device__ void scan_phase(const Ctx& c, const Params& p, int layer) {
    const float* Z = (const float*)(p.ws + WS_Z); bf16_t* Ug = (bf16_t*)(p.ws + WS_UG);
    const float* lamL = (const float*)(p.ws + WS_LAML) + (size_t)layer * NG * NP * 2;
    const int tid_ = opaque_tid(), wid_ = __builtin_amdgcn_readfirstlane(tid_ >> 6);
    for (int pr = wid_ * c.G + c.bx; pr < 4 * NG; pr += 8 * c.G) {
        const int b = pr >> 6, g = pr & 63, pp = tid_ & 63;
        const float lr = lamL[(g * NP + pp) * 2], li = lamL[(g * NP + pp) * 2 + 1];
        float sr = 0.f, si = 0.f;
        const size_t row0 = (size_t)g * NCH + b * 256;
#pragma unroll 8
        for (int ch = 0; ch < 256; ++ch) {
            const float zr = Z[(row0 + ch) * 128 + pp], zi = Z[(row0 + ch) * 128 + 64 + pp];
            bf16_t* o = Ug + (row0 + ch) * UGP + 512 + pp;
            const unsigned w = cvt_pk_bf16(sr, si);
            o[0] = (bf16_t)(w & 0xffffu); o[64] = (bf16_t)(w >> 16);
            const float nr = lr * sr - li * si + zr, ni = lr * si + li * sr + zi; sr = nr; si = ni;
        }
    }
}

__device__ void scan_after_z(const Ctx& c, const Params& p, int layer) {
    asm volatile("s_waitcnt vmcnt(0)" ::: "memory"); __syncthreads();
    __builtin_amdgcn_fence(__ATOMIC_ACQUIRE, "agent");
    asm volatile("s_waitcnt vmcnt(0)" ::: "memory");
    const float* Z = (const float*)(p.ws + WS_Z); bf16_t* Ug = (bf16_t*)(p.ws + WS_UG);
    const float* lamL = (const float*)(p.ws + WS_LAML) + (size_t)layer * NG * NP * 2;
    const int tid_ = opaque_tid(), wid_ = __builtin_amdgcn_readfirstlane(tid_ >> 6), pp = tid_ & 63;
    for (int i = wid_; ; i += 8) {
        const int L = i * c.G + c.vc; if (L >= 4 * NG) break;
        const int g = L >> 2, b = L & 3;
        const float lr = lamL[(g * NP + pp) * 2], li = lamL[(g * NP + pp) * 2 + 1];
        float sr = 0.f, si = 0.f;
        const size_t row0 = (size_t)g * NCH + b * 256;
#pragma unroll 8
        for (int ch = 0; ch < 256; ++ch) {
            const float zr = Z[(row0 + ch) * 128 + pp], zi = Z[(row0 + ch) * 128 + 64 + pp];
            bf16_t* o = Ug + (row0 + ch) * UGP + 512 + pp;
            const unsigned w = cvt_pk_bf16(sr, si);
            o[0] = (bf16_t)(w & 0xffffu); o[64] = (bf16_t)(w >> 16);
            const float nr = lr * sr - li * si + zr, ni = lr * si + li * sr + zi; sr = nr; si = ni;
        }
    }
}

#define ATTN_DMA(gp, ldsoff) __builtin_amdgcn_global_load_lds((const unsigned*)(gp), (LAS unsigned*)(lds + (ldsoff)), 16, 0, 0)
#define ATTN_PV(PB, VBASE) do { \
    bf16x8 fa__[8], fb__[8]; \
    _Pragma("unroll") for (int q_ = 0; q_ < 8; ++q_) fa__[q_] = *(LAS const bf16x8*)((VBASE) + (q_ >> 2) * 4096 + vo[q_ & 3]); \
    __builtin_amdgcn_sched_barrier(0); \
    _Pragma("unroll") for (int q_ = 0; q_ < 8; ++q_) fb__[q_] = *(LAS const bf16x8*)((VBASE) + (2 + (q_ >> 2)) * 4096 + vo[q_ & 3]); \
    _Pragma("unroll") for (int q_ = 0; q_ < 8; ++q_) o[q_ & 1] = __builtin_amdgcn_mfma_f32_32x32x16_bf16(fa__[(q_ & 1) * 4 + (q_ >> 1)], PB[q_ >> 1], o[q_ & 1], 0, 0, 0); \
    __builtin_amdgcn_sched_barrier(0); \
    _Pragma("unroll") for (int q_ = 0; q_ < 8; ++q_) o[2 + (q_ & 1)] = __builtin_amdgcn_mfma_f32_32x32x16_bf16(fb__[(q_ & 1) * 4 + (q_ >> 1)], PB[q_ >> 1], o[2 + (q_ & 1)], 0, 0, 0); \
    __builtin_amdgcn_sched_barrier(0); } while (0)
#define ATTN_QK(P0, P1, KB) do { \
    bf16x8 kf_[4]; \
    _Pragma("unroll") for (int d0 = 0; d0 < 4; ++d0) kf_[d0] = *(LAS const bf16x8*)((KB) + ko[d0]); \
    __builtin_amdgcn_sched_barrier(0); \
    P0 = __builtin_amdgcn_mfma_f32_32x32x16_bf16(kf_[0], qf[0], negm, 0, 0, 0); \
    _Pragma("unroll") for (int d0 = 1; d0 < 4; ++d0) P0 = __builtin_amdgcn_mfma_f32_32x32x16_bf16(kf_[d0], qf[d0], P0, 0, 0, 0); \
    __builtin_amdgcn_sched_barrier(0); \
    _Pragma("unroll") for (int d0 = 0; d0 < 4; ++d0) kf_[d0] = *(LAS const bf16x8*)((KB) + 8192 + ko[d0]); \
    __builtin_amdgcn_sched_barrier(0); \
    P1 = __builtin_amdgcn_mfma_f32_32x32x16_bf16(kf_[0], qf[0], negm, 0, 0, 0); \
    _Pragma("unroll") for (int d0 = 1; d0 < 4; ++d0) P1 = __builtin_amdgcn_mfma_f32_32x32x16_bf16(kf_[d0], qf[d0], P1, 0, 0, 0); \
    __builtin_amdgcn_sched_barrier(0); } while (0)
#define ATTN_BAND(P0, P1, DD) do { \
    __builtin_amdgcn_sched_barrier(0); \
    _Pragma("unroll") for (int r = 0; r < 16; ++r) { const int d0_ = (DD) - (16 * (r >> 3) + (r & 7)); P0[r] += btab[1 + min(max(d0_, -1), 127)]; } \
    __builtin_amdgcn_sched_barrier(0); \
    _Pragma("unroll") for (int r = 0; r < 16; ++r) { const int d1_ = (DD) - 32 - (16 * (r >> 3) + (r & 7)); P1[r] += btab[1 + min(max(d1_, -1), 127)]; } \
    __builtin_amdgcn_sched_barrier(0); } while (0)
#define ATTN_EXP(P0, P1, PB) do { \
      \
    _Pragma("unroll") for (int r = 0; r < 16; ++r) { P0[r] = fexp2(P0[r]); P1[r] = fexp2(P1[r]); lrun += P0[r]; lrun += P1[r]; } \
    _Pragma("unroll") for (int q = 0; q < 2; ++q) { u32x4 w0_, w1_; \
        w0_.x = cvt_pk_bf16(P0[q * 8 + 0], P0[q * 8 + 1]); w0_.y = cvt_pk_bf16(P0[q * 8 + 2], P0[q * 8 + 3]); w0_.z = cvt_pk_bf16(P0[q * 8 + 4], P0[q * 8 + 5]); w0_.w = cvt_pk_bf16(P0[q * 8 + 6], P0[q * 8 + 7]); \
        w1_.x = cvt_pk_bf16(P1[q * 8 + 0], P1[q * 8 + 1]); w1_.y = cvt_pk_bf16(P1[q * 8 + 2], P1[q * 8 + 3]); w1_.z = cvt_pk_bf16(P1[q * 8 + 4], P1[q * 8 + 5]); w1_.w = cvt_pk_bf16(P1[q * 8 + 6], P1[q * 8 + 7]); \
        PB[q] = __builtin_bit_cast(bf16x8, w0_); PB[2 + q] = __builtin_bit_cast(bf16x8, w1_); } } while (0)
__device__ void attn_phase(const Ctx& c, const bf16_t* Q, const bf16_t* Kg, const bf16_t* Vt, bf16_t* ON, const float* biasT, const float* scal, const float* hn) {
    constexpr int SUB = 16384, STAGE = 32768, V_OFF = 65536, BT_OFF = 131072 + 128;
    LAS unsigned char* lds = c.lds;
    LAS unsigned char* ldsr = lds; asm volatile("" : "+s"(ldsr) :: "memory");
    for (int itu = 0; ; ++itu) {
        const int L = itu * c.G + c.vc; if (L >= 2048) break;
        const int tid = opaque_tid(), lane = tid & 63, wid = __builtin_amdgcn_readfirstlane(tid >> 6), br = wid >> 2, wq = wid & 3, l31 = lane & 31, hi = lane >> 5;
        const int prow = (l31 & ~12) | ((l31 & 4) << 1) | ((l31 & 8) >> 1);
        const int kbase = prow * 256, kx0 = (br * 8 + hi) ^ (prow & 15);
        const int vbase = V_OFF + l31 * 128, vx0 = hi ^ ((l31 >> 1) & 7);
        int ko[4], vo[4];
#pragma unroll
        for (int q = 0; q < 4; ++q) { ko[q] = (kx0 ^ (q << 1)) << 4; vo[q] = (vx0 ^ (q << 1)) << 4; }
        const int kr0 = 4 * wid + (lane >> 4), kc = (lane & 15) ^ (kr0 & 15);
        const int vr0 = 8 * wid + (lane >> 3), vcx = (lane & 7) ^ ((vr0 >> 1) & 7);
        const int dst0 = wid * 1024, dst1 = (wid + 8) * 1024;
        LAS const float* btab = (LAS const float*)(lds + BT_OFF);
        const int i7 = 7 - (L >> 8), pair = (L & 255) >> 3, jj8 = L & 7;
        const int qb = (i7 & 1) ? (16 * (i7 >> 1) + 15 - jj8) : (16 * (i7 >> 1) + jj8);
        const int b = pair >> 3, h = pair & 7, q0 = qb * 128, NI = qb + 1;
        const size_t tokb = (size_t)b * SEQ;
        const bf16_t* kg = Kg + (tokb + kr0) * DM + h * 128 + kc * 8;
        const bf16_t* vg = Vt + ((size_t)((b * 8 + h) * 128) << 13) + vr0 * 64 + vcx * 8;
        const bf16_t* qp = Q + (tokb + q0 + wq * 32 + l31) * DM + h * 128 + br * 64 + hi * 8;
        bf16x8 qf[4];
#pragma unroll
        for (int d0 = 0; d0 < 4; ++d0) qf[d0] = *(const bf16x8*)(qp + d0 * 16);
        if (tid < 128) ((LAS float*)(lds + BT_OFF))[1 + tid] = biasT[h * 128 + tid];
        if (tid == 128) ((LAS float*)(lds + BT_OFF))[0] = -1e30f;
#pragma unroll
        for (int sb = 0; sb < 2; ++sb) {
            ATTN_DMA(kg + (size_t)sb * 64 * DM, sb * SUB + dst0); ATTN_DMA(kg + (size_t)(sb * 64 + 32) * DM, sb * SUB + dst1);
            ATTN_DMA(vg + (size_t)sb * 8192, V_OFF + sb * SUB + dst0); ATTN_DMA(vg + (size_t)sb * 8192 + 4096, V_OFF + sb * SUB + dst1);
        }
        f32x16 o[4], negm;
#pragma unroll
        for (int r = 0; r < 16; ++r) { o[0][r] = 0.f; o[1][r] = 0.f; o[2][r] = 0.f; o[3][r] = 0.f; negm[r] = 0.f; }
        float lrun = 0.f;
        const int qrow = q0 + wq * 32 + l31;
        for (int it = 0; it < NI; ++it) {
            const int st = it & 1, kt0 = it * 128;
            asm volatile("s_waitcnt vmcnt(0) lgkmcnt(0)\n\ts_barrier" ::: "memory");
            if (it + 1 < NI) { const int s2 = (st ^ 1) * STAGE;
#pragma unroll
                for (int sb = 0; sb < 2; ++sb) { const bf16_t* kn = kg + (size_t)(kt0 + 128 + sb * 64) * DM; const bf16_t* vn = vg + (size_t)((it + 1) * 2 + sb) * 8192;
                    ATTN_DMA(kn, s2 + sb * SUB + dst0); ATTN_DMA(kn + 32 * DM, s2 + sb * SUB + dst1);
                    ATTN_DMA(vn, V_OFF + s2 + sb * SUB + dst0); ATTN_DMA(vn + 4096, V_OFF + s2 + sb * SUB + dst1); } }
            LAS const unsigned char* kbp = ldsr + st * STAGE + kbase;
            LAS const unsigned char* vbp = ldsr + st * STAGE + vbase;
#pragma unroll
            for (int sb = 0; sb < 2; ++sb) {
                f32x16 pa0, pa1;
                ATTN_QK(pa0, pa1, kbp + sb * SUB);
                if (it >= NI - 2) { const int dd = qrow - kt0 - sb * 64 - 8 * hi; ATTN_BAND(pa0, pa1, dd); }
                float mxa = max3f(pa0[0], pa0[1], pa1[0]), mxb = max3f(pa0[2], pa0[3], pa1[1]); mxa = max3f(mxa, pa1[2], pa1[3]);
#pragma unroll
                for (int r = 4; r < 16; r += 4) { mxa = max3f(mxa, pa0[r], pa0[r + 1]); mxb = max3f(mxb, pa0[r + 2], pa0[r + 3]); mxa = max3f(mxa, pa1[r], pa1[r + 1]); mxb = max3f(mxb, pa1[r + 2], pa1[r + 3]); }
                float mx = max2f(mxa, mxb);
                { const auto rr_ = __builtin_amdgcn_permlane32_swap(__float_as_uint(mx), __float_as_uint(mx), false, false); mx = max2f(__uint_as_float(rr_[0]), __uint_as_float(rr_[1])); }
                if ((it == 0 && sb == 0) || __any(mx > 8.0f)) {
                    const float delta = (it == 0 && sb == 0) ? mx : fmaxf(mx, 0.f), alpha = fexp2(-delta); lrun *= alpha;
#pragma unroll
                    for (int r = 0; r < 16; ++r) { pa0[r] -= delta; pa1[r] -= delta; negm[r] -= delta; }
#pragma unroll
                    for (int q = 0; q < 4; ++q) o[q] = o[q] * alpha;
                }
                bf16x8 pk[4];
                ATTN_EXP(pa0, pa1, pk);
                ATTN_PV(pk, vbp + sb * SUB);
            }
        }
        __syncthreads();
        const int te = opaque_tid(), le31 = te & 31, hie = (te & 63) >> 5, wide = __builtin_amdgcn_readfirstlane(te >> 6), wqe = wide & 3;
        const float lam = scal[0], onem = scal[1];
        float inv = frcp(lrun + __shfl_xor(lrun, 32));
        if (wide >= 4) inv *= lam;
        LAS float* comb = (LAS float*)lds;
        if (wide >= 4) {
#pragma unroll
            for (int blk = 0; blk < 4; ++blk)
#pragma unroll
                for (int r = 0; r < 16; ++r) comb[(wqe * 128 + blk * 32 + (r & 3) + 8 * (r >> 2) + 4 * hie) * 32 + le31] = o[blk][r] * inv;
        }
        __syncthreads();
        if (wide < 4) {
            float ss = 0.f;
#pragma unroll
            for (int blk = 0; blk < 4; ++blk)
#pragma unroll
                for (int r = 0; r < 16; ++r) { const float v = o[blk][r] * inv - comb[(wqe * 128 + blk * 32 + (r & 3) + 8 * (r >> 2) + 4 * hie) * 32 + le31]; o[blk][r] = v; ss += v * v; }
            ss += __shfl_xor(ss, 32);
            const float rs = rsqrtf(ss * (1.0f / 128.0f) + EPS) * onem;
            bf16_t* op = ON + ((size_t)b * SEQ + q0 + wqe * 32 + le31) * DM + h * 128;
#pragma unroll
            for (int blk = 0; blk < 4; ++blk)
#pragma unroll
                for (int r4 = 0; r4 < 4; ++r4) { const int dv = blk * 32 + 8 * r4 + 4 * hie; const f32x4 g4 = *(const f32x4*)(hn + dv);
                    u32x2 w; w.x = cvt_pk_bf16(o[blk][r4 * 4 + 0] * rs * g4[0], o[blk][r4 * 4 + 1] * rs * g4[1]); w.y = cvt_pk_bf16(o[blk][r4 * 4 + 2] * rs * g4[2], o[blk][r4 * 4 + 3] * rs * g4[3]);
                    *(u32x2*)(op + dv) = w; }
        }
        __syncthreads();
    }
}
#undef ATTN_PV
#undef ATTN_QK
#undef ATTN_BAND
#undef ATTN_EXP
#undef ATTN_DMA

__global__ void __launch_bounds__(512, 2) yoco_fwd(Params p) {
    extern __shared__ __attribute__((aligned(16))) unsigned char lds_raw[];
    cg::grid_group grid = cg::this_grid();
    Ctx c; c.lds = (LAS unsigned char*)lds_raw; c.tid = threadIdx.x; c.lane = c.tid & 63; c.wid = __builtin_amdgcn_readfirstlane(c.tid >> 6);
    c.G = gridDim.x; c.bx = blockIdx.x; c.vc = (c.G % 8 == 0) ? (c.bx % 8) * (c.G / 8) + c.bx / 8 : c.bx;
    unsigned char* ws = p.ws;
    float* X = p.out;
    { volatile LAS unsigned* xst0 = (volatile LAS unsigned*)(c.lds + 131072); if (c.tid < 4) xst0[c.tid] = 0u; }
    __syncthreads();
    (void)xcd_barrier_post((unsigned*)(ws + WS_BAR), (volatile LAS unsigned*)(c.lds + 131072));
    bf16_t* HM = (bf16_t*)(ws + WS_HM); bf16_t* ACT = (bf16_t*)(ws + WS_ACT);
    bf16_t* UG = (bf16_t*)(ws + WS_UG); float* Zb = (float*)(ws + WS_Z); bf16_t* YG = (bf16_t*)(ws + WS_YG);
    bf16_t* Qb = (bf16_t*)(ws + WS_Q); bf16_t* ONb = (bf16_t*)(ws + WS_ON); bf16_t* HKV = (bf16_t*)(ws + WS_HKV);
    bf16_t* Kb = (bf16_t*)(ws + WS_K); bf16_t* Vtb = (bf16_t*)(ws + WS_VT);

    enum { K_PRO = 0, K_WIN = 1, K_Z = 2, K_SCAN = 3, K_Y = 4, K_GLU = 5, K_NORMA = 6, K_UP = 7, K_DOWN = 8, K_NORMB = 9, K_K = 10, K_VT = 11, K_Q = 12, K_ATTN = 13, K_O = 14 };
    for (int ph = 0; ph < 35; ++ph) {
        int kind, layer;
        if (ph == 0) { kind = K_PRO; layer = 0; }
        else if (ph < 19) { layer = (ph - 1) / 9; kind = 1 + (ph - 1) % 9; }
        else { int k; if (ph < 28) { layer = 2; k = ph - 19; } else { layer = 3; k = ph - 26; }
            kind = k < 3 ? K_K + k : (k == 3 ? K_ATTN : (k == 4 ? K_O : K_NORMA + (k - 5))); }
        const int j = layer & 1;
        if (kind == K_SCAN) continue;
        for (int rep = 0; rep < (((REPEAT_MASK >> kind) & 1) ? 2 : 1); ++rep) {
        { int t_ = threadIdx.x; asm volatile("" : "+v"(t_)); c.tid = t_; c.lane = t_ & 63; c.wid = __builtin_amdgcn_readfirstlane(t_ >> 6); }
        const bool is_gemm = (kind == K_WIN) | (kind == K_Z) | (kind == K_Y) | (kind == K_GLU) | (kind == K_UP) | (kind == K_DOWN) | (kind == K_K) | (kind == K_VT) | (kind == K_Q) | (kind == K_O);
        if (is_gemm) {
            pg8::Job jb; jb.lda = DM; jb.ldb = DM; jb.K = DM; jb.ord = pg8::ORD_STATIC; jb.M = TOK; jb.N = DM; jb.epi = pg8::EPI_STORE; jb.ldc = DM; jb.scale = 1.0f; jb.O = HM; jb.x1 = nullptr; jb.x2 = nullptr; jb.A = HM; jb.Bt = nullptr;
            const bf16_t* X16 = (const bf16_t*)X; const float* RS = (const float*)(ws + WS_RS);
            switch (kind) {
            case K_WIN: jb.A = X16; jb.x2 = RS; jb.Bt = (const bf16_t*)(ws + WS_WIN) + (size_t)j * DM * DM; jb.epi = pg8::EPI_UG; jb.O = UG; break;
            case K_Z: jb.A = UG; jb.Bt = (const bf16_t*)(ws + WS_SIN) + (size_t)j * NG * 128 * 512; jb.lda = UGP; jb.ldb = 512; jb.K = 512; jb.ord = pg8::ORD_Z; jb.epi = pg8::EPI_Z; jb.O = Zb; break;
            case K_Y: jb.A = UG; jb.Bt = (const bf16_t*)(ws + WS_TM) + (size_t)j * NG * 512 * UGP; jb.lda = UGP; jb.ldb = UGP; jb.K = UGP; jb.ord = pg8::ORD_Y; jb.epi = pg8::EPI_Y; jb.O = YG; jb.x1 = UG; jb.x2 = p.in[15] + (size_t)j * DM; break;
            case K_GLU: jb.A = YG; jb.Bt = (const bf16_t*)(ws + WS_GLU) + (size_t)j * DM * 2 * DM; jb.N = 2 * DM; jb.epi = pg8::EPI_GLU; break;
            case K_UP: jb.A = layer == 3 ? (const bf16_t*)Kb : X16; jb.x2 = RS; jb.Bt = (const bf16_t*)(ws + (layer < 2 ? WS_UP01 : WS_UP23)) + (size_t)j * DM * FF; jb.N = FF; jb.epi = pg8::EPI_RELU2; jb.O = ACT; jb.ldc = FF; break;
            case K_DOWN: jb.A = ACT; jb.Bt = (const bf16_t*)(ws + (layer < 2 ? WS_DN01 : WS_DN23)) + (size_t)j * DM * FF; jb.lda = FF; jb.ldb = FF; jb.K = FF; break;
            case K_K: jb.A = X16; jb.x2 = RS; jb.Bt = (const bf16_t*)(ws + WS_KVW); jb.O = Kb; break;
            case K_VT: jb.A = (const bf16_t*)(ws + WS_KVW) + (size_t)DM * DM; jb.Bt = X16; jb.x2 = RS; jb.M = DM; jb.N = TOK; jb.O = Vtb; jb.epi = pg8::EPI_VT; break;
            case K_Q: jb.A = X16; jb.x2 = RS; jb.Bt = (const bf16_t*)(ws + WS_QW) + (size_t)j * DM * DM; jb.O = Qb; jb.scale = 0.125f * LOG2E; break;
            default:   jb.A = ONb; jb.Bt = (const bf16_t*)(ws + WS_OW) + (size_t)j * DM * DM; break;
            }
#ifndef NO_GEMM
            pg8::gemm_phase(c.lds, jb, c.G, c.bx, c.vc, c.tid);
#endif
            if (kind == K_Z) scan_after_z(c, p, j);
        } else if (kind == K_NORMA || kind == K_NORMB || kind == K_PRO) {
            if (kind == K_PRO) {
#ifndef NO_TAB
                for (int u = c.bx; u < 2 * NG; u += c.G) ssm_tables(c, p, u >> 6, u & 63);
#endif
                if (c.bx == c.G - 1) small_tables(c, p);
#ifndef NO_CONV
                convert_weights(c, p);
#endif
            }
            const void* xin = X; void* xout = X; int xin_f32 = 0, xout_f32 = 0; const bf16_t* mix = HM; const float* gpost = nullptr; float* rsout = (float*)(ws + WS_RS);
            if (kind == K_PRO) { xin = p.in[0]; xin_f32 = 1; mix = nullptr; }
            else if (kind == K_NORMA) { if (layer == 3) xout = Kb; gpost = p.in[2] + layer * DM; }
            else { gpost = p.in[4] + layer * DM; if (layer == 3) { xin = Kb; xout_f32 = 1; rsout = nullptr; } }
#ifndef NO_NORM
            norm_phase(c, xin, xin_f32, xout, xout_f32, mix, gpost, rsout);
#endif
        } else if (kind == K_SCAN) {
#ifndef NO_SCAN
            scan_phase(c, p, j);
#endif
        } else {
#ifndef NO_ATTN
            attn_phase(c, Qb, Kb, Vtb, ONb, (const float*)(ws + WS_BIAS), (const float*)(ws + WS_SCAL) + j * 4, p.in[24] + j * 128);
#endif
        }
        }
        if (!(kind == K_K || kind == K_VT || ph == 34)) { if (ph == 0 && c.G > 0x40000000) grid.sync(); else { XcdBarrier xb_; xb_.bar = (unsigned*)(ws + WS_BAR); xb_.x = xb_xcc_id(); xb_.st = (volatile LAS unsigned*)(c.lds + 131072); xcd_barrier(xb_); } }
    }
}

extern "C" void kernel_launch(void* const* d_in, const int* in_sizes, int n_in, void* d_out, int out_size, void* d_ws, size_t ws_size, hipStream_t stream) {
    static int grid_blocks = 0;
    if (grid_blocks == 0) {
        if (n_in != 27 || out_size != TOK * DM || ws_size < WS_END) { fprintf(stderr, "kernel_launch: unexpected shapes (n_in %d, out %d, ws %zu)\n", n_in, out_size, ws_size); grid_blocks = -1; return; }
        int dev = 0, cus = 0, per_cu = 0;
        hipGetDevice(&dev);
        hipDeviceGetAttribute(&cus, hipDeviceAttributeMultiprocessorCount, dev);
        if (hipFuncSetAttribute((const void*)yoco_fwd, hipFuncAttributeMaxDynamicSharedMemorySize, LDS_BYTES) != hipSuccess) { fprintf(stderr, "kernel_launch: hipFuncSetAttribute failed\n"); grid_blocks = -1; return; }
        if (hipOccupancyMaxActiveBlocksPerMultiprocessor(&per_cu, (const void*)yoco_fwd, 512, LDS_BYTES) != hipSuccess || per_cu < 1) { fprintf(stderr, "kernel_launch: occupancy query says %d\n", per_cu); per_cu = 1; }
        (void)hipGetLastError();
        grid_blocks = cus * 1;
    }
    if (grid_blocks < 0) return;
    Params p{};
    for (int i = 0; i < 27; ++i) p.in[i] = (const float*)d_in[i];
    p.out = (float*)d_out; p.ws = (unsigned char*)d_ws;
    if (hipMemsetAsync((char*)d_ws + WS_BAR, 0, 16384, stream) != hipSuccess) { fprintf(stderr, "kernel_launch: memset of barrier words failed\n"); return; }
    void* args[] = {&p};
    hipError_t e = hipLaunchCooperativeKernel((const void*)yoco_fwd, dim3(grid_blocks), dim3(512), args, LDS_BYTES, stream);
    if (e != hipSuccess) fprintf(stderr, "cooperative launch failed: %s (grid %d)\n", hipGetErrorString(e), grid_blocks);
}
```

```cpp
#include <hip/hip_runtime.h>
#include <hip/hip_cooperative_groups.h>
#include <cstdio>
#include <cstdint>
namespace cg = cooperative_groups;

#define LAS __attribute__((address_space(3)))
typedef unsigned short bf16_t;
typedef short bf16x8 __attribute__((ext_vector_type(8)));
typedef float f32x4 __attribute__((ext_vector_type(4)));
typedef float f32x16 __attribute__((ext_vector_type(16)));
typedef unsigned u32x4 __attribute__((ext_vector_type(4)));
typedef unsigned u32x2 __attribute__((ext_vector_type(2)));

constexpr int TOK = 32768, DM = 1024, FF = 4096, SEQ = 8192;
constexpr int NG = 64, GS = 16, NP = 64;
constexpr int CL = 32;
constexpr int NCH = TOK / CL;
constexpr int UGP = CL * GS + 2 * NP;
constexpr float EPS = 1e-6f;
constexpr float LOG2E = 1.4426950408889634f;

constexpr size_t MiB = 1u << 20;
constexpr size_t WS_BIAS = 0;
constexpr size_t WS_SCAL = 4096;
constexpr size_t WS_LAML = 8192;
constexpr size_t WS_RS = 786432;
constexpr size_t WS_BAR = 131072;
constexpr size_t WS_UP23 = 1 * MiB;
constexpr size_t WS_DN23 = 17 * MiB;
constexpr size_t WS_KVW = 33 * MiB;
constexpr size_t WS_QW = 37 * MiB;
constexpr size_t WS_OW = 41 * MiB;
constexpr size_t WS_UP01 = 45 * MiB;
constexpr size_t WS_DN01 = 61 * MiB;
constexpr size_t WS_WIN = 77 * MiB;
constexpr size_t WS_GLU = 81 * MiB;
constexpr size_t WS_TM = 89 * MiB;
constexpr size_t WS_SIN = 169 * MiB;
constexpr size_t WS_K = 45 * MiB;
constexpr size_t WS_VT = 109 * MiB;
constexpr size_t WS_HM = 186 * MiB;
constexpr size_t WS_ACT = 250 * MiB;
constexpr size_t WS_UG = WS_ACT;
constexpr size_t WS_Z = WS_ACT + 80 * MiB;
constexpr size_t WS_YG = WS_ACT + 112 * MiB;
constexpr size_t WS_Q = WS_ACT;
constexpr size_t WS_ON = WS_ACT + 64 * MiB;
constexpr size_t WS_HKV = WS_ACT + 128 * MiB;
constexpr size_t WS_END = 506 * MiB;

constexpr int LDS_BYTES = 147456;
#ifndef REPEAT_MASK
#define REPEAT_MASK 0
#endif

__device__ __forceinline__ unsigned cvt_pk_bf16(float lo, float hi) { unsigned r; asm("v_cvt_pk_bf16_f32 %0, %1, %2" : "=v"(r) : "v"(lo), "v"(hi)); return r; }
__device__ __forceinline__ float bf_lo(unsigned w) { return __uint_as_float(w << 16); }
__device__ __forceinline__ float bf_hi(unsigned w) { return __uint_as_float(w & 0xffff0000u); }
__device__ __forceinline__ float fexp2(float x) { return __builtin_amdgcn_exp2f(x); }
__device__ __forceinline__ float frcp(float x) { return __builtin_amdgcn_rcpf(x); }
__device__ __forceinline__ float max3f(float a, float b, float c) { float r; asm("v_max3_f32 %0, %1, %2, %3" : "=v"(r) : "v"(a), "v"(b), "v"(c)); return r; }
__device__ __forceinline__ float max2f(float a, float b) { float r; asm("v_max_f32_e32 %0, %1, %2" : "=v"(r) : "v"(a), "v"(b)); return r; }
__device__ __forceinline__ int opaque_tid() { int t_ = threadIdx.x; asm volatile("" : "+v"(t_)); return t_; }
__device__ __forceinline__ float wave_sum(float v) {
#pragma unroll
    for (int o = 32; o >= 1; o >>= 1) v += __shfl_xor(v, o);
    return v;
}
__device__ __forceinline__ float gelu_tanh(float y) {
    const float t = y * (1.5957691216057308f + 0.07135481627f * y * y);
    return y * frcp(1.0f + fexp2(-t * LOG2E));
}

namespace pg8 {
constexpr int BM = 256, BK = 64, HALF = 128, HTB = HALF * BK * 2, STAGE_BYTES = 8 * HTB;
__host__ __device__ __forceinline__ int lds_byte(int r, int c) { const int st = (r >> 4) * 2 + (c >> 5), rr = r & 15, cc = c & 31, ob = rr * 64 + cc * 2; return st * 1024 + (ob ^ (((ob >> 9) & 1) << 5)); }
__host__ __device__ __forceinline__ void stage_rc(int b, int& R, int& C) { const int st = b / 1024, sb = b % 1024, swz = sb ^ (((sb >> 9) & 1) << 5); R = (st >> 1) * 16 + swz / 64; C = (st & 1) * 32 + (swz % 64) / 2; }
__host__ __device__ __forceinline__ int perm32(int rho) { const int n = rho >> 4, i = rho & 15; return 8 * (i >> 2) + 4 * n + (i & 3); }

struct Unit { int pm, pn, arow, brow; };
enum { ORD_STATIC = 0, ORD_Z = 1, ORD_Y = 2 };
enum { EPI_STORE = 0, EPI_RELU2 = 1, EPI_GLU = 2, EPI_UG = 3, EPI_Z = 4, EPI_Y = 5, EPI_VT = 6 };
struct Job { const bf16_t* A; const bf16_t* Bt; int lda, ldb, K, ord, M, N, epi, ldc; float scale; void* O; const void* x1; const void* x2; };

__device__ __forceinline__ bool next_unit(const Job& jb, int G, int bx, int vc, int i, Unit& u) {
    if (jb.ord == ORD_STATIC) {
        const int nM = jb.M / BM, nN = jb.N / BM, nwg = nM * nN;
        const long L = (long)i * G + bx; if (L >= nwg) return false;
        int wgid = (int)L; { const int q = nwg / 8, r = nwg % 8, xcd = wgid % 8, off = wgid / 8; wgid = (xcd < r ? xcd * (q + 1) : r * (q + 1) + (xcd - r) * q) + off; }
        const int nig = 8 * nN, gid = wgid / nig, fm = gid * 8, gsz = (nM - fm) < 8 ? (nM - fm) : 8;
        u.pm = fm + ((wgid % nig) % gsz); u.pn = (wgid % nig) / gsz; u.arow = u.pm * BM; u.brow = u.pn * BM; return true;
    } else if (jb.ord == ORD_Z) {
        const int L = i * G + vc; if (L >= NG * 4) return false; u.pm = L; u.pn = 0; u.arow = L * BM; u.brow = (L >> 2) * 128; return true;
    } else {
        const int L = i * G + vc; if (L >= NG * 8) return false; const int g = L >> 3, r = L & 7; u.pm = g * 4 + (r >> 1); u.pn = g * 2 + (r & 1); u.arow = u.pm * BM; u.brow = u.pn * BM; return true;
    }
}

typedef f32x4 Acc[2][2][4][2];
__device__ __forceinline__ u32x4 pack8(const f32x4 v0, const f32x4 v1) { u32x4 w; w.x = cvt_pk_bf16(v0[0], v0[1]); w.y = cvt_pk_bf16(v0[2], v0[3]); w.z = cvt_pk_bf16(v1[0], v1[1]); w.w = cvt_pk_bf16(v1[2], v1[3]); return w; }

__device__ __forceinline__ void epilogue(const Job& jb, const Acc& acc, const Unit& u) {
    int t_ = threadIdx.x; asm volatile("" : "+v"(t_));
    const int wid_ = __builtin_amdgcn_readfirstlane(t_ >> 6), wr = wid_ >> 2, wc = wid_ & 3, fr = t_ & 15, fq = (t_ & 63) >> 4;
    const int row0 = u.pm * BM + wr * 64 + fr;
#ifdef EPI_MASK
    const int epi_ = ((1 << jb.epi) & EPI_MASK) ? jb.epi : 0;
#else
    const int epi_ = jb.epi;
#endif
    if (epi_ == EPI_STORE || epi_ == EPI_RELU2) {
        bf16_t* O = (bf16_t*)jb.O; const int col0 = u.pn * BM + wc * 32 + 8 * fq; const bool r2 = epi_ == EPI_RELU2; const float scale = jb.scale; const float* rsc = (const float*)jb.x2;
#pragma unroll
        for (int ai = 0; ai < 2; ++ai)
#pragma unroll
            for (int m = 0; m < 4; ++m) { bf16_t* rowp = O + (size_t)(row0 + ai * HALF + m * 16) * jb.ldc + col0;
                float rsv = 1.0f; if (rsc) { rsv = rsc[row0 + ai * HALF + m * 16]; if (r2) rsv = rsv * rsv; }
                const float sc_ = scale * rsv;
#pragma unroll
                for (int bj = 0; bj < 2; ++bj) { f32x4 v0 = acc[ai][bj][m][0], v1 = acc[ai][bj][m][1];
                    if (r2) {
#pragma unroll
                        for (int e = 0; e < 4; ++e) { const float a = fmaxf(v0[e], 0.f), b = fmaxf(v1[e], 0.f); v0[e] = a * a; v1[e] = b * b; } }
                    v0 = v0 * sc_; v1 = v1 * sc_;
                    *(u32x4*)(rowp + bj * HALF) = pack8(v0, v1); } }
    } else if (epi_ == EPI_GLU) {
        bf16_t* O = (bf16_t*)jb.O; const int col0 = u.pn * HALF + wc * 32 + 8 * fq;
#pragma unroll
        for (int ai = 0; ai < 2; ++ai)
#pragma unroll
            for (int m = 0; m < 4; ++m) { bf16_t* rowp = O + (size_t)(row0 + ai * HALF + m * 16) * DM + col0;
                f32x4 o0, o1;
#pragma unroll
                for (int e = 0; e < 4; ++e) { o0[e] = acc[ai][0][m][0][e] * frcp(1.0f + fexp2(-acc[ai][1][m][0][e] * LOG2E)); o1[e] = acc[ai][0][m][1][e] * frcp(1.0f + fexp2(-acc[ai][1][m][1][e] * LOG2E)); }
                *(u32x4*)rowp = pack8(o0, o1); }
    } else if (epi_ == EPI_UG) {
        bf16_t* Ug = (bf16_t*)jb.O; const float* rsc = (const float*)jb.x2;
#pragma unroll
        for (int ai = 0; ai < 2; ++ai)
#pragma unroll
            for (int m = 0; m < 4; ++m) { const int tok = row0 + ai * HALF + m * 16; const float rsv = rsc[tok];
#pragma unroll
                for (int bj = 0; bj < 2; ++bj) { const int g = u.pn * 16 + bj * 8 + wc * 2 + (fq >> 1);
                    *(u32x4*)(Ug + ((size_t)(g * NCH + (tok >> 5)) * UGP + (tok & 31) * 16 + (fq & 1) * 8)) = pack8(acc[ai][bj][m][0] * rsv, acc[ai][bj][m][1] * rsv); } }
    } else if (epi_ == EPI_Z) {
        float* Z = (float*)jb.O; const int col0 = wc * 32 + 8 * fq;
#pragma unroll
        for (int ai = 0; ai < 2; ++ai)
#pragma unroll
            for (int m = 0; m < 4; ++m) { float* p = Z + (size_t)(row0 + ai * HALF + m * 16) * 128 + col0;
                *(f32x4*)p = acc[ai][0][m][0]; *(f32x4*)(p + 4) = acc[ai][0][m][1]; }
    } else if (epi_ == EPI_VT) {
        bf16_t* O = (bf16_t*)jb.O; const int col0 = u.pn * BM + wc * 32 + 8 * fq; const float* rsc = (const float*)jb.x2;
        const f32x4 ra0 = *(const f32x4*)(rsc + col0), rb0 = *(const f32x4*)(rsc + col0 + 4), ra1 = *(const f32x4*)(rsc + col0 + HALF), rb1 = *(const f32x4*)(rsc + col0 + HALF + 4);
#pragma unroll
        for (int ai = 0; ai < 2; ++ai)
#pragma unroll
            for (int m = 0; m < 4; ++m) { const int row = row0 + ai * HALF + m * 16;
#pragma unroll
                for (int bj = 0; bj < 2; ++bj) { const int col = col0 + bj * HALF;
                    const size_t off = ((size_t)(((col >> 13) * 8 + (row >> 7)) * 128 + ((col & 8191) >> 6)) << 13) + (row & 127) * 64 + (col & 63);
                    *(u32x4*)(O + off) = pack8(acc[ai][bj][m][0] * (bj ? ra1 : ra0), acc[ai][bj][m][1] * (bj ? rb1 : rb0)); } }
    } else {
        const bf16_t* Ug = (const bf16_t*)jb.x1; const float* dsk = (const float*)jb.x2; bf16_t* YG = (bf16_t*)jb.O;
        const int g = u.pm >> 2, n0 = (u.pm & 3) * BM + wr * 64 + fr, c0 = (u.pn & 1) * BM + wc * 32 + 8 * fq;
        const int co0 = (fq & 1) * 8;
        const f32x4 d0 = *(const f32x4*)(dsk + g * 16 + co0), d1 = *(const f32x4*)(dsk + g * 16 + co0 + 4);
#pragma unroll
        for (int ai = 0; ai < 2; ++ai)
#pragma unroll
            for (int m = 0; m < 4; ++m) { const int n = n0 + ai * HALF + m * 16;
#pragma unroll
                for (int bj = 0; bj < 2; ++bj) { const int cc = c0 + bj * HALF, j = cc >> 4;
                    const u32x4 uu = *(const u32x4*)(Ug + ((size_t)(g * NCH + n) * UGP + cc));
                    const f32x4 v0 = acc[ai][bj][m][0], v1 = acc[ai][bj][m][1];
                    f32x4 y0, y1;
                    y0[0] = v0[0] + d0[0] * bf_lo(uu.x); y0[1] = v0[1] + d0[1] * bf_hi(uu.x); y0[2] = v0[2] + d0[2] * bf_lo(uu.y); y0[3] = v0[3] + d0[3] * bf_hi(uu.y);
                    y1[0] = v1[0] + d1[0] * bf_lo(uu.z); y1[1] = v1[1] + d1[1] * bf_hi(uu.z); y1[2] = v1[2] + d1[2] * bf_lo(uu.w); y1[3] = v1[3] + d1[3] * bf_hi(uu.w);
#pragma unroll
                    for (int e = 0; e < 4; ++e) { y0[e] = gelu_tanh(y0[e]); y1[e] = gelu_tanh(y1[e]); }
                    *(u32x4*)(YG + ((size_t)(n * CL + j) * DM + g * 16 + co0)) = pack8(y0, y1); } }
    }
}

__device__ __forceinline__ void gemm_phase(LAS unsigned char* lds, const Job& g, const int G, const int bx, const int vc, const int tid_unused) {
    const int tid = opaque_tid(); (void)tid_unused;
    const int wid = __builtin_amdgcn_readfirstlane(tid >> 6), lane = tid & 63, wr = wid >> 2, wc = wid & 3, fr = lane & 15, fq = lane >> 4;
    const int K = g.K, nt = K / BK;
    unsigned voffA[2], voffB[2];
#pragma unroll
    for (int i = 0; i < 2; ++i) { int R, C; stage_rc(tid * 16 + i * 8192, R, C); const int Rb = (R & ~31) + perm32(R & 31);
        voffA[i] = (unsigned)(R * g.lda + C) * 2u; voffB[i] = (unsigned)(Rb * g.ldb + C) * 2u; }
    const size_t kstep = (size_t)(BK * 2);
    const size_t hstepA = (size_t)HALF * g.lda * 2, hstepB = (size_t)HALF * g.ldb * 2;
    const size_t rowA = (size_t)g.lda * 2, rowB = (size_t)g.ldb * 2;
    const unsigned ldsw = (unsigned)wid * 1024u;
    const int aoff = lds_byte(wr * 64 + fr, fq * 8), boff = lds_byte(wc * 32 + fr, fq * 8);
#define PG8_SA(b, h) (((b) * 2 + (h)) * HTB)
#define PG8_SB(b, h) ((4 + (b) * 2 + (h)) * HTB)
#define PG8_STAGE(bufoff, gbase, voff) do { _Pragma("unroll") for (int _i = 0; _i < 2; ++_i) \
        __builtin_amdgcn_global_load_lds((const unsigned*)((const char*)(gbase) + (voff)[_i]), (LAS unsigned*)(lds + (bufoff) + ldsw + _i * 8192), 16, 0, 0); } while (0)
#define PG8_LDA(dst, b, h) do { _Pragma("unroll") for (int m = 0; m < 4; ++m) _Pragma("unroll") for (int k = 0; k < 2; ++k) dst[m][k] = *(const LAS bf16x8*)(lds + PG8_SA(b, h) + aoff + m * 2048 + k * 1024); } while (0)
#define PG8_LDB(dst, b, h) do { _Pragma("unroll") for (int n = 0; n < 2; ++n) _Pragma("unroll") for (int k = 0; k < 2; ++k) dst[n][k] = *(const LAS bf16x8*)(lds + PG8_SB(b, h) + boff + n * 2048 + k * 1024); } while (0)
#define PG8_MMA(ai, bj, At, Bt) do { __builtin_amdgcn_s_setprio(1); _Pragma("unroll") for (int m = 0; m < 4; ++m) _Pragma("unroll") for (int n = 0; n < 2; ++n) _Pragma("unroll") for (int k = 0; k < 2; ++k) \
        acc[ai][bj][m][n] = __builtin_amdgcn_mfma_f32_16x16x32_bf16(Bt[n][k], At[m][k], acc[ai][bj][m][n], 0, 0, 0); __builtin_amdgcn_s_setprio(0); } while (0)
#define PG8_WAIT_V(n) asm volatile("s_waitcnt vmcnt(" #n ")" ::: "memory")
#define PG8_WAIT_L(n) asm volatile("s_waitcnt lgkmcnt(" #n ")" ::: "memory")
#define PG8_BAR __builtin_amdgcn_s_barrier()
#define PG8_SCHED __builtin_amdgcn_sched_barrier(0)
    Unit cur, nxt; int ui = 0;
    if (!next_unit(g, G, bx, vc, 0, cur)) return;
    Acc acc;
#pragma unroll
    for (int a = 0; a < 2; ++a)
#pragma unroll
        for (int b = 0; b < 2; ++b)
#pragma unroll
            for (int m = 0; m < 4; ++m)
#pragma unroll
                for (int n = 0; n < 2; ++n) acc[a][b][m][n] = (f32x4){0.f, 0.f, 0.f, 0.f};
    bf16x8 At[4][2], B0[2][2], B1[2][2];
    const char* cA = (const char*)g.A + (size_t)cur.arow * rowA; const char* cB = (const char*)g.Bt + (size_t)cur.brow * rowB;
    PG8_STAGE(PG8_SB(0, 0), cB, voffB); PG8_STAGE(PG8_SB(0, 1), cB + hstepB, voffB); PG8_STAGE(PG8_SA(0, 0), cA, voffA); PG8_STAGE(PG8_SA(0, 1), cA + hstepA, voffA);
    if (wr == 1) PG8_BAR;
    PG8_WAIT_V(2); PG8_BAR;
    PG8_STAGE(PG8_SB(1, 0), cB + kstep, voffB); PG8_STAGE(PG8_SA(1, 0), cA + kstep, voffA); PG8_STAGE(PG8_SB(1, 1), cB + hstepB + kstep, voffB);
    PG8_WAIT_V(6); PG8_BAR;
    for (;;) {
        const bool has_next = next_unit(g, G, bx, vc, ui + 1, nxt);
        const char* nA = has_next ? (const char*)g.A + (size_t)nxt.arow * rowA : cA; const char* nB = has_next ? (const char*)g.Bt + (size_t)nxt.brow * rowB : cB;
        for (int t = 0; t < nt; t += 2) {
            const bool last = (t == nt - 2);
            const char* a1 = cA + (size_t)(t + 1) * kstep;
            const char* a2 = last ? nA : cA + (size_t)(t + 2) * kstep; const char* b2 = last ? nB : cB + (size_t)(t + 2) * kstep;
            const char* a3 = a2 + kstep; const char* b3 = b2 + kstep;
            PG8_LDB(B0, 0, 0); PG8_LDB(B1, 0, 1); PG8_SCHED; PG8_LDA(At, 0, 0); PG8_STAGE(PG8_SA(1, 1), a1 + hstepA, voffA);
            PG8_WAIT_V(8); PG8_WAIT_L(0); PG8_BAR; PG8_MMA(0, 0, At, B0); PG8_MMA(0, 1, At, B1); PG8_BAR; PG8_SCHED;
            PG8_LDA(At, 0, 1); PG8_STAGE(PG8_SB(0, 0), b2, voffB); PG8_STAGE(PG8_SB(0, 1), b2 + hstepB, voffB); PG8_STAGE(PG8_SA(0, 0), a2, voffA);
            PG8_WAIT_V(8); PG8_WAIT_L(0); PG8_BAR; PG8_MMA(1, 0, At, B0); PG8_MMA(1, 1, At, B1); PG8_BAR; PG8_SCHED;
            PG8_LDB(B0, 1, 0); PG8_LDB(B1, 1, 1); PG8_SCHED; PG8_LDA(At, 1, 0); PG8_STAGE(PG8_SA(0, 1), a2 + hstepA, voffA);
            PG8_WAIT_V(8); PG8_WAIT_L(0); PG8_BAR; PG8_MMA(0, 0, At, B0); PG8_MMA(0, 1, At, B1); PG8_BAR; PG8_SCHED;
            PG8_LDA(At, 1, 1); PG8_STAGE(PG8_SB(1, 0), b3, voffB); PG8_STAGE(PG8_SB(1, 1), b3 + hstepB, voffB); PG8_STAGE(PG8_SA(1, 0), a3, voffA);
            PG8_WAIT_V(8); PG8_WAIT_L(0); PG8_BAR; PG8_MMA(1, 0, At, B0); PG8_MMA(1, 1, At, B1); PG8_BAR; PG8_SCHED;
        }
        if (wr == 0) PG8_BAR;
        epilogue(g, acc, cur);
        if (!has_next) break;
#pragma unroll
        for (int a = 0; a < 2; ++a)
#pragma unroll
            for (int b = 0; b < 2; ++b)
#pragma unroll
                for (int m = 0; m < 4; ++m)
#pragma unroll
                    for (int n = 0; n < 2; ++n) acc[a][b][m][n] = (f32x4){0.f, 0.f, 0.f, 0.f};
        cur = nxt; cA = nA; cB = nB; ++ui;
        if (wr == 1) PG8_BAR;
    }
    PG8_WAIT_V(0);
    PG8_BAR;
#undef PG8_SA
#undef PG8_SB
#undef PG8_STAGE
#undef PG8_LDA
#undef PG8_LDB
#undef PG8_MMA
#undef PG8_WAIT_V
#undef PG8_WAIT_L
#undef PG8_BAR
#undef PG8_SCHED
}
}

#define XB_TMO      128
#define XB_XCNT(j)  (256  + 64 * (j))
#define XB_XSUB(j)  (1280 + 64 * (j))
#define XB_XGEN(j)  (2304 + 64 * (j))
#define XB_TOP      3328
#define XB_TOPGEN   3392
#define XCD_BAR_WORDS 3456
#define XB_SPIN_CAP (1u << 22)
__device__ __forceinline__ unsigned xb_ld(unsigned* p)              { return __hip_atomic_load(p, __ATOMIC_RELAXED, __HIP_MEMORY_SCOPE_AGENT); }
__device__ __forceinline__ unsigned xb_add(unsigned* p, unsigned v) { return __hip_atomic_fetch_add(p, v, __ATOMIC_RELAXED, __HIP_MEMORY_SCOPE_AGENT); }
__device__ __forceinline__ unsigned xb_xcc_id() { return (unsigned)__builtin_amdgcn_s_getreg((3 << 11) | 20) & 0xFu; }
#define XB_SPIN(cond, bar) do { unsigned _sp = 0; while (cond) { __builtin_amdgcn_s_sleep(1); \
    if ((++_sp & 255u) == 0u) { if (xb_ld(&(bar)[XB_TMO])) break; if (_sp > XB_SPIN_CAP) { atomicAdd(&(bar)[XB_TMO], 1u); break; } } } } while (0)
struct XcdBarrier { unsigned* bar; unsigned x; volatile LAS unsigned* st; };
__device__ __forceinline__ XcdBarrier xcd_barrier_post(unsigned* bar, volatile LAS unsigned* st) {
    XcdBarrier b; b.bar = bar; b.x = xb_xcc_id(); b.st = st;
    if (threadIdx.x == 0) (void)xb_add(&bar[XB_XCNT(b.x)], 1u);
    return b;
}
__device__ __forceinline__ void xcd_barrier_complete(unsigned* bar, unsigned x, unsigned& nloc, unsigned& nx) {
    const unsigned G = gridDim.x * gridDim.y * gridDim.z;
    unsigned sum, cnt, mine, sp = 0u;
    for (;;) {
        sum = 0u; cnt = 0u; mine = 0u;
#pragma unroll
        for (unsigned j = 0; j < 16; ++j) { const unsigned c = xb_ld(&bar[XB_XCNT(j)]); sum += c; cnt += (c > 0u) ? 1u : 0u; mine = (j == x) ? c : mine; }
        if (sum == G) break;
        __builtin_amdgcn_s_sleep(1);
        if ((++sp & 255u) == 0u) { if (xb_ld(&bar[XB_TMO])) break; if (sp > XB_SPIN_CAP) { atomicAdd(&bar[XB_TMO], 1u); break; } }
    }
    nloc = mine > 0u ? mine : 1u; nx = cnt > 0u ? cnt : 1u;
}
__device__ __forceinline__ void xcd_barrier(const XcdBarrier& b) {
    asm volatile("s_waitcnt vmcnt(0)" ::: "memory");
    __syncthreads();
    if (threadIdx.x == 0) {
        unsigned* bar = b.bar;
        __builtin_amdgcn_s_waitcnt(0);
        unsigned nloc = b.st[0], nx = b.st[1];
        if (nloc == 0u) { xcd_barrier_complete(bar, b.x, nloc, nx); b.st[0] = nloc; b.st[1] = nx; }
        const unsigned old = xb_add(&bar[XB_XSUB(b.x)], 1u);
        const unsigned gen = old / nloc;
        if (old + 1u == (gen + 1u) * nloc) {
            __builtin_amdgcn_fence(__ATOMIC_RELEASE, "agent");
            asm volatile("s_waitcnt vmcnt(0)" ::: "memory");
            const unsigned og = xb_add(&bar[XB_TOP], 1u);
            const unsigned tg = og / nx;
            if (og + 1u == (tg + 1u) * nx) xb_add(&bar[XB_TOPGEN], 1u);
            else XB_SPIN(xb_ld(&bar[XB_TOPGEN]) == tg, bar);
            __builtin_amdgcn_fence(__ATOMIC_ACQUIRE, "agent");
            xb_add(&bar[XB_XGEN(b.x)], 1u);
            asm volatile("s_waitcnt vmcnt(0)" ::: "memory");
        } else {
            XB_SPIN(xb_ld(&bar[XB_XGEN(b.x)]) == gen, bar);
            __builtin_amdgcn_fence(__ATOMIC_ACQUIRE, "agent");
            asm volatile("s_waitcnt vmcnt(0)" ::: "memory");
        }
    }
    __syncthreads();
}

struct Params {
    const float* in[27];
    float* out;
    unsigned char* ws;
};

struct Ctx { LAS unsigned char* lds; int tid, lane, wid, G, bx, vc; };

__device__ __forceinline__ bool wdesc(int i, const Params& p, const float*& src, bf16_t*& dst, int& K, int& N, int& glu, const float*& gain) {
    unsigned char* ws = p.ws; glu = 0; gain = nullptr;
    if (i < 4) { gain = p.in[3] + i * DM; src = p.in[5] + (size_t)i * DM * FF; dst = (bf16_t*)(ws + (i < 2 ? WS_UP01 : WS_UP23)) + (size_t)(i & 1) * DM * FF; K = DM; N = FF; return true; }
    if (i < 8) { const int l = i - 4; src = p.in[6] + (size_t)l * DM * FF; dst = (bf16_t*)(ws + (l < 2 ? WS_DN01 : WS_DN23)) + (size_t)(l & 1) * DM * FF; K = FF; N = DM; return true; }
    if (i < 10) { const int l = i - 8; gain = p.in[1] + l * DM; src = p.in[7] + (size_t)l * DM * DM; dst = (bf16_t*)(ws + WS_WIN) + (size_t)l * DM * DM; K = DM; N = DM; return true; }
    if (i < 12) { const int l = i - 10; src = p.in[16] + (size_t)l * DM * 2 * DM; dst = (bf16_t*)(ws + WS_GLU) + (size_t)l * DM * 2 * DM; K = DM; N = 2 * DM; glu = 1; return true; }
    if (i < 13) { gain = p.in[17]; src = p.in[18]; dst = (bf16_t*)(ws + WS_KVW); K = DM; N = 2 * DM; return true; }
    if (i < 15) { const int l = i - 13; gain = p.in[1] + (2 + l) * DM; src = p.in[19] + (size_t)l * DM * DM; dst = (bf16_t*)(ws + WS_QW) + (size_t)l * DM * DM; K = DM; N = DM; return true; }
    if (i < 17) { const int l = i - 15; src = p.in[25] + (size_t)l * DM * DM; dst = (bf16_t*)(ws + WS_OW) + (size_t)l * DM * DM; K = DM; N = DM; return true; }
    return false;
}
__device__ __forceinline__ bool wlocate(int f, const Params& p, const float*& src, bf16_t*& dst, int& K, int& N, int& n0, int& k0, int& sc0, const float*& gain) {
    int base = 0;
    for (int i = 0; ; ++i) {
        int glu;
        if (!wdesc(i, p, src, dst, K, N, glu, gain)) return false;
        const int ntk = K >> 6, nt = ntk * (N >> 6);
        if (f < base + nt) { const int t = f - base; n0 = (t / ntk) << 6; k0 = (t % ntk) << 6;
            sc0 = glu ? (((n0 >> 7) & 1) * DM + (n0 >> 8) * 128 + (n0 & 127)) : n0; return true; }
        base += nt;
    }
}
constexpr int NCONV_TILES = 11264;
__device__ void convert_weights(const Ctx& c, const Params& p) {
    LAS float* T = (LAS float*)c.lds;
    int f, fstep, fend;
    if (c.G == 256) { if (c.bx < 128) { f = c.bx; fstep = 128; fend = 128 * 38; } else { f = 128 * 38 + (c.bx - 128); fstep = 128; fend = NCONV_TILES; } }
    else { f = c.bx; fstep = c.G; fend = NCONV_TILES; }
    const float* src; bf16_t* dst; int K, N, n0, k0, sc0; const float* gain;
    bool have = (f < fend) && wlocate(f, p, src, dst, K, N, n0, k0, sc0, gain);
    f32x4 v0, v1;
    const int ctid = opaque_tid(); const int kk = ctid >> 4, c4 = (ctid & 15) * 4;
    if (have) { v0 = *(const f32x4*)(src + (size_t)(k0 + kk) * N + sc0 + c4); v1 = *(const f32x4*)(src + (size_t)(k0 + 32 + kk) * N + sc0 + c4); if (gain) { v0 = v0 * gain[k0 + kk]; v1 = v1 * gain[k0 + 32 + kk]; } }
    int par = 0;
    while (have) {
        const f32x4 a0 = v0, a1 = v1; bf16_t* cdst = dst; const int cK = K, cn0 = n0, ck0 = k0;
        f += fstep;
        have = (f < fend) && wlocate(f, p, src, dst, K, N, n0, k0, sc0, gain);
        if (have) { v0 = *(const f32x4*)(src + (size_t)(k0 + kk) * N + sc0 + c4); v1 = *(const f32x4*)(src + (size_t)(k0 + 32 + kk) * N + sc0 + c4); if (gain) { v0 = v0 * gain[k0 + kk]; v1 = v1 * gain[k0 + 32 + kk]; } }
        LAS float* Tb = T + par * (64 * 65);
        Tb[(c4 + 0) * 65 + kk] = a0[0]; Tb[(c4 + 1) * 65 + kk] = a0[1]; Tb[(c4 + 2) * 65 + kk] = a0[2]; Tb[(c4 + 3) * 65 + kk] = a0[3];
        Tb[(c4 + 0) * 65 + 32 + kk] = a1[0]; Tb[(c4 + 1) * 65 + 32 + kk] = a1[1]; Tb[(c4 + 2) * 65 + 32 + kk] = a1[2]; Tb[(c4 + 3) * 65 + 32 + kk] = a1[3];
        __syncthreads();
        { const int nn = ctid >> 3, k8 = (ctid & 7) * 8; const LAS float* r = Tb + nn * 65 + k8;
          u32x4 w; w.x = cvt_pk_bf16(r[0], r[1]); w.y = cvt_pk_bf16(r[2], r[3]); w.z = cvt_pk_bf16(r[4], r[5]); w.w = cvt_pk_bf16(r[6], r[7]);
          *(u32x4*)(cdst + (size_t)(cn0 + nn) * cK + ck0 + k8) = w; }
        par ^= 1;
    }
    __syncthreads();
}

__device__ void ssm_tables(const Ctx& c, const Params& p, int layer, int g) {
    LAS float* lamp = (LAS float*)c.lds;
    LAS float* bbar = lamp + 33 * 64 * 2;
    LAS float* ccp = bbar + 64 * 16 * 2;
    LAS float* Kt = ccp + 16 * 64 * 2;
    LAS float* coef = Kt + 32 * 256;
    const int tid = opaque_tid();
    const size_t lg = (size_t)layer * NG + g;
    if (tid < 64) {
        const int pp = tid;
        const float dt = expf(p.in[10][lg]);
        const float lr = p.in[8][lg * NP + pp], li = p.in[9][lg * NP + pp];
        const float mag = expf(lr * dt), ar = mag * cosf(li * dt), ai = mag * sinf(li * dt);
        const float den = lr * lr + li * li;
        coef[pp * 2] = ((ar - 1.0f) * lr + ai * li) / den; coef[pp * 2 + 1] = (ai * lr - (ar - 1.0f) * li) / den;
        float pr = 1.0f, pi = 0.0f; asm volatile("" : "+v"(pr), "+v"(pi));
        for (int k = 0; k <= 32; ++k) { lamp[(k * 64 + pp) * 2] = pr; lamp[(k * 64 + pp) * 2 + 1] = pi; const float nr = pr * ar - pi * ai, ni = pr * ai + pi * ar; pr = nr; pi = ni; }
        float* lamL = (float*)(p.ws + WS_LAML) + (lg * NP + pp) * 2;
        lamL[0] = lamp[(32 * 64 + pp) * 2]; lamL[1] = lamp[(32 * 64 + pp) * 2 + 1];
    }
    __syncthreads();
    for (int e = tid; e < 1024; e += 512) {
        const int pp = e >> 4, cc = e & 15;
        const float br = p.in[11][lg * 1024 + e], bi = p.in[12][lg * 1024 + e], cr = coef[pp * 2], ci = coef[pp * 2 + 1];
        bbar[e * 2] = cr * br - ci * bi; bbar[e * 2 + 1] = cr * bi + ci * br;
        ccp[e * 2] = p.in[13][lg * 1024 + e]; ccp[e * 2 + 1] = p.in[14][lg * 1024 + e];
        (void)cc;
    }
    __syncthreads();
    {
        const int k = tid >> 4, co = tid & 15;
        float acc16[16];
#pragma unroll
        for (int q = 0; q < 16; ++q) acc16[q] = 0.f;
        for (int pp = 0; pp < 64; ++pp) {
            const float lr = lamp[(k * 64 + pp) * 2], li = lamp[(k * 64 + pp) * 2 + 1], cr = ccp[(co * 64 + pp) * 2], ci = ccp[(co * 64 + pp) * 2 + 1];
            const float wr = cr * lr - ci * li, wi = cr * li + ci * lr;
            const LAS f32x4* bb = (const LAS f32x4*)(bbar + pp * 32);
#pragma unroll
            for (int q = 0; q < 8; ++q) { const f32x4 b = bb[q]; acc16[2 * q] += wr * b[0] - wi * b[1]; acc16[2 * q + 1] += wr * b[2] - wi * b[3]; }
        }
#pragma unroll
        for (int q = 0; q < 16; ++q) Kt[(k * 16 + co) * 16 + q] = acc16[q];
    }
    __syncthreads();
    bf16_t* Tm = (bf16_t*)(p.ws + WS_TM) + (size_t)layer * NG * 512 * UGP + (size_t)g * 512 * UGP;
    for (int e = tid; e < 512 * 80; e += 512) {
        const int row = e / 80, ch = e % 80, j = row >> 4, co = row & 15;
        float v[8];
        if (ch < 64) { const int i = ch >> 1, ci0 = (ch & 1) * 8;
#pragma unroll
            for (int q = 0; q < 8; ++q) v[q] = (i <= j) ? Kt[((j - i) * 16 + co) * 16 + ci0 + q] : 0.f;
        } else { const int p0 = (ch - 64) * 8;
#pragma unroll
            for (int q = 0; q < 8; ++q) { const int pq = p0 + q, pp = pq & 63;
                const float lr = lamp[((j + 1) * 64 + pp) * 2], li = lamp[((j + 1) * 64 + pp) * 2 + 1], cr = ccp[(co * 64 + pp) * 2], ci = ccp[(co * 64 + pp) * 2 + 1];
                v[q] = pq < 64 ? (cr * lr - ci * li) : -(cr * li + ci * lr); }
        }
        u32x4 w; w.x = cvt_pk_bf16(v[0], v[1]); w.y = cvt_pk_bf16(v[2], v[3]); w.z = cvt_pk_bf16(v[4], v[5]); w.w = cvt_pk_bf16(v[6], v[7]);
        *(u32x4*)(Tm + (size_t)row * UGP + ch * 8) = w;
    }
    bf16_t* Sin = (bf16_t*)(p.ws + WS_SIN) + (size_t)layer * NG * 128 * 512 + (size_t)g * 128 * 512;
    for (int e = tid; e < 128 * 64; e += 512) {
        const int row = e >> 6, ch = e & 63, pp = row & 63, i = ch >> 1, ci0 = (ch & 1) * 8;
        const float lr = lamp[((31 - i) * 64 + pp) * 2], li = lamp[((31 - i) * 64 + pp) * 2 + 1];
        float v[8];
#pragma unroll
        for (int q = 0; q < 8; ++q) { const float br = bbar[(pp * 16 + ci0 + q) * 2], bi = bbar[(pp * 16 + ci0 + q) * 2 + 1]; v[q] = row < 64 ? (lr * br - li * bi) : (lr * bi + li * br); }
        u32x4 w; w.x = cvt_pk_bf16(v[0], v[1]); w.y = cvt_pk_bf16(v[2], v[3]); w.z = cvt_pk_bf16(v[4], v[5]); w.w = cvt_pk_bf16(v[6], v[7]);
        *(u32x4*)(Sin + (size_t)row * 512 + ch * 8) = w;
    }
    __syncthreads();
}

__device__ void small_tables(const Ctx& c, const Params& p) {
    float* bt = (float*)(p.ws + WS_BIAS);
    const int stid = opaque_tid();
    for (int e = stid; e < 8 * 128; e += 512) {
        const int h = e >> 7, n = e & 127;
        int bk = n;
        if (n >= 16) { const int th[16] = {16, 19, 21, 24, 27, 31, 35, 40, 46, 52, 59, 67, 77, 87, 99, 113}; bk = 15;
#pragma unroll
            for (int q = 0; q < 16; ++q) bk += (n >= th[q]) ? 1 : 0; }
        bt[e] = (p.in[26][bk * 8 + h] - p.in[26][31 * 8 + h]) * LOG2E;
    }
    if (stid < 2) {
        const int j = stid; float s1 = 0.f, s2 = 0.f;
        for (int q = 0; q < 64; ++q) { s1 += p.in[20][j * 64 + q] * p.in[21][j * 64 + q]; s2 += p.in[22][j * 64 + q] * p.in[23][j * 64 + q]; }
        const float li = 0.8f - 0.6f * expf(-0.3f * (float)(j + 2));
        float* sc = (float*)(p.ws + WS_SCAL) + j * 4;
        sc[0] = expf(s1) - expf(s2) + li; sc[1] = 1.0f - li; sc[2] = 0.f; sc[3] = 0.f;
    }
}

__device__ void norm_phase(const Ctx& c, const void* xin_, int xin_f32, void* xout_, int xout_f32, const bf16_t* mix, const float* gpost, float* rsout) {
    const float* xin = (const float*)xin_; const bf16_t* xin16 = (const bf16_t*)xin_; float* xout = (float*)xout_; bf16_t* xout16 = (bf16_t*)xout_;
    const int tid_ = opaque_tid(), lane = tid_ & 63, wid_ = __builtin_amdgcn_readfirstlane(tid_ >> 6);
    for (int r0 = (wid_ * c.G + c.bx) * 4; r0 < TOK; r0 += 8 * c.G * 4) {
        f32x4 xv[4][4]; u32x4 xw[4][2]; u32x4 mw[4][2];
        if (xin_f32) {
#pragma unroll
            for (int rr = 0; rr < 4; ++rr)
#pragma unroll
                for (int k = 0; k < 2; ++k) { const float* xp = xin + (size_t)(r0 + rr) * DM + k * 512 + lane * 8; xv[rr][2 * k] = *(const f32x4*)xp; xv[rr][2 * k + 1] = *(const f32x4*)(xp + 4); }
        } else {
#pragma unroll
            for (int rr = 0; rr < 4; ++rr)
#pragma unroll
                for (int k = 0; k < 2; ++k) xw[rr][k] = *(const u32x4*)(xin16 + (size_t)(r0 + rr) * DM + k * 512 + lane * 8);
        }
        if (mix) {
#pragma unroll
            for (int rr = 0; rr < 4; ++rr)
#pragma unroll
                for (int k = 0; k < 2; ++k) mw[rr][k] = *(const u32x4*)(mix + (size_t)(r0 + rr) * DM + k * 512 + lane * 8);
        }
#pragma unroll
        for (int rr = 0; rr < 4; ++rr) {
            const int row = r0 + rr;
            float x[16];
            if (xin_f32) {
#pragma unroll
                for (int q = 0; q < 4; ++q)
#pragma unroll
                    for (int e = 0; e < 4; ++e) x[q * 4 + e] = xv[rr][q][e];
            } else {
#pragma unroll
                for (int k = 0; k < 2; ++k) { const u32x4 w = xw[rr][k];
                    x[k * 8 + 0] = bf_lo(w.x); x[k * 8 + 1] = bf_hi(w.x); x[k * 8 + 2] = bf_lo(w.y); x[k * 8 + 3] = bf_hi(w.y); x[k * 8 + 4] = bf_lo(w.z); x[k * 8 + 5] = bf_hi(w.z); x[k * 8 + 6] = bf_lo(w.w); x[k * 8 + 7] = bf_hi(w.w); }
            }
            if (mix) {
                float mv[16]; float ss = 0.f;
#pragma unroll
                for (int k = 0; k < 2; ++k) { const u32x4 w = mw[rr][k];
                    mv[k * 8 + 0] = bf_lo(w.x); mv[k * 8 + 1] = bf_hi(w.x); mv[k * 8 + 2] = bf_lo(w.y); mv[k * 8 + 3] = bf_hi(w.y); mv[k * 8 + 4] = bf_lo(w.z); mv[k * 8 + 5] = bf_hi(w.z); mv[k * 8 + 6] = bf_lo(w.w); mv[k * 8 + 7] = bf_hi(w.w); }
#pragma unroll
                for (int e = 0; e < 16; ++e) ss += mv[e] * mv[e];
                ss = wave_sum(ss);
                const float rs = rsqrtf(ss * (1.0f / DM) + EPS);
#pragma unroll
                for (int k = 0; k < 2; ++k) { const float* gp = gpost + k * 512 + lane * 8; const f32x4 ga = *(const f32x4*)gp, gb = *(const f32x4*)(gp + 4);
#pragma unroll
                    for (int e = 0; e < 4; ++e) { x[k * 8 + e] += mv[k * 8 + e] * rs * ga[e]; x[k * 8 + 4 + e] += mv[k * 8 + 4 + e] * rs * gb[e]; } }
            }
#pragma unroll
            for (int k = 0; k < 2; ++k) {
                if (xout_f32) { float* xo = xout + (size_t)row * DM + k * 512 + lane * 8;
                    *(f32x4*)xo = (f32x4){x[k * 8 + 0], x[k * 8 + 1], x[k * 8 + 2], x[k * 8 + 3]}; *(f32x4*)(xo + 4) = (f32x4){x[k * 8 + 4], x[k * 8 + 5], x[k * 8 + 6], x[k * 8 + 7]}; }
                else { u32x4 wx; wx.x = cvt_pk_bf16(x[k * 8 + 0], x[k * 8 + 1]); wx.y = cvt_pk_bf16(x[k * 8 + 2], x[k * 8 + 3]); wx.z = cvt_pk_bf16(x[k * 8 + 4], x[k * 8 + 5]); wx.w = cvt_pk_bf16(x[k * 8 + 6], x[k * 8 + 7]);
                    *(u32x4*)(xout16 + (size_t)row * DM + k * 512 + lane * 8) = wx;
                    x[k * 8 + 0] = bf_lo(wx.x); x[k * 8 + 1] = bf_hi(wx.x); x[k * 8 + 2] = bf_lo(wx.y); x[k * 8 + 3] = bf_hi(wx.y); x[k * 8 + 4] = bf_lo(wx.z); x[k * 8 + 5] = bf_hi(wx.z); x[k * 8 + 6] = bf_lo(wx.w); x[k * 8 + 7] = bf_hi(wx.w); }
            }
            if (rsout) {
                float ss = 0.f;
#pragma unroll
                for (int e = 0; e < 16; ++e) ss += x[e] * x[e];
                ss = wave_sum(ss);
                if (lane == 0) rsout[row] = rsqrtf(ss * (1.0f / DM) + EPS);
            }
        }
    }
}

__device__ void scan_phase(const Ctx& c, const Params& p, int layer) {
    const float* Z = (const float*)(p.ws + WS_Z); bf16_t* Ug = (bf16_t*)(p.ws + WS_UG);
    const float* lamL = (const float*)(p.ws + WS_LAML) + (size_t)layer * NG * NP * 2;
    const int tid_ = opaque_tid(), wid_ = __builtin_amdgcn_readfirstlane(tid_ >> 6);
    for (int pr = wid_ * c.G + c.bx; pr < 4 * NG; pr += 8 * c.G) {
        const int b = pr >> 6, g = pr & 63, pp = tid_ & 63;
        const float lr = lamL[(g * NP + pp) * 2], li = lamL[(g * NP + pp) * 2 + 1];
        float sr = 0.f, si = 0.f;
        const size_t row0 = (size_t)g * NCH + b * 256;
#pragma unroll 8
        for (int ch = 0; ch < 256; ++ch) {
            const float zr = Z[(row0 + ch) * 128 + pp], zi = Z[(row0 + ch) * 128 + 64 + pp];
            bf16_t* o = Ug + (row0 + ch) * UGP + 512 + pp;
            const unsigned w = cvt_pk_bf16(sr, si);
            o[0] = (bf16_t)(w & 0xffffu); o[64] = (bf16_t)(w >> 16);
            const float nr = lr * sr - li * si + zr, ni = lr * si + li * sr + zi; sr = nr; si = ni;
        }
    }
}

__device__ void scan_after_z(const Ctx& c, const Params& p, int layer) {
    asm volatile("s_waitcnt vmcnt(0)" ::: "memory"); __syncthreads();
    __builtin_amdgcn_fence(__ATOMIC_ACQUIRE, "agent");
    asm volatile("s_waitcnt vmcnt(0)" ::: "memory");
    const float* Z = (const float*)(p.ws + WS_Z); bf16_t* Ug = (bf16_t*)(p.ws + WS_UG);
    const float* lamL = (const float*)(p.ws + WS_LAML) + (size_t)layer * NG * NP * 2;
    const int tid_ = opaque_tid(), wid_ = __builtin_amdgcn_readfirstlane(tid_ >> 6), pp = tid_ & 63;
    for (int i = wid_; ; i += 8) {
        const int L = i * c.G + c.vc; if (L >= 4 * NG) break;
        const int g = L >> 2, b = L & 3;
        const float lr = lamL[(g * NP + pp) * 2], li = lamL[(g * NP + pp) * 2 + 1];
        float sr = 0.f, si = 0.f;
        const size_t row0 = (size_t)g * NCH + b * 256;
#pragma unroll 8
        for (int ch = 0; ch < 256; ++ch) {
            const float zr = Z[(row0 + ch) * 128 + pp], zi = Z[(row0 + ch) * 128 + 64 + pp];
            bf16_t* o = Ug + (row0 + ch) * UGP + 512 + pp;
            const unsigned w = cvt_pk_bf16(sr, si);
            o[0] = (bf16_t)(w & 0xffffu); o[64] = (bf16_t)(w >> 16);
            const float nr = lr * sr - li * si + zr, ni = lr * si + li * sr + zi; sr = nr; si = ni;
        }
    }
}

#define ATTN_DMA(gp, ldsoff) __builtin_amdgcn_global_load_lds((const unsigned*)(gp), (LAS unsigned*)(lds + (ldsoff)), 16, 0, 0)
#define ATTN_PV(PB, VA) do { \
    bf16x8 fa__[8], fb__[8]; \
    _Pragma("unroll") for (int q_ = 0; q_ < 8; ++q_) fa__[q_] = *(LAS const bf16x8*)(VA[q_ & 3] + (q_ >> 2) * 4096); \
    __builtin_amdgcn_sched_barrier(0); \
    _Pragma("unroll") for (int q_ = 0; q_ < 8; ++q_) fb__[q_] = *(LAS const bf16x8*)(VA[q_ & 3] + (2 + (q_ >> 2)) * 4096); \
    _Pragma("unroll") for (int q_ = 0; q_ < 8; ++q_) o[q_ & 1] = __builtin_amdgcn_mfma_f32_32x32x16_bf16(fa__[(q_ & 1) * 4 + (q_ >> 1)], PB[q_ >> 1], o[q_ & 1], 0, 0, 0); \
    __builtin_amdgcn_sched_barrier(0); \
    _Pragma("unroll") for (int q_ = 0; q_ < 8; ++q_) o[2 + (q_ & 1)] = __builtin_amdgcn_mfma_f32_32x32x16_bf16(fb__[(q_ & 1) * 4 + (q_ >> 1)], PB[q_ >> 1], o[2 + (q_ & 1)], 0, 0, 0); \
    __builtin_amdgcn_sched_barrier(0); } while (0)
#define ATTN_QK(P0, P1, KA) do { \
    bf16x8 kf_[4]; \
    _Pragma("unroll") for (int d0 = 0; d0 < 4; ++d0) kf_[d0] = *(LAS const bf16x8*)(KA[d0]); \
    __builtin_amdgcn_sched_barrier(0); \
    P0 = __builtin_amdgcn_mfma_f32_32x32x16_bf16(kf_[0], qf[0], negm, 0, 0, 0); \
    _Pragma("unroll") for (int d0 = 1; d0 < 4; ++d0) P0 = __builtin_amdgcn_mfma_f32_32x32x16_bf16(kf_[d0], qf[d0], P0, 0, 0, 0); \
    __builtin_amdgcn_sched_barrier(0); \
    _Pragma("unroll") for (int d0 = 0; d0 < 4; ++d0) kf_[d0] = *(LAS const bf16x8*)(KA[d0] + 8192); \
    __builtin_amdgcn_sched_barrier(0); \
    P1 = __builtin_amdgcn_mfma_f32_32x32x16_bf16(kf_[0], qf[0], negm, 0, 0, 0); \
    _Pragma("unroll") for (int d0 = 1; d0 < 4; ++d0) P1 = __builtin_amdgcn_mfma_f32_32x32x16_bf16(kf_[d0], qf[d0], P1, 0, 0, 0); \
    __builtin_amdgcn_sched_barrier(0); } while (0)
#define ATTN_BAND(P0, P1, DD) do { \
    __builtin_amdgcn_sched_barrier(0); \
    _Pragma("unroll") for (int r = 0; r < 16; ++r) { const int d0_ = (DD) - (16 * (r >> 3) + (r & 7)); P0[r] += btab[1 + min(max(d0_, -1), 127)]; } \
    __builtin_amdgcn_sched_barrier(0); \
    _Pragma("unroll") for (int r = 0; r < 16; ++r) { const int d1_ = (DD) - 32 - (16 * (r >> 3) + (r & 7)); P1[r] += btab[1 + min(max(d1_, -1), 127)]; } \
    __builtin_amdgcn_sched_barrier(0); } while (0)
#define ATTN_EXP(P0, P1, PB) do { \
      \
    _Pragma("unroll") for (int r = 0; r < 16; ++r) { P0[r] = fexp2(P0[r]); P1[r] = fexp2(P1[r]); lrun += P0[r]; lrun += P1[r]; } \
    _Pragma("unroll") for (int q = 0; q < 2; ++q) { u32x4 w0_, w1_; \
        w0_.x = cvt_pk_bf16(P0[q * 8 + 0], P0[q * 8 + 1]); w0_.y = cvt_pk_bf16(P0[q * 8 + 2], P0[q * 8 + 3]); w0_.z = cvt_pk_bf16(P0[q * 8 + 4], P0[q * 8 + 5]); w0_.w = cvt_pk_bf16(P0[q * 8 + 6], P0[q * 8 + 7]); \
        w1_.x = cvt_pk_bf16(P1[q * 8 + 0], P1[q * 8 + 1]); w1_.y = cvt_pk_bf16(P1[q * 8 + 2], P1[q * 8 + 3]); w1_.z = cvt_pk_bf16(P1[q * 8 + 4], P1[q * 8 + 5]); w1_.w = cvt_pk_bf16(P1[q * 8 + 6], P1[q * 8 + 7]); \
        PB[q] = __builtin_bit_cast(bf16x8, w0_); PB[2 + q] = __builtin_bit_cast(bf16x8, w1_); } } while (0)
__device__ void attn_phase(const Ctx& c, const bf16_t* Q, const bf16_t* Kg, const bf16_t* Vt, bf16_t* ON, const float* biasT, const float* scal, const float* hn) {
    constexpr int SUB = 16384, STAGE = 32768, V_OFF = 65536, BT_OFF = 131072 + 128;
    LAS unsigned char* lds = c.lds;
    LAS unsigned char* ldsr = lds; asm volatile("" : "+s"(ldsr) :: "memory");
    for (int itu = 0; ; ++itu) {
        const int L = itu * c.G + c.vc; if (L >= 2048) break;
        const int tid = opaque_tid(), lane = tid & 63, wid = __builtin_amdgcn_readfirstlane(tid >> 6), br = wid >> 2, wq = wid & 3, l31 = lane & 31, hi = lane >> 5;
        const int prow = (l31 & ~12) | ((l31 & 4) << 1) | ((l31 & 8) >> 1);
        const int kbase = prow * 256, kx0 = (br * 8 + hi) ^ (prow & 15);
        const int vbase = V_OFF + l31 * 128, vx0 = hi ^ ((l31 >> 1) & 7);
        int ko[4], vo[4];
#pragma unroll
        for (int q = 0; q < 4; ++q) { ko[q] = (kx0 ^ (q << 1)) << 4; vo[q] = (vx0 ^ (q << 1)) << 4; }
        const int kr0 = 4 * wid + (lane >> 4), kc = (lane & 15) ^ (kr0 & 15);
        const int vr0 = 8 * wid + (lane >> 3), vcx = (lane & 7) ^ ((vr0 >> 1) & 7);
        const int dst0 = wid * 1024, dst1 = (wid + 8) * 1024;
        LAS const float* btab = (LAS const float*)(lds + BT_OFF);
        const int i7 = 7 - (L >> 8), pair = (L & 255) >> 3, jj8 = L & 7;
        const int qb = (i7 & 1) ? (16 * (i7 >> 1) + 15 - jj8) : (16 * (i7 >> 1) + jj8);
        const int b = pair >> 3, h = pair & 7, q0 = qb * 128, NI = qb + 1;
        const size_t tokb = (size_t)b * SEQ;
        const bf16_t* kg = Kg + (tokb + kr0) * DM + h * 128 + kc * 8;
        const bf16_t* vg = Vt + ((size_t)((b * 8 + h) * 128) << 13) + vr0 * 64 + vcx * 8;
        const bf16_t* qp = Q + (tokb + q0 + wq * 32 + l31) * DM + h * 128 + br * 64 + hi * 8;
        bf16x8 qf[4];
#pragma unroll
        for (int d0 = 0; d0 < 4; ++d0) qf[d0] = *(const bf16x8*)(qp + d0 * 16);
        if (tid < 128) ((LAS float*)(lds + BT_OFF))[1 + tid] = biasT[h * 128 + tid];
        if (tid == 128) ((LAS float*)(lds + BT_OFF))[0] = -1e30f;
#pragma unroll
        for (int sb = 0; sb < 2; ++sb) {
            ATTN_DMA(kg + (size_t)sb * 64 * DM, sb * SUB + dst0); ATTN_DMA(kg + (size_t)(sb * 64 + 32) * DM, sb * SUB + dst1);
            ATTN_DMA(vg + (size_t)sb * 8192, V_OFF + sb * SUB + dst0); ATTN_DMA(vg + (size_t)sb * 8192 + 4096, V_OFF + sb * SUB + dst1);
        }
        f32x16 o[4], negm;
#pragma unroll
        for (int r = 0; r < 16; ++r) { o[0][r] = 0.f; o[1][r] = 0.f; o[2][r] = 0.f; o[3][r] = 0.f; negm[r] = 0.f; }
        float lrun = 0.f;
        const int qrow = q0 + wq * 32 + l31;
        for (int it = 0; it < NI; ++it) {
            const int st = it & 1, kt0 = it * 128;
            asm volatile("s_waitcnt vmcnt(0) lgkmcnt(0)\n\ts_barrier" ::: "memory");
            if (it + 1 < NI) { const int s2 = (st ^ 1) * STAGE;
#pragma unroll
                for (int sb = 0; sb < 2; ++sb) { const bf16_t* kn = kg + (size_t)(kt0 + 128 + sb * 64) * DM; const bf16_t* vn = vg + (size_t)((it + 1) * 2 + sb) * 8192;
                    ATTN_DMA(kn, s2 + sb * SUB + dst0); ATTN_DMA(kn + 32 * DM, s2 + sb * SUB + dst1);
                    ATTN_DMA(vn, V_OFF + s2 + sb * SUB + dst0); ATTN_DMA(vn + 4096, V_OFF + s2 + sb * SUB + dst1); } }
            LAS const unsigned char* kbp = ldsr + st * STAGE + kbase;
            LAS const unsigned char* vbp = ldsr + st * STAGE + vbase;
#pragma unroll
            for (int sb = 0; sb < 2; ++sb) {
                LAS const unsigned char* ka_[4]; LAS const unsigned char* va_[4];
#pragma unroll
                for (int q = 0; q < 4; ++q) { ka_[q] = kbp + sb * SUB + ko[q]; va_[q] = vbp + sb * SUB + vo[q]; }
                f32x16 pa0, pa1;
                ATTN_QK(pa0, pa1, ka_);
                if (it >= NI - 2) { const int dd = qrow - kt0 - sb * 64 - 8 * hi; ATTN_BAND(pa0, pa1, dd); }
                float mxa = max3f(pa0[0], pa0[1], pa1[0]), mxb = max3f(pa0[2], pa0[3], pa1[1]); mxa = max3f(mxa, pa1[2], pa1[3]);
#pragma unroll
                for (int r = 4; r < 16; r += 4) { mxa = max3f(mxa, pa0[r], pa0[r + 1]); mxb = max3f(mxb, pa0[r + 2], pa0[r + 3]); mxa = max3f(mxa, pa1[r], pa1[r + 1]); mxb = max3f(mxb, pa1[r + 2], pa1[r + 3]); }
                float mx = max2f(mxa, mxb);
                { const auto rr_ = __builtin_amdgcn_permlane32_swap(__float_as_uint(mx), __float_as_uint(mx), false, false); mx = max2f(__uint_as_float(rr_[0]), __uint_as_float(rr_[1])); }
                if ((it == 0 && sb == 0) || __any(mx > 8.0f)) {
                    const float delta = (it == 0 && sb == 0) ? mx : fmaxf(mx, 0.f), alpha = fexp2(-delta); lrun *= alpha;
#pragma unroll
                    for (int r = 0; r < 16; ++r) { pa0[r] -= delta; pa1[r] -= delta; negm[r] -= delta; }
#pragma unroll
                    for (int q = 0; q < 4; ++q) o[q] = o[q] * alpha;
                }
                bf16x8 pk[4];
                ATTN_EXP(pa0, pa1, pk);
                ATTN_PV(pk, va_);
            }
        }
        __syncthreads();
        const int te = opaque_tid(), le31 = te & 31, hie = (te & 63) >> 5, wide = __builtin_amdgcn_readfirstlane(te >> 6), wqe = wide & 3;
        const float lam = scal[0], onem = scal[1];
        float inv = frcp(lrun + __shfl_xor(lrun, 32));
        if (wide >= 4) inv *= lam;
        LAS float* comb = (LAS float*)lds;
        if (wide >= 4) {
#pragma unroll
            for (int blk = 0; blk < 4; ++blk)
#pragma unroll
                for (int r = 0; r < 16; ++r) comb[(wqe * 128 + blk * 32 + (r & 3) + 8 * (r >> 2) + 4 * hie) * 32 + le31] = o[blk][r] * inv;
        }
        __syncthreads();
        if (wide < 4) {
            float ss = 0.f;
#pragma unroll
            for (int blk = 0; blk < 4; ++blk)
#pragma unroll
                for (int r = 0; r < 16; ++r) { const float v = o[blk][r] * inv - comb[(wqe * 128 + blk * 32 + (r & 3) + 8 * (r >> 2) + 4 * hie) * 32 + le31]; o[blk][r] = v; ss += v * v; }
            ss += __shfl_xor(ss, 32);
            const float rs = rsqrtf(ss * (1.0f / 128.0f) + EPS) * onem;
            bf16_t* op = ON + ((size_t)b * SEQ + q0 + wqe * 32 + le31) * DM + h * 128;
#pragma unroll
            for (int blk = 0; blk < 4; ++blk)
#pragma unroll
                for (int r4 = 0; r4 < 4; ++r4) { const int dv = blk * 32 + 8 * r4 + 4 * hie; const f32x4 g4 = *(const f32x4*)(hn + dv);
                    u32x2 w; w.x = cvt_pk_bf16(o[blk][r4 * 4 + 0] * rs * g4[0], o[blk][r4 * 4 + 1] * rs * g4[1]); w.y = cvt_pk_bf16(o[blk][r4 * 4 + 2] * rs * g4[2], o[blk][r4 * 4 + 3] * rs * g4[3]);
                    *(u32x2*)(op + dv) = w; }
        }
        __syncthreads();
    }
}
#undef ATTN_PV
#undef ATTN_QK
#undef ATTN_BAND
#undef ATTN_EXP
#undef ATTN_DMA

__global__ void __launch_bounds__(512, 2) yoco_fwd(Params p) {
    extern __shared__ __attribute__((aligned(16))) unsigned char lds_raw[];
    cg::grid_group grid = cg::this_grid();
    Ctx c; c.lds = (LAS unsigned char*)lds_raw; c.tid = threadIdx.x; c.lane = c.tid & 63; c.wid = __builtin_amdgcn_readfirstlane(c.tid >> 6);
    c.G = gridDim.x; c.bx = blockIdx.x; c.vc = (c.G % 8 == 0) ? (c.bx % 8) * (c.G / 8) + c.bx / 8 : c.bx;
    unsigned char* ws = p.ws;
    float* X = p.out;
    { volatile LAS unsigned* xst0 = (volatile LAS unsigned*)(c.lds + 131072); if (c.tid < 4) xst0[c.tid] = 0u; }
    __syncthreads();
    (void)xcd_barrier_post((unsigned*)(ws + WS_BAR), (volatile LAS unsigned*)(c.lds + 131072));
    bf16_t* HM = (bf16_t*)(ws + WS_HM); bf16_t* ACT = (bf16_t*)(ws + WS_ACT);
    bf16_t* UG = (bf16_t*)(ws + WS_UG); float* Zb = (float*)(ws + WS_Z); bf16_t* YG = (bf16_t*)(ws + WS_YG);
    bf16_t* Qb = (bf16_t*)(ws + WS_Q); bf16_t* ONb = (bf16_t*)(ws + WS_ON); bf16_t* HKV = (bf16_t*)(ws + WS_HKV);
    bf16_t* Kb = (bf16_t*)(ws + WS_K); bf16_t* Vtb = (bf16_t*)(ws + WS_VT);

    enum { K_PRO = 0, K_WIN = 1, K_Z = 2, K_SCAN = 3, K_Y = 4, K_GLU = 5, K_NORMA = 6, K_UP = 7, K_DOWN = 8, K_NORMB = 9, K_K = 10, K_VT = 11, K_Q = 12, K_ATTN = 13, K_O = 14 };
    for (int ph = 0; ph < 35; ++ph) {
        int kind, layer;
        if (ph == 0) { kind = K_PRO; layer = 0; }
        else if (ph < 19) { layer = (ph - 1) / 9; kind = 1 + (ph - 1) % 9; }
        else { int k; if (ph < 28) { layer = 2; k = ph - 19; } else { layer = 3; k = ph - 26; }
            kind = k < 3 ? K_K + k : (k == 3 ? K_ATTN : (k == 4 ? K_O : K_NORMA + (k - 5))); }
        const int j = layer & 1;
        if (kind == K_SCAN) continue;
        for (int rep = 0; rep < (((REPEAT_MASK >> kind) & 1) ? 2 : 1); ++rep) {
        { int t_ = threadIdx.x; asm volatile("" : "+v"(t_)); c.tid = t_; c.lane = t_ & 63; c.wid = __builtin_amdgcn_readfirstlane(t_ >> 6); }
        const bool is_gemm = (kind == K_WIN) | (kind == K_Z) | (kind == K_Y) | (kind == K_GLU) | (kind == K_UP) | (kind == K_DOWN) | (kind == K_K) | (kind == K_VT) | (kind == K_Q) | (kind == K_O);
        if (is_gemm) {
            pg8::Job jb; jb.lda = DM; jb.ldb = DM; jb.K = DM; jb.ord = pg8::ORD_STATIC; jb.M = TOK; jb.N = DM; jb.epi = pg8::EPI_STORE; jb.ldc = DM; jb.scale = 1.0f; jb.O = HM; jb.x1 = nullptr; jb.x2 = nullptr; jb.A = HM; jb.Bt = nullptr;
            const bf16_t* X16 = (const bf16_t*)X; const float* RS = (const float*)(ws + WS_RS);
            switch (kind) {
            case K_WIN: jb.A = X16; jb.x2 = RS; jb.Bt = (const bf16_t*)(ws + WS_WIN) + (size_t)j * DM * DM; jb.epi = pg8::EPI_UG; jb.O = UG; break;
            case K_Z: jb.A = UG; jb.Bt = (const bf16_t*)(ws + WS_SIN) + (size_t)j * NG * 128 * 512; jb.lda = UGP; jb.ldb = 512; jb.K = 512; jb.ord = pg8::ORD_Z; jb.epi = pg8::EPI_Z; jb.O = Zb; break;
            case K_Y: jb.A = UG; jb.Bt = (const bf16_t*)(ws + WS_TM) + (size_t)j * NG * 512 * UGP; jb.lda = UGP; jb.ldb = UGP; jb.K = UGP; jb.ord = pg8::ORD_Y; jb.epi = pg8::EPI_Y; jb.O = YG; jb.x1 = UG; jb.x2 = p.in[15] + (size_t)j * DM; break;
            case K_GLU: jb.A = YG; jb.Bt = (const bf16_t*)(ws + WS_GLU) + (size_t)j * DM * 2 * DM; jb.N = 2 * DM; jb.epi = pg8::EPI_GLU; break;
            case K_UP: jb.A = layer == 3 ? (const bf16_t*)Kb : X16; jb.x2 = RS; jb.Bt = (const bf16_t*)(ws + (layer < 2 ? WS_UP01 : WS_UP23)) + (size_t)j * DM * FF; jb.N = FF; jb.epi = pg8::EPI_RELU2; jb.O = ACT; jb.ldc = FF; break;
            case K_DOWN: jb.A = ACT; jb.Bt = (const bf16_t*)(ws + (layer < 2 ? WS_DN01 : WS_DN23)) + (size_t)j * DM * FF; jb.lda = FF; jb.ldb = FF; jb.K = FF; break;
            case K_K: jb.A = X16; jb.x2 = RS; jb.Bt = (const bf16_t*)(ws + WS_KVW); jb.O = Kb; break;
            case K_VT: jb.A = (const bf16_t*)(ws + WS_KVW) + (size_t)DM * DM; jb.Bt = X16; jb.x2 = RS; jb.M = DM; jb.N = TOK; jb.O = Vtb; jb.epi = pg8::EPI_VT; break;
            case K_Q: jb.A = X16; jb.x2 = RS; jb.Bt = (const bf16_t*)(ws + WS_QW) + (size_t)j * DM * DM; jb.O = Qb; jb.scale = 0.125f * LOG2E; break;
            default:   jb.A = ONb; jb.Bt = (const bf16_t*)(ws + WS_OW) + (size_t)j * DM * DM; break;
            }
#ifndef NO_GEMM
            pg8::gemm_phase(c.lds, jb, c.G, c.bx, c.vc, c.tid);
#endif
            if (kind == K_Z) scan_after_z(c, p, j);
        } else if (kind == K_NORMA || kind == K_NORMB || kind == K_PRO) {
            if (kind == K_PRO) {
#ifndef NO_TAB
                for (int u = c.bx; u < 2 * NG; u += c.G) ssm_tables(c, p, u >> 6, u & 63);
#endif
                if (c.bx == c.G - 1) small_tables(c, p);
#ifndef NO_CONV
                convert_weights(c, p);
#endif
            }
            const void* xin = X; void* xout = X; int xin_f32 = 0, xout_f32 = 0; const bf16_t* mix = HM; const float* gpost = nullptr; float* rsout = (float*)(ws + WS_RS);
            if (kind == K_PRO) { xin = p.in[0]; xin_f32 = 1; mix = nullptr; }
            else if (kind == K_NORMA) { if (layer == 3) xout = Kb; gpost = p.in[2] + layer * DM; }
            else { gpost = p.in[4] + layer * DM; if (layer == 3) { xin = Kb; xout_f32 = 1; rsout = nullptr; } }
#ifndef NO_NORM
            norm_phase(c, xin, xin_f32, xout, xout_f32, mix, gpost, rsout);
#endif
        } else if (kind == K_SCAN) {
#ifndef NO_SCAN
            scan_phase(c, p, j);
#endif
        } else {
#ifndef NO_ATTN
            attn_phase(c, Qb, Kb, Vtb, ONb, (const float*)(ws + WS_BIAS), (const float*)(ws + WS_SCAL) + j * 4, p.in[24] + j * 128);
#endif
        }
        }
        if (!(kind == K_K || kind == K_VT || ph == 34)) { if (ph == 0 && c.G > 0x40000000) grid.sync(); else { XcdBarrier xb_; xb_.bar = (unsigned*)(ws + WS_BAR); xb_.x = xb_xcc_id(); xb_.st = (volatile LAS unsigned*)(c.lds + 131072); xcd_barrier(xb_); } }
    }
}

extern "C" void kernel_launch(void* const* d_in, const int* in_sizes, int n_in, void* d_out, int out_size, void* d_ws, size_t ws_size, hipStream_t stream) {
    static int grid_blocks = 0;
    if (grid_blocks == 0) {
        if (n_in != 27 || out_size != TOK * DM || ws_size < WS_END) { fprintf(stderr, "kernel_launch: unexpected shapes (n_in %d, out %d, ws %zu)\n", n_in, out_size, ws_size); grid_blocks = -1; return; }
        int dev = 0, cus = 0, per_cu = 0;
        hipGetDevice(&dev);
        hipDeviceGetAttribute(&cus, hipDeviceAttributeMultiprocessorCount, dev);
        if (hipFuncSetAttribute((const void*)yoco_fwd, hipFuncAttributeMaxDynamicSharedMemorySize, LDS_BYTES) != hipSuccess) { fprintf(stderr, "kernel_launch: hipFuncSetAttribute failed\n"); grid_blocks = -1; return; }
        if (hipOccupancyMaxActiveBlocksPerMultiprocessor(&per_cu, (const void*)yoco_fwd, 512, LDS_BYTES) != hipSuccess || per_cu < 1) { fprintf(stderr, "kernel_launch: occupancy query says %d\n", per_cu); per_cu = 1; }
        (void)hipGetLastError();
        grid_blocks = cus * 1;
    }
    if (grid_blocks < 0) return;
    Params p{};
    for (int i = 0; i < 27; ++i) p.in[i] = (const float*)d_in[i];
    p.out = (float*)d_out; p.ws = (unsigned char*)d_ws;
    if (hipMemsetAsync((char*)d_ws + WS_BAR, 0, 16384, stream) != hipSuccess) { fprintf(stderr, "kernel_launch: memset of barrier words failed\n"); return; }
    void* args[] = {&p};
    hipError_t e = hipLaunchCooperativeKernel((const void*)yoco_fwd, dim3(grid_blocks), dim3(512), args, LDS_BYTES, stream);
    if (e != hipSuccess) fprintf(stderr, "cooperative launch failed: %s (grid %d)\n", hipGetErrorString(e), grid_blocks);
}
```

```cpp
#include <hip/hip_runtime.h>
#include <hip/hip_cooperative_groups.h>
#include <cstdio>
#include <cstdint>
namespace cg = cooperative_groups;

#define LAS __attribute__((address_space(3)))
typedef unsigned short bf16_t;
typedef short bf16x8 __attribute__((ext_vector_type(8)));
typedef float f32x4 __attribute__((ext_vector_type(4)));
typedef float f32x16 __attribute__((ext_vector_type(16)));
typedef unsigned u32x4 __attribute__((ext_vector_type(4)));
typedef unsigned u32x2 __attribute__((ext_vector_type(2)));

constexpr int TOK = 32768, DM = 1024, FF = 4096, SEQ = 8192;
constexpr int NG = 64, GS = 16, NP = 64;
constexpr int CL = 32;
constexpr int NCH = TOK / CL;
constexpr int UGP = CL * GS + 2 * NP;
constexpr float EPS = 1e-6f;
constexpr float LOG2E = 1.4426950408889634f;

constexpr size_t MiB = 1u << 20;
constexpr size_t WS_BIAS = 0;
constexpr size_t WS_SCAL = 4096;
constexpr size_t WS_LAML = 8192;
constexpr size_t WS_RS = 786432;
constexpr size_t WS_BAR = 131072;
constexpr size_t WS_UP23 = 1 * MiB;
constexpr size_t WS_DN23 = 17 * MiB;
constexpr size_t WS_KVW = 33 * MiB;
constexpr size_t WS_QW = 37 * MiB;
constexpr size_t WS_OW = 41 * MiB;
constexpr size_t WS_UP01 = 45 * MiB;
constexpr size_t WS_DN01 = 61 * MiB;
constexpr size_t WS_WIN = 77 * MiB;
constexpr size_t WS_GLU = 81 * MiB;
constexpr size_t WS_TM = 89 * MiB;
constexpr size_t WS_SIN = 169 * MiB;
constexpr size_t WS_K = 45 * MiB;
constexpr size_t WS_VT = 109 * MiB;
constexpr size_t WS_HM = 186 * MiB;
constexpr size_t WS_ACT = 250 * MiB;
constexpr size_t WS_UG = WS_ACT;
constexpr size_t WS_Z = WS_ACT + 80 * MiB;
constexpr size_t WS_YG = WS_ACT + 112 * MiB;
constexpr size_t WS_Q = WS_ACT;
constexpr size_t WS_ON = WS_ACT + 64 * MiB;
constexpr size_t WS_HKV = WS_ACT + 128 * MiB;
constexpr size_t WS_END = 506 * MiB;

constexpr int LDS_BYTES = 147456;
#ifndef REPEAT_MASK
#define REPEAT_MASK 0
#endif

__device__ __forceinline__ unsigned cvt_pk_bf16(float lo, float hi) { unsigned r; asm("v_cvt_pk_bf16_f32 %0, %1, %2" : "=v"(r) : "v"(lo), "v"(hi)); return r; }
__device__ __forceinline__ float bf_lo(unsigned w) { return __uint_as_float(w << 16); }
__device__ __forceinline__ float bf_hi(unsigned w) { return __uint_as_float(w & 0xffff0000u); }
__device__ __forceinline__ float fexp2(float x) { return __builtin_amdgcn_exp2f(x); }
__device__ __forceinline__ float frcp(float x) { return __builtin_amdgcn_rcpf(x); }
__device__ __forceinline__ float max3f(float a, float b, float c) { float r; asm("v_max3_f32 %0, %1, %2, %3" : "=v"(r) : "v"(a), "v"(b), "v"(c)); return r; }
__device__ __forceinline__ float max2f(float a, float b) { float r; asm("v_max_f32_e32 %0, %1, %2" : "=v"(r) : "v"(a), "v"(b)); return r; }
__device__ __forceinline__ int opaque_tid() { int t_ = threadIdx.x; asm volatile("" : "+v"(t_)); return t_; }
__device__ __forceinline__ float wave_sum(float v) {
#pragma unroll
    for (int o = 32; o >= 1; o >>= 1) v += __shfl_xor(v, o);
    return v;
}
__device__ __forceinline__ float gelu_tanh(float y) {
    const float t = y * (1.5957691216057308f + 0.07135481627f * y * y);
    return y * frcp(1.0f + fexp2(-t * LOG2E));
}

namespace pg8 {
constexpr int BM = 256, BK = 64, HALF = 128, HTB = HALF * BK * 2, STAGE_BYTES = 8 * HTB;
__host__ __device__ __forceinline__ int lds_byte(int r, int c) { const int st = (r >> 4) * 2 + (c >> 5), rr = r & 15, cc = c & 31, ob = rr * 64 + cc * 2; return st * 1024 + (ob ^ (((ob >> 9) & 1) << 5)); }
__host__ __device__ __forceinline__ void stage_rc(int b, int& R, int& C) { const int st = b / 1024, sb = b % 1024, swz = sb ^ (((sb >> 9) & 1) << 5); R = (st >> 1) * 16 + swz / 64; C = (st & 1) * 32 + (swz % 64) / 2; }
__host__ __device__ __forceinline__ int perm32(int rho) { const int n = rho >> 4, i = rho & 15; return 8 * (i >> 2) + 4 * n + (i & 3); }

struct Unit { int pm, pn, arow, brow; };
enum { ORD_STATIC = 0, ORD_Z = 1, ORD_Y = 2 };
enum { EPI_STORE = 0, EPI_RELU2 = 1, EPI_GLU = 2, EPI_UG = 3, EPI_Z = 4, EPI_Y = 5, EPI_VT = 6 };
struct Job { const bf16_t* A; const bf16_t* Bt; int lda, ldb, K, ord, M, N, epi, ldc; float scale; void* O; const void* x1; const void* x2; int rev; };

__device__ __forceinline__ bool next_unit(const Job& jb, int G, int bx, int vc, int i, Unit& u) {
    if (jb.ord == ORD_STATIC) {
        const int nM = jb.M / BM, nN = jb.N / BM, nwg = nM * nN;
        const long L = (long)i * G + bx; if (L >= nwg) return false;
        int wgid = (int)L; { const int q = nwg / 8, r = nwg % 8, xcd = wgid % 8, off = wgid / 8; wgid = (xcd < r ? xcd * (q + 1) : r * (q + 1) + (xcd - r) * q) + off; }
        if (jb.rev) wgid = nwg - 1 - wgid;
        const int nig = 8 * nN, gid = wgid / nig, fm = gid * 8, gsz = (nM - fm) < 8 ? (nM - fm) : 8;
        u.pm = fm + ((wgid % nig) % gsz); u.pn = (wgid % nig) / gsz; u.arow = u.pm * BM; u.brow = u.pn * BM; return true;
    } else if (jb.ord == ORD_Z) {
        const int L = i * G + vc; if (L >= NG * 4) return false; u.pm = L; u.pn = 0; u.arow = L * BM; u.brow = (L >> 2) * 128; return true;
    } else {
        const int L = i * G + vc; if (L >= NG * 8) return false; const int g = L >> 3, r = L & 7; u.pm = g * 4 + (r >> 1); u.pn = g * 2 + (r & 1); u.arow = u.pm * BM; u.brow = u.pn * BM; return true;
    }
}

typedef f32x4 Acc[2][2][4][2];
__device__ __forceinline__ u32x4 pack8(const f32x4 v0, const f32x4 v1) { u32x4 w; w.x = cvt_pk_bf16(v0[0], v0[1]); w.y = cvt_pk_bf16(v0[2], v0[3]); w.z = cvt_pk_bf16(v1[0], v1[1]); w.w = cvt_pk_bf16(v1[2], v1[3]); return w; }

__device__ __forceinline__ void epilogue(const Job& jb, const Acc& acc, const Unit& u) {
    int t_ = threadIdx.x; asm volatile("" : "+v"(t_));
    const int wid_ = __builtin_amdgcn_readfirstlane(t_ >> 6), wr = wid_ >> 2, wc = wid_ & 3, fr = t_ & 15, fq = (t_ & 63) >> 4;
    const int row0 = u.pm * BM + wr * 64 + fr;
#ifdef EPI_MASK
    const int epi_ = ((1 << jb.epi) & EPI_MASK) ? jb.epi : 0;
#else
    const int epi_ = jb.epi;
#endif
    if (epi_ == EPI_STORE || epi_ == EPI_RELU2) {
        bf16_t* O = (bf16_t*)jb.O; const int col0 = u.pn * BM + wc * 32 + 8 * fq; const bool r2 = epi_ == EPI_RELU2; const float scale = jb.scale; const float* rsc = (const float*)jb.x2;
#pragma unroll
        for (int ai = 0; ai < 2; ++ai)
#pragma unroll
            for (int m = 0; m < 4; ++m) { bf16_t* rowp = O + (size_t)(row0 + ai * HALF + m * 16) * jb.ldc + col0;
                float rsv = 1.0f; if (rsc) { rsv = rsc[row0 + ai * HALF + m * 16]; if (r2) rsv = rsv * rsv; }
                const float sc_ = scale * rsv;
#pragma unroll
                for (int bj = 0; bj < 2; ++bj) { f32x4 v0 = acc[ai][bj][m][0], v1 = acc[ai][bj][m][1];
                    if (r2) {
#pragma unroll
                        for (int e = 0; e < 4; ++e) { const float a = fmaxf(v0[e], 0.f), b = fmaxf(v1[e], 0.f); v0[e] = a * a; v1[e] = b * b; } }
                    v0 = v0 * sc_; v1 = v1 * sc_;
                    *(u32x4*)(rowp + bj * HALF) = pack8(v0, v1); } }
    } else if (epi_ == EPI_GLU) {
        bf16_t* O = (bf16_t*)jb.O; const int col0 = u.pn * HALF + wc * 32 + 8 * fq;
#pragma unroll
        for (int ai = 0; ai < 2; ++ai)
#pragma unroll
            for (int m = 0; m < 4; ++m) { bf16_t* rowp = O + (size_t)(row0 + ai * HALF + m * 16) * DM + col0;
                f32x4 o0, o1;
#pragma unroll
                for (int e = 0; e < 4; ++e) { o0[e] = acc[ai][0][m][0][e] * frcp(1.0f + fexp2(-acc[ai][1][m][0][e] * LOG2E)); o1[e] = acc[ai][0][m][1][e] * frcp(1.0f + fexp2(-acc[ai][1][m][1][e] * LOG2E)); }
                *(u32x4*)rowp = pack8(o0, o1); }
    } else if (epi_ == EPI_UG) {
        bf16_t* Ug = (bf16_t*)jb.O; const float* rsc = (const float*)jb.x2;
#pragma unroll
        for (int ai = 0; ai < 2; ++ai)
#pragma unroll
            for (int m = 0; m < 4; ++m) { const int tok = row0 + ai * HALF + m * 16; const float rsv = rsc[tok];
#pragma unroll
                for (int bj = 0; bj < 2; ++bj) { const int g = u.pn * 16 + bj * 8 + wc * 2 + (fq >> 1);
                    *(u32x4*)(Ug + ((size_t)(g * NCH + (tok >> 5)) * UGP + (tok & 31) * 16 + (fq & 1) * 8)) = pack8(acc[ai][bj][m][0] * rsv, acc[ai][bj][m][1] * rsv); } }
    } else if (epi_ == EPI_Z) {
        float* Z = (float*)jb.O; const int col0 = wc * 32 + 8 * fq;
#pragma unroll
        for (int ai = 0; ai < 2; ++ai)
#pragma unroll
            for (int m = 0; m < 4; ++m) { float* p = Z + (size_t)(row0 + ai * HALF + m * 16) * 128 + col0;
                *(f32x4*)p = acc[ai][0][m][0]; *(f32x4*)(p + 4) = acc[ai][0][m][1]; }
    } else if (epi_ == EPI_VT) {
        bf16_t* O = (bf16_t*)jb.O; const int col0 = u.pn * BM + wc * 32 + 8 * fq; const float* rsc = (const float*)jb.x2;
        const f32x4 ra0 = *(const f32x4*)(rsc + col0), rb0 = *(const f32x4*)(rsc + col0 + 4), ra1 = *(const f32x4*)(rsc + col0 + HALF), rb1 = *(const f32x4*)(rsc + col0 + HALF + 4);
#pragma unroll
        for (int ai = 0; ai < 2; ++ai)
#pragma unroll
            for (int m = 0; m < 4; ++m) { const int row = row0 + ai * HALF + m * 16;
#pragma unroll
                for (int bj = 0; bj < 2; ++bj) { const int col = col0 + bj * HALF;
                    const size_t off = ((size_t)(((col >> 13) * 8 + (row >> 7)) * 128 + ((col & 8191) >> 6)) << 13) + (row & 127) * 64 + (col & 63);
                    *(u32x4*)(O + off) = pack8(acc[ai][bj][m][0] * (bj ? ra1 : ra0), acc[ai][bj][m][1] * (bj ? rb1 : rb0)); } }
    } else {
        const bf16_t* Ug = (const bf16_t*)jb.x1; const float* dsk = (const float*)jb.x2; bf16_t* YG = (bf16_t*)jb.O;
        const int g = u.pm >> 2, n0 = (u.pm & 3) * BM + wr * 64 + fr, c0 = (u.pn & 1) * BM + wc * 32 + 8 * fq;
        const int co0 = (fq & 1) * 8;
        const f32x4 d0 = *(const f32x4*)(dsk + g * 16 + co0), d1 = *(const f32x4*)(dsk + g * 16 + co0 + 4);
#pragma unroll
        for (int ai = 0; ai < 2; ++ai)
#pragma unroll
            for (int m = 0; m < 4; ++m) { const int n = n0 + ai * HALF + m * 16;
#pragma unroll
                for (int bj = 0; bj < 2; ++bj) { const int cc = c0 + bj * HALF, j = cc >> 4;
                    const u32x4 uu = *(const u32x4*)(Ug + ((size_t)(g * NCH + n) * UGP + cc));
                    const f32x4 v0 = acc[ai][bj][m][0], v1 = acc[ai][bj][m][1];
                    f32x4 y0, y1;
                    y0[0] = v0[0] + d0[0] * bf_lo(uu.x); y0[1] = v0[1] + d0[1] * bf_hi(uu.x); y0[2] = v0[2] + d0[2] * bf_lo(uu.y); y0[3] = v0[3] + d0[3] * bf_hi(uu.y);
                    y1[0] = v1[0] + d1[0] * bf_lo(uu.z); y1[1] = v1[1] + d1[1] * bf_hi(uu.z); y1[2] = v1[2] + d1[2] * bf_lo(uu.w); y1[3] = v1[3] + d1[3] * bf_hi(uu.w);
#pragma unroll
                    for (int e = 0; e < 4; ++e) { y0[e] = gelu_tanh(y0[e]); y1[e] = gelu_tanh(y1[e]); }
                    *(u32x4*)(YG + ((size_t)(n * CL + j) * DM + g * 16 + co0)) = pack8(y0, y1); } }
    }
}

__device__ __forceinline__ void gemm_phase(LAS unsigned char* lds, const Job& g, const int G, const int bx, const int vc, const int tid_unused) {
    const int tid = opaque_tid(); (void)tid_unused;
    const int wid = __builtin_amdgcn_readfirstlane(tid >> 6), lane = tid & 63, wr = wid >> 2, wc = wid & 3, fr = lane & 15, fq = lane >> 4;
    const int K = g.K, nt = K / BK;
    unsigned voffA[2], voffB[2];
#pragma unroll
    for (int i = 0; i < 2; ++i) { int R, C; stage_rc(tid * 16 + i * 8192, R, C); const int Rb = (R & ~31) + perm32(R & 31);
        voffA[i] = (unsigned)(R * g.lda + C) * 2u; voffB[i] = (unsigned)(Rb * g.ldb + C) * 2u; }
    const size_t kstep = (size_t)(BK * 2);
    const size_t hstepA = (size_t)HALF * g.lda * 2, hstepB = (size_t)HALF * g.ldb * 2;
    const size_t rowA = (size_t)g.lda * 2, rowB = (size_t)g.ldb * 2;
    const unsigned ldsw = (unsigned)wid * 1024u;
    const int aoff = lds_byte(wr * 64 + fr, fq * 8), boff = lds_byte(wc * 32 + fr, fq * 8);
#define PG8_SA(b, h) (((b) * 2 + (h)) * HTB)
#define PG8_SB(b, h) ((4 + (b) * 2 + (h)) * HTB)
#define PG8_STAGE(bufoff, gbase, voff) do { _Pragma("unroll") for (int _i = 0; _i < 2; ++_i) \
        __builtin_amdgcn_global_load_lds((const unsigned*)((const char*)(gbase) + (voff)[_i]), (LAS unsigned*)(lds + (bufoff) + ldsw + _i * 8192), 16, 0, 0); } while (0)
#define PG8_LDA(dst, b, h) do { _Pragma("unroll") for (int m = 0; m < 4; ++m) _Pragma("unroll") for (int k = 0; k < 2; ++k) dst[m][k] = *(const LAS bf16x8*)(lds + PG8_SA(b, h) + aoff + m * 2048 + k * 1024); } while (0)
#define PG8_LDB(dst, b, h) do { _Pragma("unroll") for (int n = 0; n < 2; ++n) _Pragma("unroll") for (int k = 0; k < 2; ++k) dst[n][k] = *(const LAS bf16x8*)(lds + PG8_SB(b, h) + boff + n * 2048 + k * 1024); } while (0)
#define PG8_MMA(ai, bj, At, Bt) do { __builtin_amdgcn_s_setprio(1); _Pragma("unroll") for (int m = 0; m < 4; ++m) _Pragma("unroll") for (int n = 0; n < 2; ++n) _Pragma("unroll") for (int k = 0; k < 2; ++k) \
        acc[ai][bj][m][n] = __builtin_amdgcn_mfma_f32_16x16x32_bf16(Bt[n][k], At[m][k], acc[ai][bj][m][n], 0, 0, 0); __builtin_amdgcn_s_setprio(0); } while (0)
#define PG8_WAIT_V(n) asm volatile("s_waitcnt vmcnt(" #n ")" ::: "memory")
#define PG8_WAIT_L(n) asm volatile("s_waitcnt lgkmcnt(" #n ")" ::: "memory")
#define PG8_BAR __builtin_amdgcn_s_barrier()
#define PG8_SCHED __builtin_amdgcn_sched_barrier(0)
    Unit cur, nxt; int ui = 0;
    if (!next_unit(g, G, bx, vc, 0, cur)) return;
    Acc acc;
#pragma unroll
    for (int a = 0; a < 2; ++a)
#pragma unroll
        for (int b = 0; b < 2; ++b)
#pragma unroll
            for (int m = 0; m < 4; ++m)
#pragma unroll
                for (int n = 0; n < 2; ++n) acc[a][b][m][n] = (f32x4){0.f, 0.f, 0.f, 0.f};
    bf16x8 At[4][2], B0[2][2], B1[2][2];
    const char* cA = (const char*)g.A + (size_t)cur.arow * rowA; const char* cB = (const char*)g.Bt + (size_t)cur.brow * rowB;
    PG8_STAGE(PG8_SB(0, 0), cB, voffB); PG8_STAGE(PG8_SB(0, 1), cB + hstepB, voffB); PG8_STAGE(PG8_SA(0, 0), cA, voffA); PG8_STAGE(PG8_SA(0, 1), cA + hstepA, voffA);
    if (wr == 1) PG8_BAR;
    PG8_WAIT_V(2); PG8_BAR;
    PG8_STAGE(PG8_SB(1, 0), cB + kstep, voffB); PG8_STAGE(PG8_SA(1, 0), cA + kstep, voffA); PG8_STAGE(PG8_SB(1, 1), cB + hstepB + kstep, voffB);
    PG8_WAIT_V(6); PG8_BAR;
    for (;;) {
        const bool has_next = next_unit(g, G, bx, vc, ui + 1, nxt);
        const char* nA = has_next ? (const char*)g.A + (size_t)nxt.arow * rowA : cA; const char* nB = has_next ? (const char*)g.Bt + (size_t)nxt.brow * rowB : cB;
        for (int t = 0; t < nt; t += 2) {
            const bool last = (t == nt - 2);
            const char* a1 = cA + (size_t)(t + 1) * kstep;
            const char* a2 = last ? nA : cA + (size_t)(t + 2) * kstep; const char* b2 = last ? nB : cB + (size_t)(t + 2) * kstep;
            const char* a3 = a2 + kstep; const char* b3 = b2 + kstep;
            PG8_LDB(B0, 0, 0); PG8_LDB(B1, 0, 1); PG8_SCHED; PG8_LDA(At, 0, 0); PG8_STAGE(PG8_SA(1, 1), a1 + hstepA, voffA);
            PG8_WAIT_V(8); PG8_WAIT_L(0); PG8_BAR; PG8_MMA(0, 0, At, B0); PG8_MMA(0, 1, At, B1); PG8_BAR; PG8_SCHED;
            PG8_LDA(At, 0, 1); PG8_STAGE(PG8_SB(0, 0), b2, voffB); PG8_STAGE(PG8_SB(0, 1), b2 + hstepB, voffB); PG8_STAGE(PG8_SA(0, 0), a2, voffA);
            PG8_WAIT_V(8); PG8_WAIT_L(0); PG8_BAR; PG8_MMA(1, 0, At, B0); PG8_MMA(1, 1, At, B1); PG8_BAR; PG8_SCHED;
            PG8_LDB(B0, 1, 0); PG8_LDB(B1, 1, 1); PG8_SCHED; PG8_LDA(At, 1, 0); PG8_STAGE(PG8_SA(0, 1), a2 + hstepA, voffA);
            PG8_WAIT_V(8); PG8_WAIT_L(0); PG8_BAR; PG8_MMA(0, 0, At, B0); PG8_MMA(0, 1, At, B1); PG8_BAR; PG8_SCHED;
            PG8_LDA(At, 1, 1); PG8_STAGE(PG8_SB(1, 0), b3, voffB); PG8_STAGE(PG8_SB(1, 1), b3 + hstepB, voffB); PG8_STAGE(PG8_SA(1, 0), a3, voffA);
            PG8_WAIT_V(8); PG8_WAIT_L(0); PG8_BAR; PG8_MMA(1, 0, At, B0); PG8_MMA(1, 1, At, B1); PG8_BAR; PG8_SCHED;
        }
        if (wr == 0) PG8_BAR;
        epilogue(g, acc, cur);
        if (!has_next) break;
#pragma unroll
        for (int a = 0; a < 2; ++a)
#pragma unroll
            for (int b = 0; b < 2; ++b)
#pragma unroll
                for (int m = 0; m < 4; ++m)
#pragma unroll
                    for (int n = 0; n < 2; ++n) acc[a][b][m][n] = (f32x4){0.f, 0.f, 0.f, 0.f};
        cur = nxt; cA = nA; cB = nB; ++ui;
        if (wr == 1) PG8_BAR;
    }
    PG8_WAIT_V(0);
    PG8_BAR;
#undef PG8_SA
#undef PG8_SB
#undef PG8_STAGE
#undef PG8_LDA
#undef PG8_LDB
#undef PG8_MMA
#undef PG8_WAIT_V
#undef PG8_WAIT_L
#undef PG8_BAR
#undef PG8_SCHED
}
}

#define XB_TMO      128
#define XB_XCNT(j)  (256  + 64 * (j))
#define XB_XSUB(j)  (1280 + 64 * (j))
#define XB_XGEN(j)  (2304 + 64 * (j))
#define XB_TOP      3328
#define XB_TOPGEN   3392
#define XCD_BAR_WORDS 3456
#define XB_SPIN_CAP (1u << 22)
__device__ __forceinline__ unsigned xb_ld(unsigned* p)              { return __hip_atomic_load(p, __ATOMIC_RELAXED, __HIP_MEMORY_SCOPE_AGENT); }
__device__ __forceinline__ unsigned xb_add(unsigned* p, unsigned v) { return __hip_atomic_fetch_add(p, v, __ATOMIC_RELAXED, __HIP_MEMORY_SCOPE_AGENT); }
__device__ __forceinline__ unsigned xb_xcc_id() { return (unsigned)__builtin_amdgcn_s_getreg((3 << 11) | 20) & 0xFu; }
#define XB_SPIN(cond, bar) do { unsigned _sp = 0; while (cond) { __builtin_amdgcn_s_sleep(1); \
    if ((++_sp & 255u) == 0u) { if (xb_ld(&(bar)[XB_TMO])) break; if (_sp > XB_SPIN_CAP) { atomicAdd(&(bar)[XB_TMO], 1u); break; } } } } while (0)
struct XcdBarrier { unsigned* bar; unsigned x; volatile LAS unsigned* st; };
__device__ __forceinline__ XcdBarrier xcd_barrier_post(unsigned* bar, volatile LAS unsigned* st) {
    XcdBarrier b; b.bar = bar; b.x = xb_xcc_id(); b.st = st;
    if (threadIdx.x == 0) (void)xb_add(&bar[XB_XCNT(b.x)], 1u);
    return b;
}
__device__ __forceinline__ void xcd_barrier_complete(unsigned* bar, unsigned x, unsigned& nloc, unsigned& nx) {
    const unsigned G = gridDim.x * gridDim.y * gridDim.z;
    unsigned sum, cnt, mine, sp = 0u;
    for (;;) {
        sum = 0u; cnt = 0u; mine = 0u;
#pragma unroll
        for (unsigned j = 0; j < 16; ++j) { const unsigned c = xb_ld(&bar[XB_XCNT(j)]); sum += c; cnt += (c > 0u) ? 1u : 0u; mine = (j == x) ? c : mine; }
        if (sum == G) break;
        __builtin_amdgcn_s_sleep(1);
        if ((++sp & 255u) == 0u) { if (xb_ld(&bar[XB_TMO])) break; if (sp > XB_SPIN_CAP) { atomicAdd(&bar[XB_TMO], 1u); break; } }
    }
    nloc = mine > 0u ? mine : 1u; nx = cnt > 0u ? cnt : 1u;
}
__device__ __forceinline__ void xcd_barrier(const XcdBarrier& b) {
    asm volatile("s_waitcnt vmcnt(0)" ::: "memory");
    __syncthreads();
    if (threadIdx.x == 0) {
        unsigned* bar = b.bar;
        __builtin_amdgcn_s_waitcnt(0);
        unsigned nloc = b.st[0], nx = b.st[1];
        if (nloc == 0u) { xcd_barrier_complete(bar, b.x, nloc, nx); b.st[0] = nloc; b.st[1] = nx; }
        const unsigned old = xb_add(&bar[XB_XSUB(b.x)], 1u);
        const unsigned gen = old / nloc;
        if (old + 1u == (gen + 1u) * nloc) {
            __builtin_amdgcn_fence(__ATOMIC_RELEASE, "agent");
            asm volatile("s_waitcnt vmcnt(0)" ::: "memory");
            const unsigned og = xb_add(&bar[XB_TOP], 1u);
            const unsigned tg = og / nx;
            if (og + 1u == (tg + 1u) * nx) xb_add(&bar[XB_TOPGEN], 1u);
            else XB_SPIN(xb_ld(&bar[XB_TOPGEN]) == tg, bar);
            __builtin_amdgcn_fence(__ATOMIC_ACQUIRE, "agent");
            xb_add(&bar[XB_XGEN(b.x)], 1u);
            asm volatile("s_waitcnt vmcnt(0)" ::: "memory");
        } else {
            XB_SPIN(xb_ld(&bar[XB_XGEN(b.x)]) == gen, bar);
            __builtin_amdgcn_fence(__ATOMIC_ACQUIRE, "agent");
            asm volatile("s_waitcnt vmcnt(0)" ::: "memory");
        }
    }
    __syncthreads();
}

struct Params {
    const float* in[27];
    float* out;
    unsigned char* ws;
};

struct Ctx { LAS unsigned char* lds; int tid, lane, wid, G, bx, vc; };

__device__ __forceinline__ bool wdesc(int i, const Params& p, const float*& src, bf16_t*& dst, int& K, int& N, int& glu, const float*& gain) {
    unsigned char* ws = p.ws; glu = 0; gain = nullptr;
    if (i < 4) { gain = p.in[3] + i * DM; src = p.in[5] + (size_t)i * DM * FF; dst = (bf16_t*)(ws + (i < 2 ? WS_UP01 : WS_UP23)) + (size_t)(i & 1) * DM * FF; K = DM; N = FF; return true; }
    if (i < 8) { const int l = i - 4; src = p.in[6] + (size_t)l * DM * FF; dst = (bf16_t*)(ws + (l < 2 ? WS_DN01 : WS_DN23)) + (size_t)(l & 1) * DM * FF; K = FF; N = DM; return true; }
    if (i < 10) { const int l = i - 8; gain = p.in[1] + l * DM; src = p.in[7] + (size_t)l * DM * DM; dst = (bf16_t*)(ws + WS_WIN) + (size_t)l * DM * DM; K = DM; N = DM; return true; }
    if (i < 12) { const int l = i - 10; src = p.in[16] + (size_t)l * DM * 2 * DM; dst = (bf16_t*)(ws + WS_GLU) + (size_t)l * DM * 2 * DM; K = DM; N = 2 * DM; glu = 1; return true; }
    if (i < 13) { gain = p.in[17]; src = p.in[18]; dst = (bf16_t*)(ws + WS_KVW); K = DM; N = 2 * DM; return true; }
    if (i < 15) { const int l = i - 13; gain = p.in[1] + (2 + l) * DM; src = p.in[19] + (size_t)l * DM * DM; dst = (bf16_t*)(ws + WS_QW) + (size_t)l * DM * DM; K = DM; N = DM; return true; }
    if (i < 17) { const int l = i - 15; src = p.in[25] + (size_t)l * DM * DM; dst = (bf16_t*)(ws + WS_OW) + (size_t)l * DM * DM; K = DM; N = DM; return true; }
    return false;
}
__device__ __forceinline__ bool wlocate(int f, const Params& p, const float*& src, bf16_t*& dst, int& K, int& N, int& n0, int& k0, int& sc0, const float*& gain) {
    int base = 0;
    for (int i = 0; ; ++i) {
        int glu;
        if (!wdesc(i, p, src, dst, K, N, glu, gain)) return false;
        const int ntk = K >> 6, nt = ntk * (N >> 6);
        if (f < base + nt) { const int t = f - base; n0 = (t / ntk) << 6; k0 = (t % ntk) << 6;
            sc0 = glu ? (((n0 >> 7) & 1) * DM + (n0 >> 8) * 128 + (n0 & 127)) : n0; return true; }
        base += nt;
    }
}
constexpr int NCONV_TILES = 11264;
__device__ void convert_weights(const Ctx& c, const Params& p) {
    LAS float* T = (LAS float*)c.lds;
    int f, fstep, fend;
    if (c.G == 256) { if (c.bx < 128) { f = c.bx; fstep = 128; fend = 128 * 38; } else { f = 128 * 38 + (c.bx - 128); fstep = 128; fend = NCONV_TILES; } }
    else { f = c.bx; fstep = c.G; fend = NCONV_TILES; }
    const float* src; bf16_t* dst; int K, N, n0, k0, sc0; const float* gain;
    bool have = (f < fend) && wlocate(f, p, src, dst, K, N, n0, k0, sc0, gain);
    f32x4 v0, v1;
    const int ctid = opaque_tid(); const int kk = ctid >> 4, c4 = (ctid & 15) * 4;
    if (have) { v0 = *(const f32x4*)(src + (size_t)(k0 + kk) * N + sc0 + c4); v1 = *(const f32x4*)(src + (size_t)(k0 + 32 + kk) * N + sc0 + c4); if (gain) { v0 = v0 * gain[k0 + kk]; v1 = v1 * gain[k0 + 32 + kk]; } }
    int par = 0;
    while (have) {
        const f32x4 a0 = v0, a1 = v1; bf16_t* cdst = dst; const int cK = K, cn0 = n0, ck0 = k0;
        f += fstep;
        have = (f < fend) && wlocate(f, p, src, dst, K, N, n0, k0, sc0, gain);
        if (have) { v0 = *(const f32x4*)(src + (size_t)(k0 + kk) * N + sc0 + c4); v1 = *(const f32x4*)(src + (size_t)(k0 + 32 + kk) * N + sc0 + c4); if (gain) { v0 = v0 * gain[k0 + kk]; v1 = v1 * gain[k0 + 32 + kk]; } }
        LAS float* Tb = T + par * (64 * 65);
        Tb[(c4 + 0) * 65 + kk] = a0[0]; Tb[(c4 + 1) * 65 + kk] = a0[1]; Tb[(c4 + 2) * 65 + kk] = a0[2]; Tb[(c4 + 3) * 65 + kk] = a0[3];
        Tb[(c4 + 0) * 65 + 32 + kk] = a1[0]; Tb[(c4 + 1) * 65 + 32 + kk] = a1[1]; Tb[(c4 + 2) * 65 + 32 + kk] = a1[2]; Tb[(c4 + 3) * 65 + 32 + kk] = a1[3];
        __syncthreads();
        { const int nn = ctid >> 3, k8 = (ctid & 7) * 8; const LAS float* r = Tb + nn * 65 + k8;
          u32x4 w; w.x = cvt_pk_bf16(r[0], r[1]); w.y = cvt_pk_bf16(r[2], r[3]); w.z = cvt_pk_bf16(r[4], r[5]); w.w = cvt_pk_bf16(r[6], r[7]);
          *(u32x4*)(cdst + (size_t)(cn0 + nn) * cK + ck0 + k8) = w; }
        par ^= 1;
    }
    __syncthreads();
}

__device__ void ssm_tables(const Ctx& c, const Params& p, int layer, int g) {
    LAS float* lamp = (LAS float*)c.lds;
    LAS float* bbar = lamp + 33 * 64 * 2;
    LAS float* ccp = bbar + 64 * 16 * 2;
    LAS float* Kt = ccp + 16 * 64 * 2;
    LAS float* coef = Kt + 32 * 256;
    const int tid = opaque_tid();
    const size_t lg = (size_t)layer * NG + g;
    if (tid < 64) {
        const int pp = tid;
        const float dt = expf(p.in[10][lg]);
        const float lr = p.in[8][lg * NP + pp], li = p.in[9][lg * NP + pp];
        const float mag = expf(lr * dt), ar = mag * cosf(li * dt), ai = mag * sinf(li * dt);
        const float den = lr * lr + li * li;
        coef[pp * 2] = ((ar - 1.0f) * lr + ai * li) / den; coef[pp * 2 + 1] = (ai * lr - (ar - 1.0f) * li) / den;
        float pr = 1.0f, pi = 0.0f; asm volatile("" : "+v"(pr), "+v"(pi));
        for (int k = 0; k <= 32; ++k) { lamp[(k * 64 + pp) * 2] = pr; lamp[(k * 64 + pp) * 2 + 1] = pi; const float nr = pr * ar - pi * ai, ni = pr * ai + pi * ar; pr = nr; pi = ni; }
        float* lamL = (float*)(p.ws + WS_LAML) + (lg * NP + pp) * 2;
        lamL[0] = lamp[(32 * 64 + pp) * 2]; lamL[1] = lamp[(32 * 64 + pp) * 2 + 1];
    }
    __syncthreads();
    for (int e = tid; e < 1024; e += 512) {
        const int pp = e >> 4, cc = e & 15;
        const float br = p.in[11][lg * 1024 + e], bi = p.in[12][lg * 1024 + e], cr = coef[pp * 2], ci = coef[pp * 2 + 1];
        bbar[e * 2] = cr * br - ci * bi; bbar[e * 2 + 1] = cr * bi + ci * br;
        ccp[e * 2] = p.in[13][lg * 1024 + e]; ccp[e * 2 + 1] = p.in[14][lg * 1024 + e];
        (void)cc;
    }
    __syncthreads();
    {
        const int k = tid >> 4, co = tid & 15;
        float acc16[16];
#pragma unroll
        for (int q = 0; q < 16; ++q) acc16[q] = 0.f;
        for (int pp = 0; pp < 64; ++pp) {
            const float lr = lamp[(k * 64 + pp) * 2], li = lamp[(k * 64 + pp) * 2 + 1], cr = ccp[(co * 64 + pp) * 2], ci = ccp[(co * 64 + pp) * 2 + 1];
            const float wr = cr * lr - ci * li, wi = cr * li + ci * lr;
            const LAS f32x4* bb = (const LAS f32x4*)(bbar + pp * 32);
#pragma unroll
            for (int q = 0; q < 8; ++q) { const f32x4 b = bb[q]; acc16[2 * q] += wr * b[0] - wi * b[1]; acc16[2 * q + 1] += wr * b[2] - wi * b[3]; }
        }
#pragma unroll
        for (int q = 0; q < 16; ++q) Kt[(k * 16 + co) * 16 + q] = acc16[q];
    }
    __syncthreads();
    bf16_t* Tm = (bf16_t*)(p.ws + WS_TM) + (size_t)layer * NG * 512 * UGP + (size_t)g * 512 * UGP;
    for (int e = tid; e < 512 * 80; e += 512) {
        const int row = e / 80, ch = e % 80, j = row >> 4, co = row & 15;
        float v[8];
        if (ch < 64) { const int i = ch >> 1, ci0 = (ch & 1) * 8;
#pragma unroll
            for (int q = 0; q < 8; ++q) v[q] = (i <= j) ? Kt[((j - i) * 16 + co) * 16 + ci0 + q] : 0.f;
        } else { const int p0 = (ch - 64) * 8;
#pragma unroll
            for (int q = 0; q < 8; ++q) { const int pq = p0 + q, pp = pq & 63;
                const float lr = lamp[((j + 1) * 64 + pp) * 2], li = lamp[((j + 1) * 64 + pp) * 2 + 1], cr = ccp[(co * 64 + pp) * 2], ci = ccp[(co * 64 + pp) * 2 + 1];
                v[q] = pq < 64 ? (cr * lr - ci * li) : -(cr * li + ci * lr); }
        }
        u32x4 w; w.x = cvt_pk_bf16(v[0], v[1]); w.y = cvt_pk_bf16(v[2], v[3]); w.z = cvt_pk_bf16(v[4], v[5]); w.w = cvt_pk_bf16(v[6], v[7]);
        *(u32x4*)(Tm + (size_t)row * UGP + ch * 8) = w;
    }
    bf16_t* Sin = (bf16_t*)(p.ws + WS_SIN) + (size_t)layer * NG * 128 * 512 + (size_t)g * 128 * 512;
    for (int e = tid; e < 128 * 64; e += 512) {
        const int row = e >> 6, ch = e & 63, pp = row & 63, i = ch >> 1, ci0 = (ch & 1) * 8;
        const float lr = lamp[((31 - i) * 64 + pp) * 2], li = lamp[((31 - i) * 64 + pp) * 2 + 1];
        float v[8];
#pragma unroll
        for (int q = 0; q < 8; ++q) { const float br = bbar[(pp * 16 + ci0 + q) * 2], bi = bbar[(pp * 16 + ci0 + q) * 2 + 1]; v[q] = row < 64 ? (lr * br - li * bi) : (lr * bi + li * br); }
        u32x4 w; w.x = cvt_pk_bf16(v[0], v[1]); w.y = cvt_pk_bf16(v[2], v[3]); w.z = cvt_pk_bf16(v[4], v[5]); w.w = cvt_pk_bf16(v[6], v[7]);
        *(u32x4*)(Sin + (size_t)row * 512 + ch * 8) = w;
    }
    __syncthreads();
}

__device__ void small_tables(const Ctx& c, const Params& p) {
    float* bt = (float*)(p.ws + WS_BIAS);
    const int stid = opaque_tid();
    for (int e = stid; e < 8 * 128; e += 512) {
        const int h = e >> 7, n = e & 127;
        int bk = n;
        if (n >= 16) { const int th[16] = {16, 19, 21, 24, 27, 31, 35, 40, 46, 52, 59, 67, 77, 87, 99, 113}; bk = 15;
#pragma unroll
            for (int q = 0; q < 16; ++q) bk += (n >= th[q]) ? 1 : 0; }
        bt[e] = (p.in[26][bk * 8 + h] - p.in[26][31 * 8 + h]) * LOG2E;
    }
    if (stid < 2) {
        const int j = stid; float s1 = 0.f, s2 = 0.f;
        for (int q = 0; q < 64; ++q) { s1 += p.in[20][j * 64 + q] * p.in[21][j * 64 + q]; s2 += p.in[22][j * 64 + q] * p.in[23][j * 64 + q]; }
        const float li = 0.8f - 0.6f * expf(-0.3f * (float)(j + 2));
        float* sc = (float*)(p.ws + WS_SCAL) + j * 4;
        sc[0] = expf(s1) - expf(s2) + li; sc[1] = 1.0f - li; sc[2] = 0.f; sc[3] = 0.f;
    }
}

__device__ void norm_phase(const Ctx& c, const void* xin_, int xin_f32, void* xout_, int xout_f32, const bf16_t* mix, const float* gpost, float* rsout) {
    const float* xin = (const float*)xin_; const bf16_t* xin16 = (const bf16_t*)xin_; float* xout = (float*)xout_; bf16_t* xout16 = (bf16_t*)xout_;
    const int tid_ = opaque_tid(), lane = tid_ & 63, wid_ = __builtin_amdgcn_readfirstlane(tid_ >> 6);
    for (int r0 = (wid_ * c.G + c.bx) * 4; r0 < TOK; r0 += 8 * c.G * 4) {
        f32x4 xv[4][4]; u32x4 xw[4][2]; u32x4 mw[4][2];
        if (xin_f32) {
#pragma unroll
            for (int rr = 0; rr < 4; ++rr)
#pragma unroll
                for (int k = 0; k < 2; ++k) { const float* xp = xin + (size_t)(r0 + rr) * DM + k * 512 + lane * 8; xv[rr][2 * k] = *(const f32x4*)xp; xv[rr][2 * k + 1] = *(const f32x4*)(xp + 4); }
        } else {
#pragma unroll
            for (int rr = 0; rr < 4; ++rr)
#pragma unroll
                for (int k = 0; k < 2; ++k) xw[rr][k] = *(const u32x4*)(xin16 + (size_t)(r0 + rr) * DM + k * 512 + lane * 8);
        }
        if (mix) {
#pragma unroll
            for (int rr = 0; rr < 4; ++rr)
#pragma unroll
                for (int k = 0; k < 2; ++k) mw[rr][k] = *(const u32x4*)(mix + (size_t)(r0 + rr) * DM + k * 512 + lane * 8);
        }
#pragma unroll
        for (int rr = 0; rr < 4; ++rr) {
            const int row = r0 + rr;
            float x[16];
            if (xin_f32) {
#pragma unroll
                for (int q = 0; q < 4; ++q)
#pragma unroll
                    for (int e = 0; e < 4; ++e) x[q * 4 + e] = xv[rr][q][e];
            } else {
#pragma unroll
                for (int k = 0; k < 2; ++k) { const u32x4 w = xw[rr][k];
                    x[k * 8 + 0] = bf_lo(w.x); x[k * 8 + 1] = bf_hi(w.x); x[k * 8 + 2] = bf_lo(w.y); x[k * 8 + 3] = bf_hi(w.y); x[k * 8 + 4] = bf_lo(w.z); x[k * 8 + 5] = bf_hi(w.z); x[k * 8 + 6] = bf_lo(w.w); x[k * 8 + 7] = bf_hi(w.w); }
            }
            if (mix) {
                float mv[16]; float ss = 0.f;
#pragma unroll
                for (int k = 0; k < 2; ++k) { const u32x4 w = mw[rr][k];
                    mv[k * 8 + 0] = bf_lo(w.x); mv[k * 8 + 1] = bf_hi(w.x); mv[k * 8 + 2] = bf_lo(w.y); mv[k * 8 + 3] = bf_hi(w.y); mv[k * 8 + 4] = bf_lo(w.z); mv[k * 8 + 5] = bf_hi(w.z); mv[k * 8 + 6] = bf_lo(w.w); mv[k * 8 + 7] = bf_hi(w.w); }
#pragma unroll
                for (int e = 0; e < 16; ++e) ss += mv[e] * mv[e];
                ss = wave_sum(ss);
                const float rs = rsqrtf(ss * (1.0f / DM) + EPS);
#pragma unroll
                for (int k = 0; k < 2; ++k) { const float* gp = gpost + k * 512 + lane * 8; const f32x4 ga = *(const f32x4*)gp, gb = *(const f32x4*)(gp + 4);
#pragma unroll
                    for (int e = 0; e < 4; ++e) { x[k * 8 + e] += mv[k * 8 + e] * rs * ga[e]; x[k * 8 + 4 + e] += mv[k * 8 + 4 + e] * rs * gb[e]; } }
            }
#pragma unroll
            for (int k = 0; k < 2; ++k) {
                if (xout_f32) { float* xo = xout + (size_t)row * DM + k * 512 + lane * 8;
                    *(f32x4*)xo = (f32x4){x[k * 8 + 0], x[k * 8 + 1], x[k * 8 + 2], x[k * 8 + 3]}; *(f32x4*)(xo + 4) = (f32x4){x[k * 8 + 4], x[k * 8 + 5], x[k * 8 + 6], x[k * 8 + 7]}; }
                else { u32x4 wx; wx.x = cvt_pk_bf16(x[k * 8 + 0], x[k * 8 + 1]); wx.y = cvt_pk_bf16(x[k * 8 + 2], x[k * 8 + 3]); wx.z = cvt_pk_bf16(x[k * 8 + 4], x[k * 8 + 5]); wx.w = cvt_pk_bf16(x[k * 8 + 6], x[k * 8 + 7]);
                    *(u32x4*)(xout16 + (size_t)row * DM + k * 512 + lane * 8) = wx;
                    x[k * 8 + 0] = bf_lo(wx.x); x[k * 8 + 1] = bf_hi(wx.x); x[k * 8 + 2] = bf_lo(wx.y); x[k * 8 + 3] = bf_hi(wx.y); x[k * 8 + 4] = bf_lo(wx.z); x[k * 8 + 5] = bf_hi(wx.z); x[k * 8 + 6] = bf_lo(wx.w); x[k * 8 + 7] = bf_hi(wx.w); }
            }
            if (rsout) {
                float ss = 0.f;
#pragma unroll
                for (int e = 0; e < 16; ++e) ss += x[e] * x[e];
                ss = wave_sum(ss);
                if (lane == 0) rsout[row] = rsqrtf(ss * (1.0f / DM) + EPS);
            }
        }
    }
}

__device__ void scan_phase(const Ctx& c, const Params& p, int layer) {
    const float* Z = (const float*)(p.ws + WS_Z); bf16_t* Ug = (bf16_t*)(p.ws + WS_UG);
    const float* lamL = (const float*)(p.ws + WS_LAML) + (size_t)layer * NG * NP * 2;
    const int tid_ = opaque_tid(), wid_ = __builtin_amdgcn_readfirstlane(tid_ >> 6);
    for (int pr = wid_ * c.G + c.bx; pr < 4 * NG; pr += 8 * c.G) {
        const int b = pr >> 6, g = pr & 63, pp = tid_ & 63;
        const float lr = lamL[(g * NP + pp) * 2], li = lamL[(g * NP + pp) * 2 + 1];
        float sr = 0.f, si = 0.f;
        const size_t row0 = (size_t)g * NCH + b * 256;
#pragma unroll 8
        for (int ch = 0; ch < 256; ++ch) {
            const float zr = Z[(row0 + ch) * 128 + pp], zi = Z[(row0 + ch) * 128 + 64 + pp];
            bf16_t* o = Ug + (row0 + ch) * UGP + 512 + pp;
            const unsigned w = cvt_pk_bf16(sr, si);
            o[0] = (bf16_t)(w & 0xffffu); o[64] = (bf16_t)(w >> 16);
            const float nr = lr * sr - li * si + zr, ni = lr * si + li * sr + zi; sr = nr; si = ni;
        }
    }
}

__device__ void scan_after_z(const Ctx& c, const Params& p, int layer) {
    asm volatile("s_waitcnt vmcnt(0)" ::: "memory"); __syncthreads();
    __builtin_amdgcn_fence(__ATOMIC_ACQUIRE, "agent");
    asm volatile("s_waitcnt vmcnt(0)" ::: "memory");
    const float* Z = (const float*)(p.ws + WS_Z); bf16_t* Ug = (bf16_t*)(p.ws + WS_UG);
    const float* lamL = (const float*)(p.ws + WS_LAML) + (size_t)layer * NG * NP * 2;
    const int tid_ = opaque_tid(), wid_ = __builtin_amdgcn_readfirstlane(tid_ >> 6), pp = tid_ & 63;
    for (int i = wid_; ; i += 8) {
        const int L = i * c.G + c.vc; if (L >= 4 * NG) break;
        const int g = L >> 2, b = L & 3;
        const float lr = lamL[(g * NP + pp) * 2], li = lamL[(g * NP + pp) * 2 + 1];
        float sr = 0.f, si = 0.f;
        const size_t row0 = (size_t)g * NCH + b * 256;
#pragma unroll 8
        for (int ch = 0; ch < 256; ++ch) {
            const float zr = Z[(row0 + ch) * 128 + pp], zi = Z[(row0 + ch) * 128 + 64 + pp];
            bf16_t* o = Ug + (row0 + ch) * UGP + 512 + pp;
            const unsigned w = cvt_pk_bf16(sr, si);
            o[0] = (bf16_t)(w & 0xffffu); o[64] = (bf16_t)(w >> 16);
            const float nr = lr * sr - li * si + zr, ni = lr * si + li * sr + zi; sr = nr; si = ni;
        }
    }
}

#define ATTN_DMA(gp, ldsoff) __builtin_amdgcn_global_load_lds((const unsigned*)(gp), (LAS unsigned*)(lds + (ldsoff)), 16, 0, 0)
#define ATTN_PV(PB, VA) do { \
    bf16x8 fa__[8], fb__[8]; \
    _Pragma("unroll") for (int q_ = 0; q_ < 8; ++q_) fa__[q_] = *(LAS const bf16x8*)(VA[q_ & 3] + (q_ >> 2) * 4096); \
    __builtin_amdgcn_sched_barrier(0); \
    _Pragma("unroll") for (int q_ = 0; q_ < 8; ++q_) fb__[q_] = *(LAS const bf16x8*)(VA[q_ & 3] + (2 + (q_ >> 2)) * 4096); \
    _Pragma("unroll") for (int q_ = 0; q_ < 8; ++q_) o[q_ & 1] = __builtin_amdgcn_mfma_f32_32x32x16_bf16(fa__[(q_ & 1) * 4 + (q_ >> 1)], PB[q_ >> 1], o[q_ & 1], 0, 0, 0); \
    __builtin_amdgcn_sched_barrier(0); \
    _Pragma("unroll") for (int q_ = 0; q_ < 8; ++q_) o[2 + (q_ & 1)] = __builtin_amdgcn_mfma_f32_32x32x16_bf16(fb__[(q_ & 1) * 4 + (q_ >> 1)], PB[q_ >> 1], o[2 + (q_ & 1)], 0, 0, 0); \
    __builtin_amdgcn_sched_barrier(0); } while (0)
#define ATTN_QK(P0, P1, KA) do { \
    bf16x8 kf_[4]; \
    _Pragma("unroll") for (int d0 = 0; d0 < 4; ++d0) kf_[d0] = *(LAS const bf16x8*)(KA[d0]); \
    __builtin_amdgcn_sched_barrier(0); \
    P0 = __builtin_amdgcn_mfma_f32_32x32x16_bf16(kf_[0], qf[0], negm, 0, 0, 0); \
    _Pragma("unroll") for (int d0 = 1; d0 < 4; ++d0) P0 = __builtin_amdgcn_mfma_f32_32x32x16_bf16(kf_[d0], qf[d0], P0, 0, 0, 0); \
    __builtin_amdgcn_sched_barrier(0); \
    _Pragma("unroll") for (int d0 = 0; d0 < 4; ++d0) kf_[d0] = *(LAS const bf16x8*)(KA[d0] + 8192); \
    __builtin_amdgcn_sched_barrier(0); \
    P1 = __builtin_amdgcn_mfma_f32_32x32x16_bf16(kf_[0], qf[0], negm, 0, 0, 0); \
    _Pragma("unroll") for (int d0 = 1; d0 < 4; ++d0) P1 = __builtin_amdgcn_mfma_f32_32x32x16_bf16(kf_[d0], qf[d0], P1, 0, 0, 0); \
    __builtin_amdgcn_sched_barrier(0); } while (0)
#define ATTN_BAND(P0, P1, DD) do { \
    __builtin_amdgcn_sched_barrier(0); \
    _Pragma("unroll") for (int r = 0; r < 16; ++r) { const int d0_ = (DD) - (16 * (r >> 3) + (r & 7)); P0[r] += btab[1 + min(max(d0_, -1), 127)]; } \
    __builtin_amdgcn_sched_barrier(0); \
    _Pragma("unroll") for (int r = 0; r < 16; ++r) { const int d1_ = (DD) - 32 - (16 * (r >> 3) + (r & 7)); P1[r] += btab[1 + min(max(d1_, -1), 127)]; } \
    __builtin_amdgcn_sched_barrier(0); } while (0)
#define ATTN_EXP(P0, P1, PB) do { \
      \
    _Pragma("unroll") for (int r = 0; r < 16; ++r) { P0[r] = fexp2(P0[r]); P1[r] = fexp2(P1[r]); lrun += P0[r]; lrun += P1[r]; } \
    _Pragma("unroll") for (int q = 0; q < 2; ++q) { u32x4 w0_, w1_; \
        w0_.x = cvt_pk_bf16(P0[q * 8 + 0], P0[q * 8 + 1]); w0_.y = cvt_pk_bf16(P0[q * 8 + 2], P0[q * 8 + 3]); w0_.z = cvt_pk_bf16(P0[q * 8 + 4], P0[q * 8 + 5]); w0_.w = cvt_pk_bf16(P0[q * 8 + 6], P0[q * 8 + 7]); \
        w1_.x = cvt_pk_bf16(P1[q * 8 + 0], P1[q * 8 + 1]); w1_.y = cvt_pk_bf16(P1[q * 8 + 2], P1[q * 8 + 3]); w1_.z = cvt_pk_bf16(P1[q * 8 + 4], P1[q * 8 + 5]); w1_.w = cvt_pk_bf16(P1[q * 8 + 6], P1[q * 8 + 7]); \
        PB[q] = __builtin_bit_cast(bf16x8, w0_); PB[2 + q] = __builtin_bit_cast(bf16x8, w1_); } } while (0)
__device__ void attn_phase(const Ctx& c, const bf16_t* Q, const bf16_t* Kg, const bf16_t* Vt, bf16_t* ON, const float* biasT, const float* scal, const float* hn) {
    constexpr int SUB = 16384, STAGE = 32768, V_OFF = 65536, BT_OFF = 131072 + 128;
    LAS unsigned char* lds = c.lds;
    LAS unsigned char* ldsr = lds; asm volatile("" : "+s"(ldsr) :: "memory");
    for (int itu = 0; ; ++itu) {
        const int L = itu * c.G + c.vc; if (L >= 2048) break;
        const int tid = opaque_tid(), lane = tid & 63, wid = __builtin_amdgcn_readfirstlane(tid >> 6), br = wid >> 2, wq = wid & 3, l31 = lane & 31, hi = lane >> 5;
        const int prow = (l31 & ~12) | ((l31 & 4) << 1) | ((l31 & 8) >> 1);
        const int kbase = prow * 256, kx0 = (br * 8 + hi) ^ (prow & 15);
        const int vbase = V_OFF + l31 * 128, vx0 = hi ^ ((l31 >> 1) & 7);
        int ko[4], vo[4];
#pragma unroll
        for (int q = 0; q < 4; ++q) { ko[q] = (kx0 ^ (q << 1)) << 4; vo[q] = (vx0 ^ (q << 1)) << 4; }
        const int kr0 = 4 * wid + (lane >> 4), kc = (lane & 15) ^ (kr0 & 15);
        const int vr0 = 8 * wid + (lane >> 3), vcx = (lane & 7) ^ ((vr0 >> 1) & 7);
        const int dst0 = wid * 1024, dst1 = (wid + 8) * 1024;
        LAS const float* btab = (LAS const float*)(lds + BT_OFF);
        const int i7 = 7 - (L >> 8), pair = (L & 255) >> 3, jj8 = L & 7;
        const int qb = (i7 & 1) ? (16 * (i7 >> 1) + 15 - jj8) : (16 * (i7 >> 1) + jj8);
        const int b = pair >> 3, h = pair & 7, q0 = qb * 128, NI = qb + 1;
        const size_t tokb = (size_t)b * SEQ;
        const bf16_t* kg = Kg + (tokb + kr0) * DM + h * 128 + kc * 8;
        const bf16_t* vg = Vt + ((size_t)((b * 8 + h) * 128) << 13) + vr0 * 64 + vcx * 8;
        const bf16_t* qp = Q + (tokb + q0 + wq * 32 + l31) * DM + h * 128 + br * 64 + hi * 8;
        bf16x8 qf[4];
#pragma unroll
        for (int d0 = 0; d0 < 4; ++d0) qf[d0] = *(const bf16x8*)(qp + d0 * 16);
        if (tid < 128) ((LAS float*)(lds + BT_OFF))[1 + tid] = biasT[h * 128 + tid];
        if (tid == 128) ((LAS float*)(lds + BT_OFF))[0] = -1e30f;
#pragma unroll
        for (int sb = 0; sb < 2; ++sb) {
            ATTN_DMA(kg + (size_t)sb * 64 * DM, sb * SUB + dst0); ATTN_DMA(kg + (size_t)(sb * 64 + 32) * DM, sb * SUB + dst1);
            ATTN_DMA(vg + (size_t)sb * 8192, V_OFF + sb * SUB + dst0); ATTN_DMA(vg + (size_t)sb * 8192 + 4096, V_OFF + sb * SUB + dst1);
        }
        f32x16 o[4], negm;
#pragma unroll
        for (int r = 0; r < 16; ++r) { o[0][r] = 0.f; o[1][r] = 0.f; o[2][r] = 0.f; o[3][r] = 0.f; negm[r] = 0.f; }
        float lrun = 0.f;
        const int qrow = q0 + wq * 32 + l31;
        for (int it = 0; it < NI; ++it) {
            const int st = it & 1, kt0 = it * 128;
            asm volatile("s_waitcnt vmcnt(0) lgkmcnt(0)\n\ts_barrier" ::: "memory");
            if (it + 1 < NI) { const int s2 = (st ^ 1) * STAGE;
#pragma unroll
                for (int sb = 0; sb < 2; ++sb) { const bf16_t* kn = kg + (size_t)(kt0 + 128 + sb * 64) * DM; const bf16_t* vn = vg + (size_t)((it + 1) * 2 + sb) * 8192;
                    ATTN_DMA(kn, s2 + sb * SUB + dst0); ATTN_DMA(kn + 32 * DM, s2 + sb * SUB + dst1);
                    ATTN_DMA(vn, V_OFF + s2 + sb * SUB + dst0); ATTN_DMA(vn + 4096, V_OFF + s2 + sb * SUB + dst1); } }
            LAS const unsigned char* kbp = ldsr + st * STAGE + kbase;
            LAS const unsigned char* vbp = ldsr + st * STAGE + vbase;
#pragma unroll
            for (int sb = 0; sb < 2; ++sb) {
                LAS const unsigned char* ka_[4]; LAS const unsigned char* va_[4];
#pragma unroll
                for (int q = 0; q < 4; ++q) { ka_[q] = kbp + sb * SUB + ko[q]; va_[q] = vbp + sb * SUB + vo[q]; }
                f32x16 pa0, pa1;
                ATTN_QK(pa0, pa1, ka_);
                if (it >= NI - 2) { const int dd = qrow - kt0 - sb * 64 - 8 * hi; ATTN_BAND(pa0, pa1, dd); }
                float mxa = max3f(pa0[0], pa0[1], pa1[0]), mxb = max3f(pa0[2], pa0[3], pa1[1]); mxa = max3f(mxa, pa1[2], pa1[3]);
#pragma unroll
                for (int r = 4; r < 16; r += 4) { mxa = max3f(mxa, pa0[r], pa0[r + 1]); mxb = max3f(mxb, pa0[r + 2], pa0[r + 3]); mxa = max3f(mxa, pa1[r], pa1[r + 1]); mxb = max3f(mxb, pa1[r + 2], pa1[r + 3]); }
                float mx = max2f(mxa, mxb);
                { const auto rr_ = __builtin_amdgcn_permlane32_swap(__float_as_uint(mx), __float_as_uint(mx), false, false); mx = max2f(__uint_as_float(rr_[0]), __uint_as_float(rr_[1])); }
                if ((it == 0 && sb == 0) || __any(mx > 8.0f)) {
                    const float delta = (it == 0 && sb == 0) ? mx : fmaxf(mx, 0.f), alpha = fexp2(-delta); lrun *= alpha;
#pragma unroll
                    for (int r = 0; r < 16; ++r) { pa0[r] -= delta; pa1[r] -= delta; negm[r] -= delta; }
#pragma unroll
                    for (int q = 0; q < 4; ++q) o[q] = o[q] * alpha;
                }
                bf16x8 pk[4];
                ATTN_EXP(pa0, pa1, pk);
                ATTN_PV(pk, va_);
            }
        }
        __syncthreads();
        const int te = opaque_tid(), le31 = te & 31, hie = (te & 63) >> 5, wide = __builtin_amdgcn_readfirstlane(te >> 6), wqe = wide & 3;
        const float lam = scal[0], onem = scal[1];
        float inv = frcp(lrun + __shfl_xor(lrun, 32));
        if (wide >= 4) inv *= lam;
        LAS float* comb = (LAS float*)lds;
        if (wide >= 4) {
#pragma unroll
            for (int blk = 0; blk < 4; ++blk)
#pragma unroll
                for (int r = 0; r < 16; ++r) comb[(wqe * 128 + blk * 32 + (r & 3) + 8 * (r >> 2) + 4 * hie) * 32 + le31] = o[blk][r] * inv;
        }
        __syncthreads();
        if (wide < 4) {
            float ss = 0.f;
#pragma unroll
            for (int blk = 0; blk < 4; ++blk)
#pragma unroll
                for (int r = 0; r < 16; ++r) { const float v = o[blk][r] * inv - comb[(wqe * 128 + blk * 32 + (r & 3) + 8 * (r >> 2) + 4 * hie) * 32 + le31]; o[blk][r] = v; ss += v * v; }
            ss += __shfl_xor(ss, 32);
            const float rs = rsqrtf(ss * (1.0f / 128.0f) + EPS) * onem;
            bf16_t* op = ON + ((size_t)b * SEQ + q0 + wqe * 32 + le31) * DM + h * 128;
#pragma unroll
            for (int blk = 0; blk < 4; ++blk)
#pragma unroll
                for (int r4 = 0; r4 < 4; ++r4) { const int dv = blk * 32 + 8 * r4 + 4 * hie; const f32x4 g4 = *(const f32x4*)(hn + dv);
                    u32x2 w; w.x = cvt_pk_bf16(o[blk][r4 * 4 + 0] * rs * g4[0], o[blk][r4 * 4 + 1] * rs * g4[1]); w.y = cvt_pk_bf16(o[blk][r4 * 4 + 2] * rs * g4[2], o[blk][r4 * 4 + 3] * rs * g4[3]);
                    *(u32x2*)(op + dv) = w; }
        }
        __syncthreads();
    }
}
#undef ATTN_PV
#undef ATTN_QK
#undef ATTN_BAND
#undef ATTN_EXP
#undef ATTN_DMA

__global__ void __launch_bounds__(512, 2) yoco_fwd(Params p) {
    extern __shared__ __attribute__((aligned(16))) unsigned char lds_raw[];
    cg::grid_group grid = cg::this_grid();
    Ctx c; c.lds = (LAS unsigned char*)lds_raw; c.tid = threadIdx.x; c.lane = c.tid & 63; c.wid = __builtin_amdgcn_readfirstlane(c.tid >> 6);
    c.G = gridDim.x; c.bx = blockIdx.x; c.vc = (c.G % 8 == 0) ? (c.bx % 8) * (c.G / 8) + c.bx / 8 : c.bx;
    unsigned char* ws = p.ws;
    float* X = p.out;
    { volatile LAS unsigned* xst0 = (volatile LAS unsigned*)(c.lds + 131072); if (c.tid < 4) xst0[c.tid] = 0u; }
    __syncthreads();
    (void)xcd_barrier_post((unsigned*)(ws + WS_BAR), (volatile LAS unsigned*)(c.lds + 131072));
    bf16_t* HM = (bf16_t*)(ws + WS_HM); bf16_t* ACT = (bf16_t*)(ws + WS_ACT);
    bf16_t* UG = (bf16_t*)(ws + WS_UG); float* Zb = (float*)(ws + WS_Z); bf16_t* YG = (bf16_t*)(ws + WS_YG);
    bf16_t* Qb = (bf16_t*)(ws + WS_Q); bf16_t* ONb = (bf16_t*)(ws + WS_ON); bf16_t* HKV = (bf16_t*)(ws + WS_HKV);
    bf16_t* Kb = (bf16_t*)(ws + WS_K); bf16_t* Vtb = (bf16_t*)(ws + WS_VT);

    enum { K_PRO = 0, K_WIN = 1, K_Z = 2, K_SCAN = 3, K_Y = 4, K_GLU = 5, K_NORMA = 6, K_UP = 7, K_DOWN = 8, K_NORMB = 9, K_K = 10, K_VT = 11, K_Q = 12, K_ATTN = 13, K_O = 14 };
    for (int ph = 0; ph < 35; ++ph) {
        int kind, layer;
        if (ph == 0) { kind = K_PRO; layer = 0; }
        else if (ph < 19) { layer = (ph - 1) / 9; kind = 1 + (ph - 1) % 9; }
        else { int k; if (ph < 28) { layer = 2; k = ph - 19; } else { layer = 3; k = ph - 26; }
            kind = k < 3 ? K_K + k : (k == 3 ? K_ATTN : (k == 4 ? K_O : K_NORMA + (k - 5))); }
        const int j = layer & 1;
        if (kind == K_SCAN) continue;
        for (int rep = 0; rep < (((REPEAT_MASK >> kind) & 1) ? 2 : 1); ++rep) {
        { int t_ = threadIdx.x; asm volatile("" : "+v"(t_)); c.tid = t_; c.lane = t_ & 63; c.wid = __builtin_amdgcn_readfirstlane(t_ >> 6); }
        const bool is_gemm = (kind == K_WIN) | (kind == K_Z) | (kind == K_Y) | (kind == K_GLU) | (kind == K_UP) | (kind == K_DOWN) | (kind == K_K) | (kind == K_VT) | (kind == K_Q) | (kind == K_O);
        if (is_gemm) {
            pg8::Job jb; jb.lda = DM; jb.ldb = DM; jb.K = DM; jb.ord = pg8::ORD_STATIC; jb.M = TOK; jb.N = DM; jb.epi = pg8::EPI_STORE; jb.ldc = DM; jb.scale = 1.0f; jb.O = HM; jb.x1 = nullptr; jb.x2 = nullptr; jb.A = HM; jb.Bt = nullptr; jb.rev = 0;
            const bf16_t* X16 = (const bf16_t*)X; const float* RS = (const float*)(ws + WS_RS);
            switch (kind) {
            case K_WIN: jb.A = X16; jb.x2 = RS; jb.Bt = (const bf16_t*)(ws + WS_WIN) + (size_t)j * DM * DM; jb.epi = pg8::EPI_UG; jb.O = UG; break;
            case K_Z: jb.A = UG; jb.Bt = (const bf16_t*)(ws + WS_SIN) + (size_t)j * NG * 128 * 512; jb.lda = UGP; jb.ldb = 512; jb.K = 512; jb.ord = pg8::ORD_Z; jb.epi = pg8::EPI_Z; jb.O = Zb; break;
            case K_Y: jb.A = UG; jb.Bt = (const bf16_t*)(ws + WS_TM) + (size_t)j * NG * 512 * UGP; jb.lda = UGP; jb.ldb = UGP; jb.K = UGP; jb.ord = pg8::ORD_Y; jb.epi = pg8::EPI_Y; jb.O = YG; jb.x1 = UG; jb.x2 = p.in[15] + (size_t)j * DM; break;
            case K_GLU: jb.A = YG; jb.Bt = (const bf16_t*)(ws + WS_GLU) + (size_t)j * DM * 2 * DM; jb.N = 2 * DM; jb.epi = pg8::EPI_GLU; break;
            case K_UP: jb.A = layer == 3 ? (const bf16_t*)Kb : X16; jb.x2 = RS; jb.Bt = (const bf16_t*)(ws + (layer < 2 ? WS_UP01 : WS_UP23)) + (size_t)j * DM * FF; jb.N = FF; jb.epi = pg8::EPI_RELU2; jb.O = ACT; jb.ldc = FF; break;
            case K_DOWN: jb.A = ACT; jb.Bt = (const bf16_t*)(ws + (layer < 2 ? WS_DN01 : WS_DN23)) + (size_t)j * DM * FF; jb.lda = FF; jb.ldb = FF; jb.K = FF; jb.rev = 1; break;
            case K_K: jb.A = X16; jb.x2 = RS; jb.Bt = (const bf16_t*)(ws + WS_KVW); jb.O = Kb; break;
            case K_VT: jb.A = (const bf16_t*)(ws + WS_KVW) + (size_t)DM * DM; jb.Bt = X16; jb.x2 = RS; jb.M = DM; jb.N = TOK; jb.O = Vtb; jb.epi = pg8::EPI_VT; break;
            case K_Q: jb.A = X16; jb.x2 = RS; jb.Bt = (const bf16_t*)(ws + WS_QW) + (size_t)j * DM * DM; jb.O = Qb; jb.scale = 0.125f * LOG2E; break;
            default:   jb.A = ONb; jb.Bt = (const bf16_t*)(ws + WS_OW) + (size_t)j * DM * DM; break;
            }
#ifndef NO_GEMM
            pg8::gemm_phase(c.lds, jb, c.G, c.bx, c.vc, c.tid);
#endif
            if (kind == K_Z) scan_after_z(c, p, j);
        } else if (kind == K_NORMA || kind == K_NORMB || kind == K_PRO) {
            if (kind == K_PRO) {
#ifndef NO_TAB
                for (int u = c.bx; u < 2 * NG; u += c.G) ssm_tables(c, p, u >> 6, u & 63);
#endif
                if (c.bx == c.G - 1) small_tables(c, p);
#ifndef NO_CONV
                convert_weights(c, p);
#endif
            }
            const void* xin = X; void* xout = X; int xin_f32 = 0, xout_f32 = 0; const bf16_t* mix = HM; const float* gpost = nullptr; float* rsout = (float*)(ws + WS_RS);
            if (kind == K_PRO) { xin = p.in[0]; xin_f32 = 1; mix = nullptr; }
            else if (kind == K_NORMA) { if (layer == 3) xout = Kb; gpost = p.in[2] + layer * DM; }
            else { gpost = p.in[4] + layer * DM; if (layer == 3) { xin = Kb; xout_f32 = 1; rsout = nullptr; } }
#ifndef NO_NORM
            norm_phase(c, xin, xin_f32, xout, xout_f32, mix, gpost, rsout);
#endif
        } else if (kind == K_SCAN) {
#ifndef NO_SCAN
            scan_phase(c, p, j);
#endif
        } else {
#ifndef NO_ATTN
            attn_phase(c, Qb, Kb, Vtb, ONb, (const float*)(ws + WS_BIAS), (const float*)(ws + WS_SCAL) + j * 4, p.in[24] + j * 128);
#endif
        }
        }
        if (!(kind == K_K || kind == K_VT || ph == 34)) { if (ph == 0 && c.G > 0x40000000) grid.sync(); else { XcdBarrier xb_; xb_.bar = (unsigned*)(ws + WS_BAR); xb_.x = xb_xcc_id(); xb_.st = (volatile LAS unsigned*)(c.lds + 131072); xcd_barrier(xb_); } }
    }
}

extern "C" void kernel_launch(void* const* d_in, const int* in_sizes, int n_in, void* d_out, int out_size, void* d_ws, size_t ws_size, hipStream_t stream) {
    static int grid_blocks = 0;
    if (grid_blocks == 0) {
        if (n_in != 27 || out_size != TOK * DM || ws_size < WS_END) { fprintf(stderr, "kernel_launch: unexpected shapes (n_in %d, out %d, ws %zu)\n", n_in, out_size, ws_size); grid_blocks = -1; return; }
        int dev = 0, cus = 0, per_cu = 0;
        hipGetDevice(&dev);
        hipDeviceGetAttribute(&cus, hipDeviceAttributeMultiprocessorCount, dev);
        if (hipFuncSetAttribute((const void*)yoco_fwd, hipFuncAttributeMaxDynamicSharedMemorySize, LDS_BYTES) != hipSuccess) { fprintf(stderr, "kernel_launch: hipFuncSetAttribute failed\n"); grid_blocks = -1; return; }
        if (hipOccupancyMaxActiveBlocksPerMultiprocessor(&per_cu, (const void*)yoco_fwd, 512, LDS_BYTES) != hipSuccess || per_cu < 1) { fprintf(stderr, "kernel_launch: occupancy query says %d\n", per_cu); per_cu = 1; }
        (void)hipGetLastError();
        grid_blocks = cus * 1;
    }
    if (grid_blocks < 0) return;
    Params p{};
    for (int i = 0; i < 27; ++i) p.in[i] = (const float*)d_in[i];
    p.out = (float*)d_out; p.ws = (unsigned char*)d_ws;
    if (hipMemsetAsync((char*)d_ws + WS_BAR, 0, 16384, stream) != hipSuccess) { fprintf(stderr, "kernel_launch: memset of barrier words failed\n"); return; }
    void* args[] = {&p};
    hipError_t e = hipLaunchCooperativeKernel((const void*)yoco_fwd, dim3(grid_blocks), dim3(512), args, LDS_BYTES, stream);
    if (e != hipSuccess) fprintf(stderr, "cooperative launch failed: %s (grid %d)\n", hipGetErrorString(e), grid_blocks);
}
```
